# Optimizing an MI355X kernel written in HIP

```python
import math
import jax, jax.numpy as jnp
from jax import lax
import numpy as np

D_MODEL = 1024
BATCH = 16
SEQ = 4096
DEPTH = 4

CTX_LEN = 256
GRID_W = 64

ATT_QK_DIM = 64
ATT_V_DIM = 2 * ATT_QK_DIM
ATT_W = D_MODEL // 2
ATT_HEADS = ATT_W // ATT_V_DIM
QK_W = ATT_HEADS * 2 * ATT_QK_DIM
LRU_W = D_MODEL // 4
LRU_BLOCKS = 4
LRU_BLOCK_W = LRU_W // LRU_BLOCKS
LRU_CONV_W = 4
LRU_C = 8.0
FNET_W = D_MODEL - ATT_W - LRU_W
FNET_GROUPS = 4
FNET_GROUP_W = FNET_W // FNET_GROUPS
IN_SPLITS = [QK_W, 2 * QK_W, 2 * QK_W + ATT_W, 2 * QK_W + ATT_W + LRU_W, 2 * QK_W + ATT_W + 2 * LRU_W]
IN_W = 2 * QK_W + ATT_W + 2 * LRU_W + FNET_W
ROPE_BASE = 10000.0
Q_BLOCK = 128
N_EXPERTS = 16
CAPACITY_FACTOR = 2
D_EXPERT = 2 * D_MODEL
DEEPNORM_ALPHA = (2 * DEPTH) ** 0.25
DEEPNORM_BETA = (8 * DEPTH) ** -0.25
LN_EPS = 1e-5
RMS_EPS = 1e-6

kernel_name = "hymba_style_diffusion_hybrid_ec_moe"

F32 = jnp.float32


def _ln(x):
    xf = x.astype(F32)
    mu = jnp.mean(xf, -1, keepdims=True)
    var = jnp.mean(jnp.square(xf - mu), -1, keepdims=True)
    return ((xf - mu) * lax.rsqrt(var + LN_EPS)).astype(x.dtype)


def _ln_affine(x, g, b):
    return _ln(x) * g + b


def _rope_1d(x, pos):
    half = x.shape[-1] // 2
    inv = ROPE_BASE ** (-jnp.arange(half, dtype=F32) / half)
    ang = pos.astype(F32)[:, None] * inv
    ang = ang.reshape((ang.shape[0],) + (1,) * (x.ndim - 3) + (half,))
    cos, sin = jnp.cos(ang), jnp.sin(ang)
    xf = x.astype(F32)
    x1, x2 = xf[..., :half], xf[..., half:]
    return jnp.concatenate([x1 * cos - x2 * sin, x1 * sin + x2 * cos], -1).astype(x.dtype)


def _axial_rope(x, row, col):
    h = x.shape[-1] // 2
    return jnp.concatenate([_rope_1d(x[..., :h], row), _rope_1d(x[..., h:], col)], -1)


def _split_proj(z):
    b, t, _ = z.shape
    q, k, v, ux, ug, uf = jnp.split(z, IN_SPLITS, axis=-1)
    q = q.reshape(b, t, ATT_HEADS, 2, ATT_QK_DIM)
    k = k.reshape(b, t, ATT_HEADS, 2, ATT_QK_DIM)
    v = v.reshape(b, t, ATT_HEADS, ATT_V_DIM)
    return q, k, v, ux, ug, uf


def _diff_attend(q, k, v, lam):
    s = jnp.einsum('bqhmd,bkhmd->bhmqk', q, k).astype(F32) * (ATT_QK_DIM ** -0.5)
    p = jax.nn.softmax(s, axis=-1)
    w = p[:, :, 0] - lam * p[:, :, 1]
    return jnp.einsum('bhqk,bkhd->bqhd', w.astype(v.dtype), v)


def _latent_diff_attention(q, k, v, lam):
    b, n = q.shape[:2]
    nb = n // Q_BLOCK
    qb = q.reshape((b, nb, Q_BLOCK) + q.shape[2:]).swapaxes(0, 1)
    ob = lax.map(lambda blk: _diff_attend(blk, k, v, lam), qb)
    return ob.swapaxes(0, 1).reshape((b, n) + ob.shape[3:])


def _head_rms(o, g, lam_init):
    of = o.astype(F32)
    r = of * lax.rsqrt(jnp.mean(jnp.square(of), -1, keepdims=True) + RMS_EPS)
    r = r * g * (1.0 - lam_init)
    return r.reshape(o.shape[0], o.shape[1], ATT_W).astype(o.dtype)


def _centred_dwconv(u, w, b):
    left = LRU_CONV_W // 2
    right = LRU_CONV_W - 1 - left
    t = u.shape[1]
    up = jnp.pad(u, ((0, 0), (left, right), (0, 0)))
    return sum((up[:, j:j + t] * w[j] for j in range(LRU_CONV_W)), b)


def _lin_combine(e1, e2):
    a1, b1 = e1
    a2, b2 = e2
    return a1 * a2, a2 * b1 + b2


def _rglru(u, wa, ba, wx, bx, lam, h0, reverse):
    b, t, w = u.shape
    ub = u.reshape(b, t, LRU_BLOCKS, LRU_BLOCK_W)
    r = jax.nn.sigmoid((jnp.einsum('btnc,ncd->btnd', ub, wa).reshape(b, t, w) + ba).astype(F32))
    i = jax.nn.sigmoid((jnp.einsum('btnc,ncd->btnd', ub, wx).reshape(b, t, w) + bx).astype(F32))
    log_a = -LRU_C * r * jax.nn.softplus(-lam.astype(F32))
    a = jnp.exp(log_a)
    inp = jnp.sqrt(-jnp.expm1(2.0 * log_a)) * i * u.astype(F32)
    a_cum, h = lax.associative_scan(_lin_combine, (a, inp), axis=1, reverse=reverse)
    return h + a_cum * h0[:, None, :]


def _fourier(uf):
    b, t, _ = uf.shape
    g = uf.astype(F32).reshape(b, t, FNET_GROUPS, FNET_GROUP_W)
    y = jnp.fft.fft2(g, axes=(1, 3), norm='ortho').real
    return y.reshape(b, t, FNET_W).astype(uf.dtype)


def _expert_choice(h, w_router, w_gate, w_up, w_down):
    b, t, d = h.shape
    cap = CAPACITY_FACTOR * t // N_EXPERTS
    s = jax.nn.softmax(jnp.einsum('btd,de->bte', h, w_router).astype(F32), axis=-1)
    g, idx = lax.top_k(jnp.swapaxes(s, 1, 2), cap)
    xs = jax.vmap(lambda hb, ib: hb[ib])(h, idx)
    a = jnp.einsum('becd,edf->becf', xs, w_gate)
    u = jnp.einsum('becd,edf->becf', xs, w_up)
    y = jnp.einsum('becf,efd->becd', jax.nn.silu(a) * u, w_down) * g[..., None].astype(h.dtype)
    return jax.vmap(lambda ib, yb: jnp.zeros((t, d), yb.dtype).at[ib.reshape(-1)].add(yb.reshape(-1, d)))(idx, y)


def setup_inputs(seed: int = 0) -> dict:
    key = jax.random.key(seed)
    ks = jax.random.split(key, 32)
    D = D_MODEL

    def nrm(k, shape, scale):
        return jax.random.normal(k, shape, F32) * scale

    u = jax.random.uniform(ks[20], (DEPTH, 2, LRU_W), F32, 0.9, 0.999)
    a = u ** (1.0 / LRU_C)
    return {
        "x": nrm(ks[0], (BATCH, SEQ, D), 1.0),
        "c": nrm(ks[1], (BATCH, D), 1.0),
        "ctx": nrm(ks[2], (BATCH, CTX_LEN, D), 1.0),
        "c_ctx": nrm(ks[3], (D,), 1.0),
        "w_mod": nrm(ks[4], (DEPTH, D, 6 * D), 0.5 * D ** -0.5),
        "b_mod": nrm(ks[5], (DEPTH, 6 * D), 0.02),
        "w_in": nrm(ks[6], (DEPTH, D, IN_W), D ** -0.5),
        "lam_q1": nrm(ks[7], (DEPTH, ATT_QK_DIM), 0.1),
        "lam_k1": nrm(ks[8], (DEPTH, ATT_QK_DIM), 0.1),
        "lam_q2": nrm(ks[9], (DEPTH, ATT_QK_DIM), 0.1),
        "lam_k2": nrm(ks[10], (DEPTH, ATT_QK_DIM), 0.1),
        "attn_norm_g": 1.0 + nrm(ks[11], (DEPTH, ATT_HEADS, ATT_V_DIM), 0.02),
        "conv_w": nrm(ks[12], (DEPTH, LRU_CONV_W, LRU_W), LRU_CONV_W ** -0.5),
        "conv_b": nrm(ks[13], (DEPTH, LRU_W), 0.02),
        "lru_wa": nrm(ks[14], (DEPTH, 2, LRU_BLOCKS, LRU_BLOCK_W, LRU_BLOCK_W), LRU_BLOCK_W ** -0.5),
        "lru_ba": nrm(ks[15], (DEPTH, 2, LRU_W), 0.02),
        "lru_wx": nrm(ks[16], (DEPTH, 2, LRU_BLOCKS, LRU_BLOCK_W, LRU_BLOCK_W), LRU_BLOCK_W ** -0.5),
        "lru_bx": nrm(ks[17], (DEPTH, 2, LRU_W), 0.02),
        "lru_lam": jnp.log(a) - jnp.log1p(-a),
        "w_out": nrm(ks[18], (DEPTH, D, D), DEEPNORM_BETA * D ** -0.5),
        "ln1_g": 1.0 + nrm(ks[19], (DEPTH, D), 0.02),
        "ln1_b": nrm(ks[21], (DEPTH, D), 0.02),
        "w_router": nrm(ks[22], (DEPTH, D, N_EXPERTS), D ** -0.5),
        "w_gate": nrm(ks[23], (DEPTH, N_EXPERTS, D, D_EXPERT), D ** -0.5),
        "w_up": nrm(ks[24], (DEPTH, N_EXPERTS, D, D_EXPERT), D ** -0.5),
        "w_down": nrm(ks[25], (DEPTH, N_EXPERTS, D_EXPERT, D), DEEPNORM_BETA * D_EXPERT ** -0.5),
        "ln2_g": 1.0 + nrm(ks[26], (DEPTH, D), 0.02),
        "ln2_b": nrm(ks[27], (DEPTH, D), 0.02),
    }


def reference(x, c, ctx, c_ctx, w_mod, b_mod, w_in, lam_q1, lam_k1, lam_q2, lam_k2, attn_norm_g,
              conv_w, conv_b, lru_wa, lru_ba, lru_wx, lru_bx, lru_lam, w_out, ln1_g, ln1_b,
              w_router, w_gate, w_up, w_down, ln2_g, ln2_b):
    b, n, _ = x.shape
    rows = n // GRID_W
    pos = jnp.arange(rows * GRID_W)
    row = (pos // GRID_W).astype(F32)
    col = (pos % GRID_W).astype(F32)
    silu_c = jax.nn.silu(c)
    silu_cc = jax.nn.silu(c_ctx)

    for l in range(DEPTH):
        last = l == DEPTH - 1
        lam_init = 0.8 - 0.6 * math.exp(-0.3 * l)
        lam = (jnp.exp(jnp.sum(lam_q1[l].astype(F32) * lam_k1[l].astype(F32)))
               - jnp.exp(jnp.sum(lam_q2[l].astype(F32) * lam_k2[l].astype(F32))) + lam_init)

        sh1, sc1, g1, sh2, sc2, g2 = jnp.split((silu_c @ w_mod[l] + b_mod[l])[:, None, :], 6, axis=-1)
        csh1, csc1, cg1, csh2, csc2, cg2 = jnp.split(silu_cc @ w_mod[l] + b_mod[l], 6)

        hl = _ln(x) * (1.0 + sc1) + sh1
        hc = _ln(ctx) * (1.0 + csc1) + csh1
        ql, kl, vl, xl, gl, fl = _split_proj(hl @ w_in[l])
        qc, kc, vc, xc, gc, fc = _split_proj(hc @ w_in[l])

        ql = _axial_rope(ql, row, col)
        kl = _axial_rope(kl, row, col)
        k_all = jnp.concatenate([kl, kc], axis=1)
        v_all = jnp.concatenate([vl, vc], axis=1)
        att_l = _head_rms(_latent_diff_attention(ql, k_all, v_all, lam), attn_norm_g[l], lam_init)

        ul = _centred_dwconv(xl, conv_w[l], conv_b[l])
        uc = _centred_dwconv(xc, conv_w[l], conv_b[l])
        lru_l = jnp.zeros((b, n, LRU_W), F32)
        lru_c = jnp.zeros((b, ctx.shape[1], LRU_W), F32)
        for d, rev in enumerate((False, True)):
            h_c = _rglru(uc, lru_wa[l, d], lru_ba[l, d], lru_wx[l, d], lru_bx[l, d], lru_lam[l, d],
                         jnp.zeros((b, LRU_W), F32), rev)
            h_fin = h_c[:, 0] if rev else h_c[:, -1]
            h_l = _rglru(ul, lru_wa[l, d], lru_ba[l, d], lru_wx[l, d], lru_bx[l, d], lru_lam[l, d], h_fin, rev)
            lru_l = lru_l + h_l
            lru_c = lru_c + h_c
        y_l = (lru_l * jax.nn.gelu(gl.astype(F32))).astype(x.dtype)

        mix_l = jnp.concatenate([att_l, y_l, _fourier(fl)], axis=-1) @ w_out[l]
        x_new = _ln_affine(DEEPNORM_ALPHA * x + g1 * mix_l, ln1_g[l], ln1_b[l])
        hl2 = _ln(x_new) * (1.0 + sc2) + sh2
        x_new = _ln_affine(DEEPNORM_ALPHA * x_new + g2 * _expert_choice(hl2, w_router[l], w_gate[l], w_up[l], w_down[l]),
                           ln2_g[l], ln2_b[l])

        if not last:
            att_c = _head_rms(_diff_attend(qc, kc, vc, lam), attn_norm_g[l], lam_init)
            y_c = (lru_c * jax.nn.gelu(gc.astype(F32))).astype(ctx.dtype)
            mix_c = jnp.concatenate([att_c, y_c, _fourier(fc)], axis=-1) @ w_out[l]
            ctx_new = _ln_affine(DEEPNORM_ALPHA * ctx + cg1 * mix_c, ln1_g[l], ln1_b[l])
            hc2 = _ln(ctx_new) * (1.0 + csc2) + csh2
            ctx = _ln_affine(DEEPNORM_ALPHA * ctx_new + cg2 * _expert_choice(hc2, w_router[l], w_gate[l], w_up[l], w_down[l]),
                             ln2_g[l], ln2_b[l])
        x = x_new
    return x
```

```cpp
#include <hip/hip_runtime.h>
#include <cstdio>
#include <cstdint>

#define GAS __attribute__((address_space(1)))
#define LAS __attribute__((address_space(3)))
typedef unsigned short bf16_t;
typedef short bf16x8 __attribute__((ext_vector_type(8)));
typedef short s16x4 __attribute__((ext_vector_type(4)));
typedef float f32x4 __attribute__((ext_vector_type(4)));
typedef float f32x2 __attribute__((ext_vector_type(2)));
typedef float f32x16 __attribute__((ext_vector_type(16)));
typedef unsigned u32x4 __attribute__((ext_vector_type(4)));
typedef unsigned u32x2 __attribute__((ext_vector_type(2)));
typedef GAS unsigned gu32;
#define RLX_AGENT __ATOMIC_RELAXED, __HIP_MEMORY_SCOPE_AGENT
#define LDS_WAIT() asm volatile("s_waitcnt lgkmcnt(0)" ::: "memory")
#define VM_WAIT() asm volatile("s_waitcnt vmcnt(0)" ::: "memory")

constexpr int D = 1024, NB = 16, T = 4096, TC = 256, DEPTH = 4;
constexpr int ML = NB * T, MC = NB * TC, M = ML + MC;
constexpr int INW = 2304, NE = 16, FE = 2048;
constexpr int CAPL = 512, CAPC = 32;
constexpr int NPAIR = NE * 17;
constexpr float LN_EPS = 1e-5f, RMS_EPS = 1e-6f;
constexpr float DN_ALPHA = 1.6817928305074290f;
constexpr int NWAVES = 8, NTHR = 512;

constexpr size_t MiB = 1u << 20;
constexpr size_t WS_CTL = 0, CTL_ZERO_BYTES = 1 * MiB;
constexpr size_t WS_MOD = 1 * MiB;
constexpr size_t WS_SMALL = 3 * MiB;
constexpr size_t SM_LAM = 0, SM_LRUW = 4096, SM_DC = SM_LRUW + 4 * 2 * 2 * 4 * 4096 * 2, SM_AC = SM_DC + 512 * 256 * 2, SM_END = SM_AC + 256 * 512 * 2;
static_assert(SM_END <= 3 * MiB, "small region");
constexpr size_t WS_WIN = 6 * MiB;
constexpr size_t WS_WOUT = 24 * MiB;
constexpr size_t WS_AT = 32 * MiB;
constexpr size_t WS_WEXP = 96 * MiB;
constexpr size_t WS_WDN = WS_WEXP + 128 * MiB;
constexpr size_t WS_X = 288 * MiB;
constexpr size_t WS_H = 560 * MiB;
constexpr size_t WS_CC = 696 * MiB;
constexpr size_t WS_ZR = 832 * MiB;
constexpr size_t WS_O1 = 1138 * MiB;
constexpr size_t WS_GT = 1170 * MiB;
constexpr size_t WS_GTC = 1234 * MiB;
constexpr size_t WS_SC = 1238 * MiB;
constexpr size_t WS_TM = 1243 * MiB;
constexpr size_t WS_IDX = 1248 * MiB;
constexpr size_t WS_SUM = 1249 * MiB;
constexpr size_t WS_CAR = 1258 * MiB;
constexpr size_t WS_HM = 1270 * MiB;
constexpr size_t WS_END = 1814 * MiB;
static_assert(WS_HM + (size_t)NPAIR * 512 * FE * 2 <= WS_END, "ws map");
static_assert(WS_ZR + (size_t)M * INW * 2 <= WS_O1 && WS_ZR + (size_t)NPAIR * 512 * D * 2 <= WS_O1, "ws map zr");

constexpr int PH_LDS = 147456;
constexpr int ROPE_OFF = PH_LDS;
constexpr int MISC_OFF = ROPE_OFF + 8192;
constexpr int LDS_BYTES = MISC_OFF + 512;

__device__ __forceinline__ unsigned f2bf(float f) { unsigned u = __builtin_bit_cast(unsigned, f); return (u + 0x7fffu + ((u >> 16) & 1u)) >> 16; }
__device__ __forceinline__ unsigned pk2(float lo, float hi) { return f2bf(lo) | (f2bf(hi) << 16); }
__device__ __forceinline__ float bf2f(unsigned short h) { return __builtin_bit_cast(float, (unsigned)h << 16); }
__device__ __forceinline__ float bflo(unsigned w) { return __builtin_bit_cast(float, w << 16); }
__device__ __forceinline__ float bfhi(unsigned w) { return __builtin_bit_cast(float, w & 0xffff0000u); }
__device__ __forceinline__ unsigned cvt_pk_bf16(float lo, float hi) { unsigned r; asm volatile("v_cvt_pk_bf16_f32 %0, %1, %2" : "=v"(r) : "v"(lo), "v"(hi)); return r; }
typedef int v8i __attribute__((ext_vector_type(8)));
__device__ __forceinline__ float clamp448(float x) { return __builtin_amdgcn_fmed3f(x, -448.f, 448.f); }
__device__ __forceinline__ unsigned cvt4_fp8(float a, float b, float c, float d) { int w = 0; w = __builtin_amdgcn_cvt_pk_fp8_f32(a, b, w, false); w = __builtin_amdgcn_cvt_pk_fp8_f32(c, d, w, true); return (unsigned)w; }
__device__ __forceinline__ float fp8_dec(unsigned char b) { return __builtin_amdgcn_cvt_f32_fp8((int)b, 0); }
constexpr float SX8 = 16.f, SWG8 = 128.f, SH8 = 8.f, SWD8 = 512.f, SY8 = 64.f;
__device__ __forceinline__ float fast_sigmoid(float x) { return __builtin_amdgcn_rcpf(1.0f + __expf(-x)); }
__device__ __forceinline__ int lane_id() { int r; asm volatile("v_mbcnt_lo_u32_b32 %0, -1, 0\n\tv_mbcnt_hi_u32_b32 %0, -1, %0" : "=v"(r)); return r; }
template <int CTRL> __device__ __forceinline__ float dppf(float v) { return __builtin_bit_cast(float, __builtin_amdgcn_update_dpp(0, __builtin_bit_cast(int, v), CTRL, 0xF, 0xF, true)); }
template <int CTRL> __device__ __forceinline__ int dppi(int v) { return __builtin_amdgcn_update_dpp(0, v, CTRL, 0xF, 0xF, true); }
__device__ __forceinline__ float swz16f(float v) { return __builtin_bit_cast(float, __builtin_amdgcn_ds_swizzle(__builtin_bit_cast(int, v), 0x401F)); }
__device__ __forceinline__ float row32_sum(float v) {
    v += dppf<0xB1>(v); v += dppf<0x4E>(v); v += dppf<0x141>(v); v += dppf<0x140>(v); v += swz16f(v); return v; }
__device__ __forceinline__ void swap32(unsigned x, unsigned& r0, unsigned& r1) { unsigned y = x; asm volatile("" : "+v"(y)); auto r = __builtin_amdgcn_permlane32_swap(x, y, false, false); r0 = r[0]; r1 = r[1]; }
__device__ __forceinline__ float wave_sum(float v) {
    v = row32_sum(v); unsigned r0, r1; swap32(__builtin_bit_cast(unsigned, v), r0, r1);
    return __builtin_bit_cast(float, r0) + __builtin_bit_cast(float, r1);
}
__device__ __forceinline__ int wave_sum_i(int v) {
    v += dppi<0xB1>(v); v += dppi<0x4E>(v); v += dppi<0x141>(v); v += dppi<0x140>(v); v += __builtin_amdgcn_ds_swizzle(v, 0x401F);
    unsigned r0, r1; swap32((unsigned)v, r0, r1); return (int)r0 + (int)r1;
}
__device__ __forceinline__ float xor32f(float v, bool lo_half) { unsigned r0, r1; swap32(__builtin_bit_cast(unsigned, v), r0, r1); return __builtin_bit_cast(float, lo_half ? r1 : r0); }

#define XB_TMO      128
#define XB_XCNT(j)  (256  + 64 * (j))
#define XB_XSUB(j)  (1280 + 64 * (j))
#define XB_XGEN(j)  (2304 + 64 * (j))
#define XB_TOP      3328
#define XB_TOPGEN   3392
#define XCD_BAR_WORDS 3456
#define XB_SPIN_CAP (1u << 18)
__device__ __forceinline__ unsigned xb_ld(unsigned* p)              { return __hip_atomic_load(p, __ATOMIC_RELAXED, __HIP_MEMORY_SCOPE_AGENT); }
__device__ __forceinline__ unsigned xb_add(unsigned* p, unsigned v) { return __hip_atomic_fetch_add(p, v, __ATOMIC_RELAXED, __HIP_MEMORY_SCOPE_AGENT); }
__device__ __forceinline__ unsigned xb_xcc_id() { return (unsigned)__builtin_amdgcn_s_getreg((3 << 11) | 20) & 0xFu; }
#define XB_SPIN(cond, bar) do { unsigned _sp = 0; while (cond) { __builtin_amdgcn_s_sleep(1); \
    if ((++_sp & 255u) == 0u) { if (xb_ld(&(bar)[XB_TMO])) break; if (_sp > XB_SPIN_CAP) { atomicAdd(&(bar)[XB_TMO], 1u); break; } } } } while (0)
struct XcdBarrier { unsigned* bar; unsigned x; volatile LAS unsigned* st; };
__device__ __forceinline__ XcdBarrier xcd_barrier_post(unsigned* bar, volatile LAS unsigned* st) {
    XcdBarrier b; b.bar = bar; b.x = xb_xcc_id(); b.st = st;
    if (threadIdx.x == 0) (void)xb_add(&bar[XB_XCNT(b.x)], 1u);
    return b;
}
__device__ __forceinline__ void xcd_barrier_complete(unsigned* bar, unsigned x, unsigned& nloc, unsigned& nx) {
    const unsigned G = gridDim.x * gridDim.y * gridDim.z;
    unsigned sum, cnt, mine, sp = 0u;
    for (;;) {
        sum = 0u; cnt = 0u; mine = 0u;
#pragma unroll
        for (unsigned j = 0; j < 16; ++j) { const unsigned c = xb_ld(&bar[XB_XCNT(j)]); sum += c; cnt += (c > 0u) ? 1u : 0u; mine = (j == x) ? c : mine; }
        if (sum == G) break;
        __builtin_amdgcn_s_sleep(1);
        if ((++sp & 255u) == 0u) { if (xb_ld(&bar[XB_TMO])) break; if (sp > XB_SPIN_CAP) { atomicAdd(&bar[XB_TMO], 1u); break; } }
    }
    nloc = mine > 0u ? mine : 1u; nx = cnt > 0u ? cnt : 1u;
}
__device__ __forceinline__ void xcd_barrier(const XcdBarrier& b) {
    asm volatile("s_waitcnt vmcnt(0)" ::: "memory");
    __syncthreads();
    if (threadIdx.x == 0) {
        unsigned* bar = b.bar;
        __builtin_amdgcn_s_waitcnt(0);
        unsigned nloc = b.st[0], nx = b.st[1];
        if (nloc == 0u) { xcd_barrier_complete(bar, b.x, nloc, nx); b.st[0] = nloc; b.st[1] = nx; }
        const unsigned old = xb_add(&bar[XB_XSUB(b.x)], 1u);
        const unsigned gen = old / nloc;
        if (old + 1u == (gen + 1u) * nloc) {
            __builtin_amdgcn_fence(__ATOMIC_RELEASE, "agent");
            asm volatile("s_waitcnt vmcnt(0)" ::: "memory");
            const unsigned og = xb_add(&bar[XB_TOP], 1u);
            const unsigned tg = og / nx;
            if (og + 1u == (tg + 1u) * nx) xb_add(&bar[XB_TOPGEN], 1u);
            else XB_SPIN(xb_ld(&bar[XB_TOPGEN]) == tg, bar);
            __builtin_amdgcn_fence(__ATOMIC_ACQUIRE, "agent");
            xb_add(&bar[XB_XGEN(b.x)], 1u);
            asm volatile("s_waitcnt vmcnt(0)" ::: "memory");
        } else {
            XB_SPIN(xb_ld(&bar[XB_XGEN(b.x)]) == gen, bar);
            __builtin_amdgcn_fence(__ATOMIC_ACQUIRE, "agent");
            asm volatile("s_waitcnt vmcnt(0)" ::: "memory");
        }
    }
    __syncthreads();
}
namespace pg8 {
constexpr int BM = 256, BK = 64, HALF = 128, HTB = HALF * BK * 2, STAGE_BYTES = 8 * HTB;
__host__ __device__ __forceinline__ int lds_byte(int r, int c) { const int st = (r >> 4) * 2 + (c >> 5), rr = r & 15, cc = c & 31, ob = rr * 64 + cc * 2; return st * 1024 + (ob ^ (((ob >> 9) & 1) << 5)); }
__host__ __device__ __forceinline__ void stage_rc(int b, int& R, int& C) { const int st = b / 1024, sb = b % 1024, swz = sb ^ (((sb >> 9) & 1) << 5); R = (st >> 1) * 16 + swz / 64; C = (st & 1) * 32 + (swz % 64) / 2; }
__host__ __device__ __forceinline__ int perm32(int rho) { const int n = rho >> 4, i = rho & 15; return 8 * (i >> 2) + 4 * n + (i & 3); }

struct Unit { const char* a; const char* b; int orow, ocol; const int* idx; };
struct GemmP { int K; unsigned lda, ldb; size_t hstepA, hstepB; };

template <class Epi, class Sched, bool ALIGN_EPI, bool FP8 = false, bool GATHER = false>
__device__ __forceinline__ void gemm_phase(LAS unsigned char* lds, const GemmP g, const Sched& S, const Epi& E, int tid) {
    const int wid = __builtin_amdgcn_readfirstlane(tid >> 6), lane = tid & 63, wr = wid >> 2, wc = wid & 3, fr = lane & 15, fq = lane >> 4;
    const int K = g.K, nt = K / BK;
    unsigned voffA[2], voffB[2];
#pragma unroll
    for (int i = 0; i < 2; ++i) { int R, C; stage_rc(tid * 16 + i * 8192, R, C); const int Rb = Epi::PERM ? ((R & ~31) + perm32(R & 31)) : R;
        voffA[i] = (unsigned)(R * g.lda + C) * 2u; voffB[i] = (unsigned)(Rb * g.ldb + C) * 2u; }
    const size_t kstep = (size_t)(BK * 2);
    const size_t hA = GATHER ? (size_t)0 : g.hstepA, hB = g.hstepB;
    unsigned a0c[2], a1c[2], a0n[2], a1n[2]; int gR[2], gC[2];
#pragma unroll
    for (int i = 0; i < 2; ++i) { stage_rc(tid * 16 + i * 8192, gR[i], gC[i]); a0c[i] = a1c[i] = a0n[i] = a1n[i] = voffA[i]; }
#define PG8_IDX(u_, v0_, v1_) do { if constexpr (GATHER) { _Pragma("unroll") for (int _i = 0; _i < 2; ++_i) { v0_[_i] = (unsigned)(u_).idx[gR[_i]] * (g.lda * 2u) + (unsigned)gC[_i] * 2u; v1_[_i] = (unsigned)(u_).idx[128 + gR[_i]] * (g.lda * 2u) + (unsigned)gC[_i] * 2u; } } } while (0)
    const unsigned ldsw = (unsigned)wid * 1024u;
    const int aoff = FP8 ? lds_byte(wr * 64 + fr, (fq & 1) * 16) + (fq >> 1) * 1024 : lds_byte(wr * 64 + fr, fq * 8), boff = FP8 ? lds_byte(wc * 32 + fr, (fq & 1) * 16) + (fq >> 1) * 1024 : lds_byte(wc * 32 + fr, fq * 8);
#define PG8_SA(b, h) (((b) * 2 + (h)) * HTB)
#define PG8_SB(b, h) ((4 + (b) * 2 + (h)) * HTB)
#define PG8_STAGE(bufoff, gbase, voff) do { _Pragma("unroll") for (int _i = 0; _i < 2; ++_i) \
        __builtin_amdgcn_global_load_lds((const unsigned*)((const char*)(gbase) + (voff)[_i]), (LAS unsigned*)(lds + (bufoff) + ldsw + _i * 8192), 16, 0, 0); } while (0)
#define PG8_LD8(p_) ({ const u32x4 lo_ = *(const LAS u32x4*)(p_), hi_ = *(const LAS u32x4*)((p_) + 16); (v8i){(int)lo_.x, (int)lo_.y, (int)lo_.z, (int)lo_.w, (int)hi_.x, (int)hi_.y, (int)hi_.z, (int)hi_.w}; })
#define PG8_LDA(dst, b, h) do { if constexpr (FP8) { _Pragma("unroll") for (int m = 0; m < 4; ++m) dst##8[m] = PG8_LD8(lds + PG8_SA(b, h) + aoff + m * 2048); } \
        else { _Pragma("unroll") for (int m = 0; m < 4; ++m) _Pragma("unroll") for (int k = 0; k < 2; ++k) dst[m][k] = *(const LAS bf16x8*)(lds + PG8_SA(b, h) + aoff + m * 2048 + k * 1024); } } while (0)
#define PG8_LDB(dst, b, h) do { if constexpr (FP8) { _Pragma("unroll") for (int n = 0; n < 2; ++n) dst##8[n] = PG8_LD8(lds + PG8_SB(b, h) + boff + n * 2048); } \
        else { _Pragma("unroll") for (int n = 0; n < 2; ++n) _Pragma("unroll") for (int k = 0; k < 2; ++k) dst[n][k] = *(const LAS bf16x8*)(lds + PG8_SB(b, h) + boff + n * 2048 + k * 1024); } } while (0)
#define PG8_MMA(ai, bj, At, Bt) do { __builtin_amdgcn_s_setprio(1); if constexpr (FP8) { _Pragma("unroll") for (int m = 0; m < 4; ++m) _Pragma("unroll") for (int n = 0; n < 2; ++n) \
        asm volatile("v_mfma_f32_16x16x128_f8f6f4 %0, %1, %2, %0" : "+v"(acc[ai][bj][m][n]) : "v"(Bt##8[n]), "v"(At##8[m])); }   \
        else { _Pragma("unroll") for (int m = 0; m < 4; ++m) _Pragma("unroll") for (int n = 0; n < 2; ++n) _Pragma("unroll") for (int k = 0; k < 2; ++k) \
        acc[ai][bj][m][n] = __builtin_amdgcn_mfma_f32_16x16x32_bf16(Bt[n][k], At[m][k], acc[ai][bj][m][n], 0, 0, 0); } __builtin_amdgcn_s_setprio(0); } while (0)
#define PG8_WAIT_V(n) asm volatile("s_waitcnt vmcnt(" #n ")" ::: "memory")
#define PG8_WAIT_L(n) asm volatile("s_waitcnt lgkmcnt(" #n ")" ::: "memory")
#define PG8_BAR __builtin_amdgcn_s_barrier()
#define PG8_SCHED __builtin_amdgcn_sched_barrier(0)
    Unit cur, nxt; int ui = 0;
    if (!S.next(0, cur)) return;
    f32x4 acc[2][2][4][2];
#pragma unroll
    for (int a = 0; a < 2; ++a)
#pragma unroll
        for (int b = 0; b < 2; ++b)
#pragma unroll
            for (int m = 0; m < 4; ++m)
#pragma unroll
                for (int n = 0; n < 2; ++n) acc[a][b][m][n] = (f32x4){0.f, 0.f, 0.f, 0.f};
    bf16x8 At[4][2], B0[2][2], B1[2][2]; v8i At8[4], B08[2], B18[2];
    const char* cA = cur.a; const char* cB = cur.b;
    PG8_IDX(cur, a0c, a1c);
    PG8_STAGE(PG8_SB(0, 0), cB, voffB); PG8_STAGE(PG8_SB(0, 1), cB + hB, voffB); PG8_STAGE(PG8_SA(0, 0), cA, a0c); PG8_STAGE(PG8_SA(0, 1), cA + hA, a1c);
    if (wr == 1) PG8_BAR;
    PG8_WAIT_V(2); PG8_BAR;
    PG8_STAGE(PG8_SB(1, 0), cB + kstep, voffB); PG8_STAGE(PG8_SA(1, 0), cA + kstep, a0c); PG8_STAGE(PG8_SB(1, 1), cB + hB + kstep, voffB);
    PG8_WAIT_V(6); PG8_BAR;
    for (;;) {
        const bool has_next = S.next(ui + 1, nxt);
        const char* nA = has_next ? nxt.a : cA; const char* nB = has_next ? nxt.b : cB;
        if constexpr (GATHER) { if (has_next)
            __builtin_amdgcn_global_load_lds((const unsigned*)(nxt.idx + 4 * lane), (LAS unsigned*)(lds + STAGE_BYTES + wid * 1024), 16, 0, 0); }
#pragma unroll 1
        for (int t = 0; t < nt; t += 2) {
            const bool last = (t == nt - 2);
            const char* a1 = cA + (size_t)(t + 1) * kstep;
            const char* a2 = last ? nA : cA + (size_t)(t + 2) * kstep; const char* b2 = last ? nB : cB + (size_t)(t + 2) * kstep;
            const char* a3 = a2 + kstep; const char* b3 = b2 + kstep;
            PG8_LDB(B0, 0, 0); PG8_LDB(B1, 0, 1); PG8_SCHED; PG8_LDA(At, 0, 0); PG8_STAGE(PG8_SA(1, 1), a1 + hA, a1c);
            if constexpr (GATHER) { if (last && has_next) {
                { const LAS unsigned* ix = (const LAS unsigned*)(lds + STAGE_BYTES + wid * 1024); a0n[0] = ix[gR[0]]; a0n[1] = ix[gR[1]]; a1n[0] = ix[128 + gR[0]]; a1n[1] = ix[128 + gR[1]]; }
                a0c[0] = a0n[0] * (g.lda * 2u) + (unsigned)gC[0] * 2u; a0c[1] = a0n[1] * (g.lda * 2u) + (unsigned)gC[1] * 2u; a1c[0] = a1n[0] * (g.lda * 2u) + (unsigned)gC[0] * 2u; a1c[1] = a1n[1] * (g.lda * 2u) + (unsigned)gC[1] * 2u; } }
            PG8_WAIT_V(8); PG8_WAIT_L(0); PG8_BAR; PG8_MMA(0, 0, At, B0); PG8_MMA(0, 1, At, B1); PG8_BAR; PG8_SCHED;
            PG8_LDA(At, 0, 1); PG8_STAGE(PG8_SB(0, 0), b2, voffB); PG8_STAGE(PG8_SB(0, 1), b2 + hB, voffB); PG8_STAGE(PG8_SA(0, 0), a2, a0c);
            PG8_WAIT_V(8); PG8_WAIT_L(0); PG8_BAR; PG8_MMA(1, 0, At, B0); PG8_MMA(1, 1, At, B1); PG8_BAR; PG8_SCHED;
            PG8_LDB(B0, 1, 0); PG8_LDB(B1, 1, 1); PG8_SCHED; PG8_LDA(At, 1, 0); PG8_STAGE(PG8_SA(0, 1), a2 + hA, a1c);
            PG8_WAIT_V(8); PG8_WAIT_L(0); PG8_BAR; PG8_MMA(0, 0, At, B0); PG8_MMA(0, 1, At, B1); PG8_BAR; PG8_SCHED;
            PG8_LDA(At, 1, 1); PG8_STAGE(PG8_SB(1, 0), b3, voffB); PG8_STAGE(PG8_SB(1, 1), b3 + hB, voffB); PG8_STAGE(PG8_SA(1, 0), a3, a0c);
            PG8_WAIT_V(8); PG8_WAIT_L(0); PG8_BAR; PG8_MMA(1, 0, At, B0); PG8_MMA(1, 1, At, B1); PG8_BAR; PG8_SCHED;
        }
        if constexpr (ALIGN_EPI) { if (wr == 0) PG8_BAR; }
        if constexpr (FP8) asm volatile("s_nop 15\n\ts_nop 15" ::: "memory");
        { int fr_ = fr, fq_ = fq; asm volatile("" : "+v"(fr_), "+v"(fq_)); E(acc, cur, wr, wc, fr_, fq_); }
        if (!has_next) break;
#pragma unroll
        for (int a = 0; a < 2; ++a)
#pragma unroll
            for (int b = 0; b < 2; ++b)
#pragma unroll
                for (int m = 0; m < 4; ++m)
#pragma unroll
                    for (int n = 0; n < 2; ++n) acc[a][b][m][n] = (f32x4){0.f, 0.f, 0.f, 0.f};
        cur = nxt; cA = nA; cB = nB; ++ui;
        if constexpr (ALIGN_EPI) { if (wr == 1) PG8_BAR; }
    }
    PG8_WAIT_V(0);
    if constexpr (!ALIGN_EPI) { if (wr == 0) PG8_BAR; }
    PG8_BAR;
#undef PG8_SA
#undef PG8_SB
#undef PG8_STAGE
#undef PG8_LDA
#undef PG8_IDX
#undef PG8_LD8
#undef PG8_LDB
#undef PG8_MMA
#undef PG8_WAIT_V
#undef PG8_WAIT_L
#undef PG8_BAR
#undef PG8_SCHED
}

typedef const f32x4 (&AccRef)[2][2][4][2];
__device__ __forceinline__ u32x4 pack8(const f32x4 v0, const f32x4 v1) { u32x4 w; w.x = cvt_pk_bf16(v0[0], v0[1]); w.y = cvt_pk_bf16(v0[2], v0[3]); w.z = cvt_pk_bf16(v1[0], v1[1]); w.w = cvt_pk_bf16(v1[2], v1[3]); return w; }

struct EpiBf16 {
    static constexpr bool PERM = true;
    bf16_t* O; int ldc; float scale;
    __device__ __forceinline__ void operator()(AccRef acc, const Unit& u, int wr, int wc, int fr, int fq) const {
        const int row0 = u.orow + wr * 64 + fr, col0 = u.ocol + wc * 32 + 8 * fq;
#pragma unroll
        for (int ai = 0; ai < 2; ++ai)
#pragma unroll
            for (int m = 0; m < 4; ++m) { bf16_t* rowp = O + (size_t)(row0 + ai * HALF + m * 16) * ldc + col0;
#pragma unroll
                for (int bj = 0; bj < 2; ++bj) *(u32x4*)(rowp + bj * HALF) = pack8(acc[ai][bj][m][0] * scale, acc[ai][bj][m][1] * scale); }
    }
};
struct EpiFp8 {
    static constexpr bool PERM = true;
    unsigned char* O; int ldc; float scale;
    __device__ __forceinline__ void operator()(AccRef acc, const Unit& u, int wr, int wc, int fr, int fq) const {
        const int row0 = u.orow + wr * 64 + fr, col0 = u.ocol + wc * 32 + 8 * fq;
#pragma unroll
        for (int ai = 0; ai < 2; ++ai)
#pragma unroll
            for (int m = 0; m < 4; ++m) { unsigned char* rowp = O + (size_t)(row0 + ai * HALF + m * 16) * ldc + col0;
#pragma unroll
                for (int bj = 0; bj < 2; ++bj) { const f32x4 v0 = acc[ai][bj][m][0] * scale, v1 = acc[ai][bj][m][1] * scale; u32x2 w;
                    w.x = cvt4_fp8(clamp448(v0[0]), clamp448(v0[1]), clamp448(v0[2]), clamp448(v0[3])); w.y = cvt4_fp8(clamp448(v1[0]), clamp448(v1[1]), clamp448(v1[2]), clamp448(v1[3]));
                    *(u32x2*)(rowp + bj * HALF) = w; } }
    }
};
struct EpiInProj {
    static constexpr bool PERM = true;
    bf16_t* O; const LAS f32x2* rope;
    __device__ __forceinline__ void operator()(AccRef acc, const Unit& u, int wr, int wc, int fr, int fq) const {
        const int row0 = u.orow + wr * 64 + fr, col0 = u.ocol + wc * 32 + 8 * fq;
        const bool do_rope = (u.ocol < 1024) && (u.orow < ML);
        const float sgn = (fq < 2) ? -1.f : 1.f;
#pragma unroll
        for (int ai = 0; ai < 2; ++ai)
#pragma unroll
            for (int m = 0; m < 4; ++m) { const int row = row0 + ai * HALF + m * 16; bf16_t* rowp = O + (size_t)row * INW + col0;
                f32x2 cs[8];
                if (do_rope) { const int t = row & (T - 1); const int pos = (wc & 1) ? (t & 63) : (t >> 6);
                    const LAS f32x4* rp = (const LAS f32x4*)(rope + pos * 16 + 8 * (fq & 1));
#pragma unroll
                    for (int k = 0; k < 4; ++k) { const f32x4 q = rp[k]; cs[2 * k] = (f32x2){q[0], q[1]}; cs[2 * k + 1] = (f32x2){q[2], q[3]}; } }
#pragma unroll
                for (int bj = 0; bj < 2; ++bj) { f32x4 v0 = acc[ai][bj][m][0], v1 = acc[ai][bj][m][1];
                    if (do_rope) {
#pragma unroll
                        for (int k = 0; k < 4; ++k) { const float p0 = xor32f(v0[k], fq < 2), p1 = xor32f(v1[k], fq < 2);
                            v0[k] = v0[k] * cs[k].x + sgn * p0 * cs[k].y; v1[k] = v1[k] * cs[4 + k].x + sgn * p1 * cs[4 + k].y; } }
                    *(u32x4*)(rowp + bj * HALF) = pack8(v0, v1); } }
    }
};
struct EpiF32 {
    static constexpr bool PERM = false;
    float* C; int ldc;
    __device__ __forceinline__ void operator()(AccRef acc, const Unit& u, int wr, int wc, int fr, int fq) const {
        const int row0 = u.orow + wr * 64 + fr, col0 = u.ocol + wc * 32 + 4 * fq;
#pragma unroll
        for (int ai = 0; ai < 2; ++ai)
#pragma unroll
            for (int m = 0; m < 4; ++m) { float* rowp = C + (size_t)(row0 + ai * HALF + m * 16) * ldc + col0;
#pragma unroll
                for (int bj = 0; bj < 2; ++bj)
#pragma unroll
                    for (int n = 0; n < 2; ++n) *(f32x4*)(rowp + bj * HALF + n * 16) = acc[ai][bj][m][n]; }
    }
};
struct EpiGateUp {
    static constexpr bool PERM = true;
    unsigned char* O;
    __device__ __forceinline__ void operator()(AccRef acc, const Unit& u, int wr, int wc, int fr, int fq) const {
        const int row0 = u.orow + wr * 64 + fr, col0 = u.ocol + wc * 32 + 8 * fq; constexpr float sg = 1.0f / (SX8 * SWG8);
#pragma unroll
        for (int ai = 0; ai < 2; ++ai)
#pragma unroll
            for (int m = 0; m < 4; ++m) { unsigned char* rowp = O + (size_t)(row0 + ai * HALF + m * 16) * FE + col0;
                float h[8];
#pragma unroll
                for (int k = 0; k < 4; ++k) { const float g0 = acc[ai][0][m][0][k] * sg, g1 = acc[ai][0][m][1][k] * sg;
                    h[k] = clamp448(g0 * fast_sigmoid(g0) * acc[ai][1][m][0][k] * (sg * SH8)); h[4 + k] = clamp448(g1 * fast_sigmoid(g1) * acc[ai][1][m][1][k] * (sg * SH8)); }
                u32x2 w; w.x = cvt4_fp8(h[0], h[1], h[2], h[3]); w.y = cvt4_fp8(h[4], h[5], h[6], h[7]); *(u32x2*)rowp = w; }
    }
};
struct EpiF1 {
    static constexpr bool PERM = true;
    bf16_t* GT; bf16_t* GTC;
    __device__ __forceinline__ void operator()(AccRef acc, const Unit& u, int wr, int wc, int fr, int fq) const {
        const int p = u.orow >> 8, pn = u.ocol >> 8, c0 = wr * 64 + fr, t0 = wc * 32 + 8 * fq;
        bf16_t* base; int cs;
        if (pn < 256) { base = GT + ((size_t)(pn >> 4) << 21) + (size_t)p * 4096 + (pn & 15) * 256; cs = 8192; }
        else { base = GTC + (size_t)(pn - 256) * 131072 + p * 256; cs = 512; }
        bf16_t* lp = base + (size_t)c0 * cs + t0;
#pragma unroll
        for (int ai = 0; ai < 2; ++ai)
#pragma unroll
            for (int m = 0; m < 4; ++m) { bf16_t* rp = lp + (size_t)(ai * HALF + m * 16) * cs;
#pragma unroll
                for (int bj = 0; bj < 2; ++bj) *(u32x4*)(rp + bj * HALF) = pack8(acc[ai][bj][m][0], acc[ai][bj][m][1]); }
    }
};

struct EpiF2H {
    static constexpr bool PERM = true;
    float* PQ; bf16_t* CC; unsigned* flags; unsigned epoch;
    __device__ __forceinline__ void operator()(AccRef acc, const Unit& u, int wr, int wc, int fr, int fq) const {
        const int part = u.ocol, b = u.orow >> 3, pm8 = u.orow & 7;
        float* tile = PQ + (size_t)u.orow * 65536; const int r0 = wr * 64 + fr, c0 = wc * 32 + 8 * fq;
        if (part == 0) {
#pragma unroll
            for (int ai = 0; ai < 2; ++ai)
#pragma unroll
                for (int m = 0; m < 4; ++m) { float* rp = tile + (size_t)(r0 + ai * HALF + m * 16) * 256 + c0;
#pragma unroll
                    for (int bj = 0; bj < 2; ++bj) { *(f32x4*)(rp + bj * HALF) = acc[ai][bj][m][0]; *(f32x4*)(rp + bj * HALF + 4) = acc[ai][bj][m][1]; } }
            asm volatile("s_waitcnt vmcnt(0)" ::: "memory"); __builtin_amdgcn_s_barrier();
            if (threadIdx.x == 0) { __builtin_amdgcn_fence(__ATOMIC_RELEASE, "agent"); asm volatile("s_waitcnt vmcnt(0)" ::: "memory"); __hip_atomic_store(flags + u.orow * 64, epoch, __ATOMIC_RELAXED, __HIP_MEMORY_SCOPE_AGENT); }
        } else {
            if (threadIdx.x == 0) { unsigned sp = 0; while (__hip_atomic_load(flags + u.orow * 64, __ATOMIC_RELAXED, __HIP_MEMORY_SCOPE_AGENT) < epoch) { __builtin_amdgcn_s_sleep(2); if (++sp > (1u << 20)) break; }
                __builtin_amdgcn_fence(__ATOMIC_ACQUIRE, "agent"); asm volatile("s_waitcnt vmcnt(0)" ::: "memory"); }
            __builtin_amdgcn_s_barrier(); asm volatile("" ::: "memory");
#pragma unroll
            for (int ai = 0; ai < 2; ++ai)
#pragma unroll
                for (int m = 0; m < 4; ++m) { const int r = r0 + ai * HALF + m * 16, k = pm8 * 256 + r; const float* rp = tile + (size_t)r * 256 + c0;
                    bf16_t* y0 = CC + (size_t)(b * T + k) * D + 768 + c0; bf16_t* y1 = CC + (size_t)(b * T + (T - k)) * D + 768 + c0;
#pragma unroll
                    for (int bj = 0; bj < 2; ++bj) { const f32x4 p0 = __builtin_nontemporal_load((const f32x4*)(rp + bj * HALF)), p1 = __builtin_nontemporal_load((const f32x4*)(rp + bj * HALF + 4));
                        *(u32x4*)(y0 + bj * HALF) = pack8(p0 + acc[ai][bj][m][0], p1 + acc[ai][bj][m][1]);
                        if (k > 0) *(u32x4*)(y1 + bj * HALF) = pack8(p0 - acc[ai][bj][m][0], p1 - acc[ai][bj][m][1]); } }
        }
    }
};

struct SchedPlain {
    int nN, total, G, c; const char* A; const char* B; size_t tA, tB; bool grp8;
    __device__ __forceinline__ bool next(int i, Unit& u) const { const int L = i * G + c; if (L >= total) return false; int pm = L / nN, pn = L - pm * nN;
        if (grp8) { const int gsz = 8 * nN, gi = L / gsz, r = L - gi * gsz; pm = gi * 8 + (r & 7); pn = r >> 3; }
        u.a = A + (size_t)pm * tA; u.b = B + (size_t)pn * tB; u.orow = pm * BM; u.ocol = pn * BM; u.idx = nullptr; return true; }
};
struct SchedF1 {
    int total, G, c; const char* A; const char* B;
    __device__ __forceinline__ bool next(int i, Unit& u) const { const int L = i * G + c; if (L >= total) return false; const int pn = L >> 1, pm = L & 1;
        u.a = A + (size_t)pm * (256 * 256 * 2); u.b = B + (size_t)pn * (256 * (size_t)INW * 2); u.orow = pm * BM; u.ocol = pn * BM; u.idx = nullptr; return true; }
};
struct SchedF2L {
    int G, c; const char* AT; const char* GT;
    __device__ __forceinline__ bool next(int i, Unit& u) const { const int L = i * G + c; if (L >= 256) return false;
        int b = L >> 4, pm = L & 15; if (G == 256) { const int x = L >> 5, w = L & 31; pm = (x & 3) * 4 + (w & 3); b = (x >> 2) * 8 + (w >> 2); }
        u.a = AT + (size_t)pm * (256 * 8192 * 2); u.b = GT + (size_t)b * (256 * 8192 * 2); u.orow = b * T + pm * BM; u.ocol = 768; u.idx = nullptr; return true; }
};
struct SchedF2H {
    int G, c; const char* AT; const char* GT;
    __device__ __forceinline__ bool next(int i, Unit& u) const { const int L = i * G + c; if (L >= 256) return false;
        const int x = L >> 5, w = L & 31, part = w & 1, pm8 = (x & 1) * 4 + ((w >> 1) & 3), b = (x >> 1) * 4 + (w >> 3);
        u.a = AT + (size_t)pm8 * (256 * 8192 * 2) + (size_t)part * (4096 * 2); u.b = GT + (size_t)b * (256 * 8192 * 2) + (size_t)part * (4096 * 2); u.orow = b * 8 + pm8; u.ocol = part; u.idx = nullptr; return true; }
};
struct SchedF2C {
    int G, c; const char* AC; const char* GTC;
    __device__ __forceinline__ bool next(int i, Unit& u) const { const int L = i * G + c; if (L >= 16) return false;
        u.a = AC; u.b = GTC + (size_t)L * (256 * 512 * 2); u.orow = ML + L * TC; u.ocol = 768; u.idx = nullptr; return true; }
};
struct SchedGU {
    int nrt, G, c; const char* XS; const char* W; const int* IDX;
    __device__ __forceinline__ bool next(int i, Unit& u) const { const int L = i * G + c; if (L >= 16 * 16 * nrt) return false;
        const int e = L / (16 * nrt), r = L - e * 16 * nrt, rt = r >> 4, ct = r & 15;
        const int rowbase = (rt < 32) ? (e * 17 + (rt >> 1)) * 512 + (rt & 1) * 256 : (e * 17 + 16) * 512 + (rt - 32) * 256;
        u.a = XS; u.idx = IDX + rowbase; u.b = W + (size_t)e * (2 * FE * D) + (size_t)ct * (128 * D); u.orow = rowbase; u.ocol = ct * 128; return true; }
};
struct SchedDN {
    int nrt, G, c; const char* HM; const char* W;
    __device__ __forceinline__ bool next(int i, Unit& u) const { const int L = i * G + c; if (L >= 16 * 4 * nrt) return false;
        const int e = L / (4 * nrt), r = L - e * 4 * nrt, rt = r >> 2, ct = r & 3;
        const int rowbase = (rt < 32) ? (e * 17 + (rt >> 1)) * 512 + (rt & 1) * 256 : (e * 17 + 16) * 512 + (rt - 32) * 256;
        u.a = HM + (size_t)rowbase * FE; u.b = W + (size_t)e * (D * FE) + (size_t)ct * (256 * FE); u.orow = rowbase; u.ocol = ct * 256; u.idx = nullptr; return true; }
};
}
namespace att {
constexpr int NW = 8, QBLK = 32, KVBLK = 64, LDZ = INW;
constexpr float SCALE = 0.125f, THR = 8.f;
#ifndef ATT_SDEPTH
#define ATT_SDEPTH 2
#endif
constexpr int SDEPTH = ATT_SDEPTH;
constexpr int SHM_V = KVBLK * 128 * 2, SHM_K = KVBLK * 64 * 2;
#ifndef ATT_RING3
#define ATT_RING3 1
#endif
constexpr int NBUF = ATT_RING3 ? 3 : 2;
constexpr int OFF_V = 0, OFF_K = NBUF * SHM_V, OFF_WS = OFF_K + NBUF * SHM_K, ATT_LDS = OFF_WS + NW * 64 * 4;
#define KSWZ(row, colB) ((row) * 128 + ((colB) ^ ((((row) >> 1) & 7) << 4)))
#define SBAR() __builtin_amdgcn_sched_barrier(0)
__device__ __forceinline__ int crow(int r, int hi) { return (r & 3) + 8 * (r >> 2) + 4 * hi; }
__device__ __forceinline__ void partialSM(f32x16& p0, f32x16& p1, float& m_reg, float& mn, float& alpha) {
  constexpr float C = SCALE * 1.4426950408889634f;
  float pmax = p0[0];
#pragma unroll
  for (int r = 1; r < 16; ++r) pmax = fmaxf(pmax, p0[r]);
#pragma unroll
  for (int r = 0; r < 16; ++r) pmax = fmaxf(pmax, p1[r]);
  { unsigned r0, r1; swap32(__float_as_uint(pmax), r0, r1); pmax = fmaxf(__uint_as_float(r0), __uint_as_float(r1)); }
  if (__builtin_expect(__all(pmax - m_reg <= THR / SCALE), 1)) { mn = m_reg; alpha = 1.f; }
  else { mn = fmaxf(m_reg, pmax); alpha = __builtin_amdgcn_exp2f((m_reg - mn) * C); m_reg = mn; }
  float mnC = -mn * C;
#pragma unroll
  for (int r = 0; r < 16; ++r) p0[r] = fmaf(p0[r], C, mnC);
#pragma unroll
  for (int r = 0; r < 16; ++r) p1[r] = fmaf(p1[r], C, mnC);
#ifndef ABL_NOEXP
#pragma unroll
  for (int r = 0; r < 16; ++r) p0[r] = __builtin_amdgcn_exp2f(p0[r]);
#endif
}
__device__ __forceinline__ void finishSM(f32x16& p0, f32x16& p1, float alpha, float& l_reg, bf16x8& pa0, bf16x8& pa1, bf16x8& pa2, bf16x8& pa3) {
#ifndef ABL_NOEXP
#pragma unroll
  for (int r = 0; r < 16; ++r) p1[r] = __builtin_amdgcn_exp2f(p1[r]);
#endif
  float ps = 0;
#pragma unroll
  for (int r = 0; r < 16; ++r) ps += p0[r];
#pragma unroll
  for (int r = 0; r < 16; ++r) ps += p1[r];
  { unsigned r0, r1; swap32(__float_as_uint(ps), r0, r1); ps = __uint_as_float(r0) + __uint_as_float(r1); }
  l_reg = l_reg * alpha + ps;
#define PK4(P, BASE, OUT) do { unsigned a0 = cvt_pk_bf16(P[BASE + 0], P[BASE + 1]), a1 = cvt_pk_bf16(P[BASE + 2], P[BASE + 3]);   \
    unsigned b0 = cvt_pk_bf16(P[BASE + 4], P[BASE + 5]), b1 = cvt_pk_bf16(P[BASE + 6], P[BASE + 7]);                              \
    auto r0 = __builtin_amdgcn_permlane32_swap(a0, b0, false, false); auto r1 = __builtin_amdgcn_permlane32_swap(a1, b1, false, false); \
    u32x4 w = {r0[0], r1[0], r0[1], r1[1]}; OUT = __builtin_bit_cast(bf16x8, w); } while (0)
  PK4(p0, 0, pa0); PK4(p0, 8, pa1); PK4(p1, 0, pa2); PK4(p1, 8, pa3);
#undef PK4
}
__device__ __forceinline__ void qkt(f32x16& p0, f32x16& p1, const LAS char* Ks, const bf16x8* qr, int r32, int hi) {
#pragma unroll
  for (int r = 0; r < 16; ++r) { p0[r] = 0.f; p1[r] = 0.f; }
#pragma unroll
  for (int d0 = 0; d0 < 4; ++d0) { const int cb = (d0 * 16 + hi * 8) * 2;
    bf16x8 b0 = *(const LAS bf16x8*)(Ks + KSWZ(r32, cb));
    bf16x8 b1 = *(const LAS bf16x8*)(Ks + KSWZ(32 + r32, cb));
    p0 = __builtin_amdgcn_mfma_f32_32x32x16_bf16(b0, qr[d0], p0, 0, 0, 0);
    p1 = __builtin_amdgcn_mfma_f32_32x32x16_bf16(b1, qr[d0], p1, 0, 0, 0); }
}
__device__ __forceinline__ int v_st(int k, int c) { const int kk = (k & ~0xC) | ((k & 4) << 1) | ((k & 8) >> 1); return ((kk >> 3) * 4 + (c >> 5)) * 512 + ((kk & 7) * 32 + (c & 31)) * 2; }
__device__ __forceinline__ int v_rd_base(int lane) { return ((lane & 3) << 3) | (((lane >> 2) & 3) << 6) | (((lane >> 4) & 1) << 5) | (((lane >> 5) & 1) << 8); }
constexpr int v_rd_off(int d0, int ks, int half) { return d0 * 512 + ks * 4096 + half * 2048; }
template <int OFF> __device__ __forceinline__ s16x4 tr_read(int vb) {
  s16x4 r; asm volatile("ds_read_b64_tr_b16 %0, %1 offset:%2" : "=&v"(r) : "v"(vb), "i"(OFF) : "memory"); return r;
}
template <int D0> __device__ __forceinline__ void pv_one(f32x16& od, int vb, bf16x8 pa0, bf16x8 pa1, bf16x8 pa2, bf16x8 pa3) {
  const s16x4 l0 = tr_read<v_rd_off(D0, 0, 0)>(vb), h0 = tr_read<v_rd_off(D0, 0, 1)>(vb), l1 = tr_read<v_rd_off(D0, 1, 0)>(vb), h1 = tr_read<v_rd_off(D0, 1, 1)>(vb);
  const s16x4 l2 = tr_read<v_rd_off(D0, 2, 0)>(vb), h2 = tr_read<v_rd_off(D0, 2, 1)>(vb), l3 = tr_read<v_rd_off(D0, 3, 0)>(vb), h3 = tr_read<v_rd_off(D0, 3, 1)>(vb);
  asm volatile("s_waitcnt lgkmcnt(0)" ::: "memory"); SBAR();
#define PK(L, H) (bf16x8){L[0], L[1], L[2], L[3], H[0], H[1], H[2], H[3]}
  od = __builtin_amdgcn_mfma_f32_32x32x16_bf16(pa0, PK(l0, h0), od, 0, 0, 0);
  od = __builtin_amdgcn_mfma_f32_32x32x16_bf16(pa1, PK(l1, h1), od, 0, 0, 0);
  od = __builtin_amdgcn_mfma_f32_32x32x16_bf16(pa2, PK(l2, h2), od, 0, 0, 0);
  od = __builtin_amdgcn_mfma_f32_32x32x16_bf16(pa3, PK(l3, h3), od, 0, 0, 0);
#undef PK
}
__device__ __forceinline__ void pv_d0(f32x16* o, int vb, bf16x8 pa0, bf16x8 pa1, bf16x8 pa2, bf16x8 pa3) {
  pv_one<0>(o[0], vb, pa0, pa1, pa2, pa3); pv_one<1>(o[1], vb, pa0, pa1, pa2, pa3); pv_one<2>(o[2], vb, pa0, pa1, pa2, pa3); pv_one<3>(o[3], vb, pa0, pa1, pa2, pa3);
}

__device__ __forceinline__ void diff_attn_unit(const bf16_t* __restrict__ Z, bf16_t* __restrict__ CC, float* o1s, const float* __restrict__ gvec, float lam, float gsc,
                                               int qrow0, int h, int seg0, int n0, int seg1, int NT, LAS char* lds, int tid) {
  asm volatile("" : "+v"(tid));
  const int wid = tid >> 6, lane = tid & 63, r32 = lane & 31, hi = lane >> 5;
  LAS char* V_lds = lds + OFF_V; LAS char* K_lds = lds + OFF_K;
  LAS float* ws = (LAS float*)(lds + OFF_WS) + wid * 64; LAS float* li_l = ws; LAS float* al_l = ws + 32;
  const int sr = tid >> 4, sc = (tid & 15) * 8, vst0 = v_st(sr, sc), vst1 = v_st(32 + sr, sc);
  const int kr = tid >> 3, kc = (tid & 7) * 8, kst = KSWZ(kr, kc * 2);
  const int vb0 = (int)(uintptr_t)V_lds + v_rd_base(lane);
  const bf16_t* Vcol = Z + 1024 + h * 128 + sc;
  for (int mp = 0; mp < 2; ++mp) {
    __syncthreads();
    const bf16_t* Kcol = Z + 512 + h * 128 + mp * 64 + kc;
    float m_reg = -1e30f, l_reg = 0; f32x16 o[4]; bf16x8 qr[4];
#pragma unroll
    for (int d = 0; d < 4; ++d)
#pragma unroll
      for (int r = 0; r < 16; ++r) o[d][r] = 0.f;
    const bf16_t* Qw = Z + (size_t)(qrow0 + wid * QBLK + r32) * LDZ + h * 128 + mp * 64 + hi * 8;
#pragma unroll
    for (int d0 = 0; d0 < 4; ++d0) qr[d0] = *(const bf16x8*)(Qw + d0 * 16);
    struct { bf16x8 vs0, vs1, ks; } sr_[SDEPTH];
#define TROW(j) ((j) < n0 ? seg0 + (j) * KVBLK : seg1 + ((j) - n0) * KVBLK)
#define SLOAD(i, j) do { const int _k0 = TROW(j); sr_[i].vs0 = *(const bf16x8*)(Vcol + (size_t)(_k0 + sr) * LDZ); sr_[i].vs1 = *(const bf16x8*)(Vcol + (size_t)(_k0 + 32 + sr) * LDZ); \
    sr_[i].ks = *(const bf16x8*)(Kcol + (size_t)(_k0 + kr) * LDZ); } while (0)
#define SWRITE(b, i) do { *(LAS bf16x8*)(V_lds + (b) * SHM_V + vst0) = sr_[i].vs0; *(LAS bf16x8*)(V_lds + (b) * SHM_V + vst1) = sr_[i].vs1; \
    *(LAS bf16x8*)(K_lds + (b) * SHM_K + kst) = sr_[i].ks; } while (0)
#define SWAIT() do { if constexpr (SDEPTH == 2) asm volatile("s_waitcnt vmcnt(3)" ::: "memory"); else asm volatile("s_waitcnt vmcnt(0)" ::: "memory"); } while (0)
#define RESC(a) do { if (__any((a) < 1.f)) { if (hi == 0) al_l[r32] = (a); asm volatile("s_waitcnt lgkmcnt(0)" ::: "memory"); \
    _Pragma("unroll") for (int d = 0; d < 4; ++d) _Pragma("unroll") for (int r = 0; r < 16; ++r) o[d][r] *= al_l[crow(r, hi)]; } } while (0)
    f32x16 pA0, pA1, pB0, pB1; float mnA, mnB, alA, alB; bf16x8 pa0, pa1, pa2, pa3;
    constexpr int SE = 0, SO = SDEPTH - 1;
    SLOAD(SE, 0); asm volatile("s_waitcnt vmcnt(0)" ::: "memory"); SWRITE(0, SE); __syncthreads();
    qkt(pA0, pA1, K_lds, qr, r32, hi); partialSM(pA0, pA1, m_reg, mnA, alA);
    SLOAD(SO, 1); if constexpr (SDEPTH == 2) { if (2 < NT) SLOAD(SE, 2); }
    SWAIT(); SWRITE(1, SO); __syncthreads();
#if ATT_RING3
    int b0 = 0, b1 = 1, b2 = 2;
    for (int j = 1; j + 1 < NT; j += 2) {
      SBAR(); qkt(pB0, pB1, K_lds + b1 * SHM_K, qr, r32, hi);
      finishSM(pA0, pA1, alA, l_reg, pa0, pa1, pa2, pa3); SBAR();
      SLOAD(SO, j + SDEPTH); SBAR();
      pv_d0(o, vb0 + b0 * SHM_V, pa0, pa1, pa2, pa3); partialSM(pB0, pB1, m_reg, mnB, alB);
      SWAIT(); SWRITE(b2, SE);
      RESC(alB); __syncthreads();
      SBAR(); qkt(pA0, pA1, K_lds + b2 * SHM_K, qr, r32, hi);
      finishSM(pB0, pB1, alB, l_reg, pa0, pa1, pa2, pa3); SBAR();
      if (SDEPTH == 1 || j + 3 < NT) SLOAD(SE, j + 1 + SDEPTH); SBAR();
      pv_d0(o, vb0 + b1 * SHM_V, pa0, pa1, pa2, pa3); partialSM(pA0, pA1, m_reg, mnA, alA);
      SWAIT(); SWRITE(b0, SO);
      RESC(alA); __syncthreads();
      { const int t0_ = b0; b0 = b2; b2 = b1; b1 = t0_; }
    }
    SBAR(); qkt(pB0, pB1, K_lds + b1 * SHM_K, qr, r32, hi);
    finishSM(pA0, pA1, alA, l_reg, pa0, pa1, pa2, pa3); SBAR();
    pv_d0(o, vb0 + b0 * SHM_V, pa0, pa1, pa2, pa3); partialSM(pB0, pB1, m_reg, mnB, alB);
    RESC(alB);
    finishSM(pB0, pB1, alB, l_reg, pa0, pa1, pa2, pa3); SBAR();
    pv_d0(o, vb0 + b1 * SHM_V, pa0, pa1, pa2, pa3);
#else
    for (int j = 1; j + 1 < NT; j += 2) {
      SBAR(); qkt(pB0, pB1, K_lds + SHM_K, qr, r32, hi);
      finishSM(pA0, pA1, alA, l_reg, pa0, pa1, pa2, pa3); SBAR();
      SLOAD(SO, j + SDEPTH); SBAR();
      pv_d0(o, vb0, pa0, pa1, pa2, pa3); partialSM(pB0, pB1, m_reg, mnB, alB);
      __syncthreads(); SWAIT(); SWRITE(0, SE);
      RESC(alB); __syncthreads();
      SBAR(); qkt(pA0, pA1, K_lds, qr, r32, hi);
      finishSM(pB0, pB1, alB, l_reg, pa0, pa1, pa2, pa3); SBAR();
      if (SDEPTH == 1 || j + 3 < NT) SLOAD(SE, j + 1 + SDEPTH); SBAR();
      pv_d0(o, vb0 + SHM_V, pa0, pa1, pa2, pa3); partialSM(pA0, pA1, m_reg, mnA, alA);
      __syncthreads(); SWAIT(); SWRITE(1, SO);
      RESC(alA); __syncthreads();
    }
    SBAR(); qkt(pB0, pB1, K_lds + SHM_K, qr, r32, hi);
    finishSM(pA0, pA1, alA, l_reg, pa0, pa1, pa2, pa3); SBAR();
    pv_d0(o, vb0, pa0, pa1, pa2, pa3); partialSM(pB0, pB1, m_reg, mnB, alB);
    __syncthreads(); RESC(alB);
    finishSM(pB0, pB1, alB, l_reg, pa0, pa1, pa2, pa3); SBAR();
    pv_d0(o, vb0 + SHM_V, pa0, pa1, pa2, pa3);
#endif
    if (hi == 0) li_l[r32] = l_reg; asm volatile("s_waitcnt lgkmcnt(0)" ::: "memory");
    float rli[16];
#pragma unroll
    for (int r = 0; r < 16; ++r) rli[r] = __builtin_amdgcn_rcpf(li_l[crow(r, hi)]);
    float* op = o1s + tid * 64;
    if (mp == 0) {
#pragma unroll
      for (int d0 = 0; d0 < 4; ++d0)
#pragma unroll
        for (int r4 = 0; r4 < 4; ++r4) *(f32x4*)(op + d0 * 16 + r4 * 4) = (f32x4){o[d0][4 * r4] * rli[4 * r4], o[d0][4 * r4 + 1] * rli[4 * r4 + 1], o[d0][4 * r4 + 2] * rli[4 * r4 + 2], o[d0][4 * r4 + 3] * rli[4 * r4 + 3]};
    } else {
      float ss[16];
#pragma unroll
      for (int r = 0; r < 16; ++r) ss[r] = 0.f;
#pragma unroll
      for (int d0 = 0; d0 < 4; ++d0)
#pragma unroll
        for (int r4 = 0; r4 < 4; ++r4) { const f32x4 o1 = __builtin_nontemporal_load((const f32x4*)(op + d0 * 16 + r4 * 4));
#pragma unroll
          for (int k = 0; k < 4; ++k) { const int r = 4 * r4 + k; const float v = o1[k] - lam * (o[d0][r] * rli[r]); o[d0][r] = v; ss[r] += v * v; } }
#pragma unroll
      for (int r = 0; r < 16; ++r) {
        ss[r] = row32_sum(ss[r]);
        ss[r] = __builtin_amdgcn_rsqf(ss[r] * (1.0f / 128.0f) + RMS_EPS) * gsc; }
      float gg[4];
#pragma unroll
      for (int d0 = 0; d0 < 4; ++d0) gg[d0] = gvec[h * 128 + d0 * 32 + r32];
      bf16_t* Ow = CC + (size_t)(qrow0 + wid * QBLK) * D + h * 128 + r32;
#pragma unroll
      for (int r = 0; r < 16; ++r) { int roff = crow(r, hi) * D; asm volatile("" : "+v"(roff)); bf16_t* rp = Ow + roff;
#pragma unroll
        for (int d0 = 0; d0 < 4; ++d0) rp[d0 * 32] = (bf16_t)f2bf(o[d0][r] * ss[r] * gg[d0]); }
    }
#undef TROW
#undef SLOAD
#undef SWRITE
#undef SWAIT
#undef RESC
  }
}
#undef KSWZ
}
struct Args { const float* in[28]; float* out; unsigned char* ws; int ph_lo, ph_hi, li, pad; };
struct Frame {
    LAS unsigned char* lds;
    int tid, lane, wave, vcu, G;
    unsigned char* ws;
};
enum { I_X = 0, I_C, I_CTX, I_CCTX, I_WMOD, I_BMOD, I_WIN, I_LQ1, I_LK1, I_LQ2, I_LK2, I_ANG, I_CONVW, I_CONVB, I_LWA, I_LBA, I_LWX, I_LBX, I_LLAM, I_WOUT,
       I_LN1G, I_LN1B, I_WR, I_WG, I_WU, I_WD, I_LN2G, I_LN2B };

__device__ __forceinline__ void transpose_item(const float* W, int N, bf16_t* WT, int ldt, LAS float* scr, int kb, int nb, int lane) {
    const int k0 = 64 * kb, n0 = 32 * nb;
#pragma unroll 8
    for (int i = 0; i < 32; ++i) { const int kk = 2 * i + (lane >> 5); scr[kk * 33 + (lane & 31)] = W[(size_t)(k0 + kk) * N + n0 + (lane & 31)]; }
    LDS_WAIT(); asm volatile("" ::: "memory");
    const int c = lane & 7;
#pragma unroll
    for (int j = 0; j < 4; ++j) { const int n = (lane >> 3) + 8 * j; const LAS float* s = scr + (8 * c) * 33 + n;
        u32x4 o; o.x = pk2(s[0 * 33], s[1 * 33]); o.y = pk2(s[2 * 33], s[3 * 33]); o.z = pk2(s[4 * 33], s[5 * 33]); o.w = pk2(s[6 * 33], s[7 * 33]);
        *(u32x4*)(WT + (size_t)(n0 + n) * ldt + k0 + 8 * c) = o; }
    LDS_WAIT(); asm volatile("" ::: "memory");
}

__device__ __forceinline__ void p0a(Frame& F, const Args& args) {
    const int gw = F.vcu * NWAVES + F.wave, NGW = F.G * NWAVES;
    LAS float* scr = (LAS float*)(F.lds + F.wave * 16384);
    { constexpr int IA = 16 * 72, IB = 16 * 32, PER = IA + IB;
      for (int it = gw; it < DEPTH * PER; it += NGW) { const int l = it / PER, r = it - l * PER;
        if (r < IA) transpose_item(args.in[I_WIN] + (size_t)l * D * INW, INW, (bf16_t*)(F.ws + WS_WIN) + (size_t)l * INW * D, D, scr, r / 72, r % 72, F.lane);
        else { const int r2 = r - IA; transpose_item(args.in[I_WOUT] + (size_t)l * D * D, D, (bf16_t*)(F.ws + WS_WOUT) + (size_t)l * D * D, D, scr, r2 / 32, r2 % 32, F.lane); } } }
    __syncthreads();
    { LAS float* sl = (LAS float*)F.lds;
      LAS float* cmb = sl + 17 * 1024;
      bool loaded = false;
      for (int it = F.vcu; it < DEPTH * 24; it += F.G) {
        if (!loaded) { for (int i = F.tid; i < 17 * 1024; i += NTHR) { const float c = (i < 16 * 1024) ? args.in[I_C][i] : args.in[I_CCTX][i - 16 * 1024]; sl[i] = c * fast_sigmoid(c); } loaded = true; }
        __syncthreads();
        const int l = it / 24, nb = it % 24, col = nb * 256 + (F.tid & 255), kh = F.tid >> 8;
        const float* wp = args.in[I_WMOD] + (size_t)l * D * 6144 + (size_t)(kh * 512) * 6144 + col;
        float acc[17];
#pragma unroll
        for (int j = 0; j < 17; ++j) acc[j] = 0.f;
        const float* wq = wp; float w0 = wq[0], w1 = wq[6144], w2 = wq[2 * 6144], w3 = wq[3 * 6144];
#pragma unroll 1
        for (int k = 0; k < 512; k += 4) {
            wq += 4 * 6144; const bool more = (k + 4 < 512);
            const float n0 = more ? wq[0] : 0.f, n1 = more ? wq[6144] : 0.f, n2 = more ? wq[2 * 6144] : 0.f, n3 = more ? wq[3 * 6144] : 0.f;
#pragma unroll
            for (int j = 0; j < 17; ++j) { const f32x4 s = *(const LAS f32x4*)(sl + j * 1024 + kh * 512 + k); acc[j] += s[0] * w0 + s[1] * w1 + s[2] * w2 + s[3] * w3; }
            w0 = n0; w1 = n1; w2 = n2; w3 = n3; }
        if (kh == 1) {
#pragma unroll
            for (int j = 0; j < 17; ++j) cmb[j * 256 + (F.tid & 255)] = acc[j]; }
        __syncthreads();
        if (kh == 0) { const float bm = args.in[I_BMOD][l * 6144 + col]; float* mo = (float*)(F.ws + WS_MOD) + (size_t)l * 17 * 6144 + col;
#pragma unroll
            for (int j = 0; j < 17; ++j) mo[(size_t)j * 6144] = acc[j] + cmb[j * 256 + (F.tid & 255)] + bm; }
        __syncthreads(); } }
    __syncthreads();
    { LAS f32x2* tab = (LAS f32x2*)F.lds;
      for (int r = F.tid; r < 4096; r += NTHR) { float s, c; sincospif((float)r * (1.0f / 2048.0f), &s, &c); tab[r] = (f32x2){c, s}; }
      __syncthreads();
      bf16_t* AT = (bf16_t*)(F.ws + WS_AT);
      for (int k = F.vcu; k < 2048; k += F.G) {
        for (int c8 = F.tid; c8 < 1024; c8 += NTHR) { const int half = c8 >> 9, t0 = (c8 & 511) * 8; unsigned w[4];
#pragma unroll
            for (int q = 0; q < 4; ++q) { const f32x2 e0 = tab[(k * (t0 + 2 * q)) & 4095], e1 = tab[(k * (t0 + 2 * q + 1)) & 4095];
                w[q] = half ? pk2(-e0.y * (1.f / 64.f), -e1.y * (1.f / 64.f)) : pk2(e0.x * (1.f / 64.f), e1.x * (1.f / 64.f)); }
            *(u32x4*)(AT + (size_t)k * 8192 + half * 4096 + t0) = (u32x4){w[0], w[1], w[2], w[3]}; } }
      bf16_t* AC = (bf16_t*)(F.ws + WS_SMALL + SM_AC);
      for (int i = gw * 64 + F.lane; i < 256 * 512; i += NGW * 64) { const int k = i >> 9, c = i & 511, half = c >> 8, t = c & 255; const f32x2 e = tab[((k * t) & 255) * 16];
        AC[i] = (bf16_t)f2bf(half ? -e.y * (1.f / 16.f) : e.x * (1.f / 16.f)); }
      bf16_t* DC = (bf16_t*)(F.ws + WS_SMALL + SM_DC);
      for (int i = gw * 64 + F.lane; i < 512 * 256; i += NGW * 64) { const int r = i >> 8, col = i & 255, p = r >> 8, g = (r >> 6) & 3, cp = r & 63, g2 = col >> 6, c = col & 63;
        const f32x2 e = tab[((c * cp) & 63) * 64]; DC[i] = (bf16_t)((g == g2) ? f2bf((p ? e.y : e.x) * 0.125f) : 0u); }
    }
    { bf16_t* LW = (bf16_t*)(F.ws + WS_SMALL + SM_LRUW);
      for (int i = gw * 64 + F.lane; i < 4 * 2 * 2 * 4 * 4096; i += NGW * 64) { const int k = i & 63, n = (i >> 6) & 63, blk = (i >> 12) & 3, gate = (i >> 14) & 1, ld = i >> 15;
        const float* src = (gate ? args.in[I_LWX] : args.in[I_LWA]) + ((size_t)(ld * 4 + blk) * 64 + k) * 64 + n; LW[i] = (bf16_t)f2bf(*src); } }
    if (F.vcu == 0 && F.wave == 0) { float* lamv = (float*)(F.ws + WS_SMALL + SM_LAM);
      for (int l = 0; l < DEPTH; ++l) { const float a = wave_sum(args.in[I_LQ1][l * 64 + F.lane] * args.in[I_LK1][l * 64 + F.lane]), b = wave_sum(args.in[I_LQ2][l * 64 + F.lane] * args.in[I_LK2][l * 64 + F.lane]);
        const float li = 0.8f - 0.6f * expf(-0.3f * (float)l); if (F.lane == 0) lamv[l] = expf(a) - expf(b) + li; } }
    __syncthreads();
}

__device__ __forceinline__ void ln_mod_store(const f32x4 (&v)[4], const float* md_sh, const float* md_sc, bf16_t* hrow, int lane) {
    float s = 0.f;
#pragma unroll
    for (int q = 0; q < 4; ++q) s += (v[q][0] + v[q][1]) + (v[q][2] + v[q][3]);
    const float mean = wave_sum(s) * (1.f / D); float s2 = 0.f; f32x4 d[4];
#pragma unroll
    for (int q = 0; q < 4; ++q) { d[q] = v[q] - mean; s2 += (d[q][0] * d[q][0] + d[q][1] * d[q][1]) + (d[q][2] * d[q][2] + d[q][3] * d[q][3]); }
    const float rstd = __builtin_amdgcn_rsqf(wave_sum(s2) * (1.f / D) + LN_EPS);
#pragma unroll
    for (int q = 0; q < 4; ++q) { const int col = 4 * lane + 256 * q; const f32x4 sh = *(const f32x4*)(md_sh + col), sc = *(const f32x4*)(md_sc + col);
        const f32x4 h = d[q] * rstd * (sc + 1.0f) + sh; u32x2 w; w.x = cvt_pk_bf16(h[0], h[1]); w.y = cvt_pk_bf16(h[2], h[3]); *(u32x2*)(hrow + col) = w; }
}
__device__ __forceinline__ void p0b(Frame& F, const Args& args) {
    const int gw = F.vcu * NWAVES + F.wave, NGW = F.G * NWAVES;
    bf16_t* H = (bf16_t*)(F.ws + WS_H); const float* mod = (const float*)(F.ws + WS_MOD);
#define SRCROW(mm) ((mm) < ML ? args.in[I_X] + (size_t)(mm) * D : args.in[I_CTX] + (size_t)((mm) - ML) * D)
    f32x4 vn[4];
    if (gw < M) {
#pragma unroll
        for (int q = 0; q < 4; ++q) vn[q] = *(const f32x4*)(SRCROW(gw) + 4 * F.lane + 256 * q); }
    for (int m = gw; m < M; m += NGW) { const int j = m < ML ? (m >> 12) : 16;
        f32x4 v[4], shp[4], scp[4]; const float* md = mod + (size_t)j * 6144;
#pragma unroll
        for (int q = 0; q < 4; ++q) { v[q] = vn[q]; shp[q] = *(const f32x4*)(md + 4 * F.lane + 256 * q); scp[q] = *(const f32x4*)(md + D + 4 * F.lane + 256 * q); }
        asm volatile("" ::: "memory");
        if (m + NGW < M) {
#pragma unroll
            for (int q = 0; q < 4; ++q) vn[q] = *(const f32x4*)(SRCROW(m + NGW) + 4 * F.lane + 256 * q); }
        asm volatile("" ::: "memory");
        float s = 0.f;
#pragma unroll
        for (int q = 0; q < 4; ++q) s += (v[q][0] + v[q][1]) + (v[q][2] + v[q][3]);
        const float mean = wave_sum(s) * (1.f / D); float s2 = 0.f;
#pragma unroll
        for (int q = 0; q < 4; ++q) { v[q] = v[q] - mean; s2 += (v[q][0] * v[q][0] + v[q][1] * v[q][1]) + (v[q][2] * v[q][2] + v[q][3] * v[q][3]); }
        const float rstd = __builtin_amdgcn_rsqf(wave_sum(s2) * (1.f / D) + LN_EPS);
#pragma unroll
        for (int q = 0; q < 4; ++q) { const f32x4 h = v[q] * rstd * (scp[q] + 1.0f) + shp[q]; u32x2 w; w.x = cvt_pk_bf16(h[0], h[1]); w.y = cvt_pk_bf16(h[2], h[3]); *(u32x2*)(H + (size_t)m * D + 4 * F.lane + 256 * q) = w; } }
#undef SRCROW
}

__device__ __forceinline__ void pw_item(const float* W, int N, unsigned char* WT, int ldt, LAS float* scr, int kb, int nb, int tid, float scale) {
    const int wave = tid >> 6, lane = tid & 63, k0 = 128 * kb, n0 = 256 * nb;
    const float* src = W + (size_t)(k0 + wave * 16) * N + n0 + lane * 4;
#pragma unroll
    for (int i = 0; i < 16; ++i) *(LAS f32x4*)(scr + (wave * 16 + i) * 260 + lane * 4) = *(const f32x4*)(src + (size_t)i * N);
    __syncthreads();
    const int n = tid & 255, kh = tid >> 8; const LAS float* s = scr + (64 * kh) * 260 + n; unsigned char* dst = WT + (size_t)(n0 + n) * ldt + k0 + 64 * kh;
#pragma unroll
    for (int h = 0; h < 4; ++h) { unsigned w[4];
#pragma unroll
        for (int g = 0; g < 4; ++g) { const LAS float* p = s + (16 * h + 4 * g) * 260; w[g] = cvt4_fp8(p[0] * scale, p[260] * scale, p[520] * scale, p[780] * scale); }
        *(u32x4*)(dst + 16 * h) = (u32x4){w[0], w[1], w[2], w[3]}; }
    __syncthreads();
}
__device__ __forceinline__ void pw_experts(Frame& F, const Args& args, int l) {
    LAS float* scr = (LAS float*)F.lds;
    unsigned char* WGU = F.ws + WS_WEXP; unsigned char* WDN = F.ws + WS_WDN;
    for (int it = F.vcu; it < NE * 192; it += F.G) { const int e = it / 192, r = it - e * 192, which = r >> 6, q = r & 63;
        if (which < 2) pw_item(args.in[which ? I_WU : I_WG] + ((size_t)l * NE + e) * D * FE, FE, WGU + ((size_t)e * 2 + which) * FE * D, D, scr, q >> 3, q & 7, F.tid, SWG8);
        else pw_item(args.in[I_WD] + ((size_t)l * NE + e) * FE * D, D, WDN + (size_t)e * D * FE, FE, scr, q >> 2, q & 3, F.tid, SWD8); }
}

__device__ __forceinline__ void pe_phase(Frame& F, const Args& args, int l, int nrows) {
    const int gw = F.vcu * NWAVES + F.wave, NGW = F.G * NWAVES;
    LAS f32x4* WR4 = (LAS f32x4*)F.lds;
    { const float* wr = args.in[I_WR] + (size_t)l * D * NE;
      for (int i = F.tid; i < 16 * 4 * 64; i += NTHR) { const int ln = i & 63, e4 = (i >> 6) & 3, qi = i >> 8, q = qi >> 2, ii = qi & 3; WR4[i] = *(const f32x4*)(wr + (size_t)(4 * ln + ii + 256 * q) * NE + 4 * e4); } }
    __syncthreads();
    float* X = (float*)(F.ws + WS_X); const bf16_t* MIX = (const bf16_t*)(F.ws + WS_ZR); unsigned char* H8 = F.ws + WS_H; float* SC = (float*)(F.ws + WS_SC);
    const float* mod = (const float*)(F.ws + WS_MOD) + (size_t)l * 17 * 6144;
    const float* g1p = args.in[I_LN1G] + l * D; const float* b1p = args.in[I_LN1B] + l * D;
    f32x4 xn[4]; u32x2 mn[4];
    const float* Xin0 = (l == 0) ? args.in[I_X] : X; const float* Xin1 = (l == 0) ? args.in[I_CTX] - (size_t)ML * D : X;
#define XROW(mm) (((mm) < ML ? Xin0 : Xin1) + (size_t)(mm) * D)
    if (gw < nrows) {
#pragma unroll
        for (int q = 0; q < 4; ++q) { const int col = 4 * F.lane + 256 * q; xn[q] = *(const f32x4*)(XROW(gw) + col); mn[q] = *(const u32x2*)(MIX + (size_t)gw * D + col); } }
    f32x4 g1r[4], b1r[4];
#pragma unroll
    for (int q = 0; q < 4; ++q) { g1r[q] = *(const f32x4*)(g1p + 4 * F.lane + 256 * q); b1r[q] = *(const f32x4*)(b1p + 4 * F.lane + 256 * q); }
    for (int m = gw; m < nrows; m += NGW) { const int j = m < ML ? (m >> 12) : 16; const float* md = mod + (size_t)j * 6144;
        f32x4 v[4], gm[4], sh2[4], sc2[4]; float s = 0.f;
#pragma unroll
        for (int q = 0; q < 4; ++q) { const int col = 4 * F.lane + 256 * q; gm[q] = *(const f32x4*)(md + 2 * D + col); }
#pragma unroll
        for (int q = 0; q < 4; ++q) { const int col = 4 * F.lane + 256 * q; sh2[q] = *(const f32x4*)(md + 3 * D + col); sc2[q] = *(const f32x4*)(md + 4 * D + col); }
#pragma unroll
        for (int q = 0; q < 4; ++q) { const f32x4 mx4 = (f32x4){bflo(mn[q].x), bfhi(mn[q].x), bflo(mn[q].y), bfhi(mn[q].y)};
            v[q] = xn[q] * DN_ALPHA + gm[q] * mx4; s += (v[q][0] + v[q][1]) + (v[q][2] + v[q][3]); }
        asm volatile("" ::: "memory");
        if (m + NGW < nrows) {
#pragma unroll
            for (int q = 0; q < 4; ++q) { const int col = 4 * F.lane + 256 * q; xn[q] = *(const f32x4*)(XROW(m + NGW) + col); mn[q] = *(const u32x2*)(MIX + (size_t)(m + NGW) * D + col); } }
        asm volatile("" ::: "memory");
        const float mean = wave_sum(s) * (1.f / D); float s2 = 0.f;
#pragma unroll
        for (int q = 0; q < 4; ++q) { v[q] = v[q] - mean; s2 += (v[q][0] * v[q][0] + v[q][1] * v[q][1]) + (v[q][2] * v[q][2] + v[q][3] * v[q][3]); }
        const float rstd = __builtin_amdgcn_rsqf(wave_sum(s2) * (1.f / D) + LN_EPS); s = 0.f;
#pragma unroll
        for (int q = 0; q < 4; ++q) { const int col = 4 * F.lane + 256 * q; v[q] = v[q] * rstd * g1r[q] + b1r[q]; *(f32x4*)(X + (size_t)m * D + col) = v[q];
            s += (v[q][0] + v[q][1]) + (v[q][2] + v[q][3]); }
        const float mean2 = wave_sum(s) * (1.f / D); s2 = 0.f;
#pragma unroll
        for (int q = 0; q < 4; ++q) { v[q] = v[q] - mean2; s2 += (v[q][0] * v[q][0] + v[q][1] * v[q][1]) + (v[q][2] * v[q][2] + v[q][3] * v[q][3]); }
        const float rstd2 = __builtin_amdgcn_rsqf(wave_sum(s2) * (1.f / D) + LN_EPS);
        f32x2 lg2[8];
#pragma unroll
        for (int e = 0; e < 8; ++e) lg2[e] = (f32x2){0.f, 0.f};
#pragma unroll
        for (int q = 0; q < 4; ++q) { const int col = 4 * F.lane + 256 * q;
            const f32x4 h = v[q] * rstd2 * (sc2[q] + 1.0f) + sh2[q]; *(unsigned*)(H8 + (size_t)m * D + col) = cvt4_fp8(clamp448(h[0] * SX8), clamp448(h[1] * SX8), clamp448(h[2] * SX8), clamp448(h[3] * SX8));
#pragma unroll
            for (int ii = 0; ii < 4; ++ii)
#pragma unroll
                for (int e4 = 0; e4 < 4; ++e4) { const f32x4 w4 = WR4[((q * 4 + ii) * 4 + e4) * 64 + F.lane]; const f32x2 hh = (f32x2){h[ii], h[ii]};
                    lg2[e4 * 2] += hh * (f32x2){w4[0], w4[1]}; lg2[e4 * 2 + 1] += hh * (f32x2){w4[2], w4[3]}; } }
        float lg[16];
#pragma unroll
        for (int e = 0; e < 8; ++e) { lg[2 * e] = lg2[e][0]; lg[2 * e + 1] = lg2[e][1]; }
        float r1[8], r2[4];
#pragma unroll
        for (int k = 0; k < 8; ++k) { const float ta = lg[k] + xor32f(lg[k], F.lane < 32), tb = lg[k + 8] + xor32f(lg[k + 8], F.lane < 32); r1[k] = (F.lane & 32) ? tb : ta; }
#pragma unroll
        for (int k = 0; k < 4; ++k) { const float ta = r1[k] + swz16f(r1[k]), tb = r1[k + 4] + swz16f(r1[k + 4]); r2[k] = (F.lane & 16) ? tb : ta; }
        float mx = -1e30f;
#pragma unroll
        for (int k = 0; k < 4; ++k) { float t = r2[k]; t += dppf<0xB1>(t); t += dppf<0x4E>(t); t += dppf<0x141>(t); t += dppf<0x140>(t); r2[k] = t; mx = fmaxf(mx, t); }
        mx = fmaxf(mx, swz16f(mx)); mx = fmaxf(mx, xor32f(mx, F.lane < 32));
        float se = 0.f;
#pragma unroll
        for (int k = 0; k < 4; ++k) { r2[k] = __expf(r2[k] - mx); se += r2[k]; }
        se += swz16f(se); se += xor32f(se, F.lane < 32);
        const float inv = 1.0f / se;
        if ((F.lane & 15) == 0) *(f32x4*)(SC + (size_t)m * NE + 4 * (F.lane >> 4)) = (f32x4){r2[0] * inv, r2[1] * inv, r2[2] * inv, r2[3] * inv}; }
#undef XROW
    __syncthreads();
}

__device__ __forceinline__ int block_sum_i(LAS int* red, int v, int wave, int lane) {
    v = wave_sum_i(v);
    if (lane == 0) red[wave] = v;
    __syncthreads();
    int s = 0;
#pragma unroll
    for (int w = 0; w < 8; ++w) s += red[w];
    return s;
}
__device__ __forceinline__ int lower_lanes(unsigned long long m) { return (int)__builtin_amdgcn_mbcnt_hi((unsigned)(m >> 32), __builtin_amdgcn_mbcnt_lo((unsigned)m, 0u)); }
__device__ __forceinline__ void topk_pair(Frame& F, const float* SC, int* TM, int m0, int n, int e, int cap, int yrow0, LAS int* sel, LAS int* red) {
    unsigned key[8];
#pragma unroll
    for (int k = 0; k < 8; ++k) { const int t = k * NTHR + F.tid; key[k] = (t < n) ? __builtin_bit_cast(unsigned, SC[(size_t)(m0 + t) * NE + e]) : 0u; }
    unsigned v = 0u; int it = 0;
    for (int shift = 28; shift >= -2; shift -= 3, ++it) { const int sh = shift < 0 ? 0 : shift; const unsigned jmax = shift < 0 ? 1u : 7u;
        int c[8];
#pragma unroll
        for (int j = 0; j < 8; ++j) c[j] = 0;
#pragma unroll
        for (int k = 0; k < 8; ++k) { const unsigned t = key[k] >= v ? min((key[k] - v) >> sh, jmax) : 0u;
#pragma unroll
            for (int j = 1; j < 8; ++j) c[j] += (t >= (unsigned)j) ? 1 : 0; }
        int pk[4];
#pragma unroll
        for (int q = 0; q < 4; ++q) pk[q] = wave_sum_i(c[2 * q] | (c[2 * q + 1] << 16));
        LAS int* rb = red + (it & 1) * 32;
        if (F.lane == 0) {
#pragma unroll
            for (int q = 0; q < 4; ++q) rb[F.wave * 4 + q] = pk[q]; }
        __syncthreads();
        int tot[4] = {0, 0, 0, 0};
#pragma unroll
        for (int w = 0; w < 8; ++w)
#pragma unroll
            for (int q = 0; q < 4; ++q) tot[q] += rb[w * 4 + q];
        unsigned best = 0u;
#pragma unroll
        for (int j = 1; j < 8; ++j) { const int cj = (j & 1) ? (tot[j >> 1] >> 16) : (tot[j >> 1] & 0xffff); if (cj >= cap && (unsigned)j <= jmax) best = (unsigned)j; }
        v |= best << sh; }
    LAS int* cgt = red + 64; LAS int* ceq = red + 64 + 64;
    __syncthreads();
    int lg[8], le[8];
#pragma unroll
    for (int k = 0; k < 8; ++k) { const unsigned long long mg = __builtin_amdgcn_ballot_w64(key[k] > v), me = __builtin_amdgcn_ballot_w64(key[k] == v);
        lg[k] = lower_lanes(mg); le[k] = lower_lanes(me);
        if (F.lane == 0) { cgt[k * 8 + F.wave] = __builtin_popcountll(mg); ceq[k * 8 + F.wave] = __builtin_popcountll(me); } }
    __syncthreads();
    int tot_gt = 0;
    for (int i = 0; i < 64; ++i) tot_gt += cgt[i];
    const int need_eq = cap - tot_gt;
    int gb = 0, eb = 0, idx = 0;
#pragma unroll
    for (int k = 0; k < 8; ++k) {
        for (; idx < k * 8 + F.wave; ++idx) { gb += cgt[idx]; eb += ceq[idx]; }
        const int t = k * NTHR + F.tid;
        if (t < n) { const bool gt = key[k] > v, eq = key[k] == v; const int myg = gb + lg[k], mye = eb + le[k];
            const bool selx = gt || (eq && mye < need_eq); const int slot = myg + (mye < need_eq ? mye : need_eq);
            if (selx) sel[slot] = m0 + t;
            TM[(size_t)(m0 + t) * NE + e] = selx ? (yrow0 + slot) : -1; } }
    __syncthreads();
}
__device__ __forceinline__ void pk_phase(Frame& F, bool with_ctx) {
    LAS int* sel = (LAS int*)F.lds; LAS int* red = sel + 512;
    const float* SC = (const float*)(F.ws + WS_SC); int* TM = (int*)(F.ws + WS_TM);
    int* IDXp = (int*)(F.ws + WS_IDX);
    for (int pr = F.vcu; pr < (with_ctx ? 512 : 256); pr += F.G) {
        const bool lat = pr < 256; const int q = lat ? pr : pr - 256, b = q >> 4, e = q & 15;
        const int cap = lat ? CAPL : CAPC, yrow0 = lat ? (e * 17 + b) * 512 : (e * 17 + 16) * 512 + b * CAPC;
        topk_pair(F, SC, TM, lat ? b * T : ML + b * TC, lat ? T : TC, e, cap, yrow0, sel, red);
        for (int s = F.tid; s < cap; s += NTHR) IDXp[yrow0 + s] = sel[s];
        __syncthreads(); }
}

__device__ __forceinline__ void pj_phase(Frame& F, const Args& args, int l, int nrows) {
    const int gw = F.vcu * NWAVES + F.wave, NGW = F.G * NWAVES; const bool last = (l == DEPTH - 1);
    float* X = (float*)(F.ws + WS_X); bf16_t* H = (bf16_t*)(F.ws + WS_H); const float* SC = (const float*)(F.ws + WS_SC); const int* TM = (const int*)(F.ws + WS_TM);
    const unsigned char* Y = F.ws + WS_ZR;
    const float* mod = (const float*)(F.ws + WS_MOD) + (size_t)l * 17 * 6144; const float* modn = mod + 17 * 6144;
    const float* g2p = args.in[I_LN2G] + l * D; const float* b2p = args.in[I_LN2B] + l * D;
    int tmn = -1; float scn = 0.f; f32x4 xnx[4];
    if (gw < nrows) { if (F.lane < 16) { tmn = TM[(size_t)gw * NE + F.lane]; scn = SC[(size_t)gw * NE + F.lane]; }
#pragma unroll
        for (int q = 0; q < 4; ++q) xnx[q] = *(const f32x4*)(X + (size_t)gw * D + 4 * F.lane + 256 * q); }
    f32x4 g2r[4], b2r[4];
#pragma unroll
    for (int q = 0; q < 4; ++q) { g2r[q] = *(const f32x4*)(g2p + 4 * F.lane + 256 * q); b2r[q] = *(const f32x4*)(b2p + 4 * F.lane + 256 * q); }
    for (int m = gw; m < nrows; m += NGW) { const int j = m < ML ? (m >> 12) : 16; const float* md = mod + (size_t)j * 6144; const float* mdn = modn + (size_t)j * 6144;
        const int tmv = tmn; const float scv = scn;
        f32x4 xr[4], g2m[4], shn[4], scq[4];
#pragma unroll
        for (int q = 0; q < 4; ++q) { xr[q] = xnx[q]; g2m[q] = *(const f32x4*)(md + 5 * D + 4 * F.lane + 256 * q); }
        if (!last) {
#pragma unroll
            for (int q = 0; q < 4; ++q) { shn[q] = *(const f32x4*)(mdn + 4 * F.lane + 256 * q); scq[q] = *(const f32x4*)(mdn + D + 4 * F.lane + 256 * q); } }
        unsigned long long mask = __builtin_amdgcn_ballot_w64(tmv >= 0);
        f32x4 a[4];
#pragma unroll
        for (int q = 0; q < 4; ++q) a[q] = (f32x4){0.f, 0.f, 0.f, 0.f};
        bool first = true;
        do {
            int yr[4]; float gg[4];
#pragma unroll
            for (int k = 0; k < 4; ++k) { if (mask) { const int e = __builtin_ctzll(mask); mask &= mask - 1; yr[k] = __builtin_amdgcn_readlane(tmv, e); gg[k] = __builtin_bit_cast(float, __builtin_amdgcn_readlane(__builtin_bit_cast(int, scv), e)); } else { yr[k] = 0; gg[k] = 0.f; } }
            unsigned w[4][4];
#pragma unroll
            for (int k = 0; k < 4; ++k)
#pragma unroll
                for (int q = 0; q < 4; ++q) w[k][q] = *(const unsigned*)(Y + (size_t)yr[k] * D + 4 * F.lane + 256 * q);
            asm volatile("" ::: "memory");
            if (first && m + NGW < nrows) { if (F.lane < 16) { tmn = TM[(size_t)(m + NGW) * NE + F.lane]; scn = SC[(size_t)(m + NGW) * NE + F.lane]; }
#pragma unroll
                for (int q = 0; q < 4; ++q) xnx[q] = *(const f32x4*)(X + (size_t)(m + NGW) * D + 4 * F.lane + 256 * q); }
            first = false;
            asm volatile("" ::: "memory");
#pragma unroll
            for (int k = 0; k < 4; ++k)
#pragma unroll
                for (int q = 0; q < 4; ++q) { const float gs = gg[k] * (1.0f / SY8); a[q][0] += gs * __builtin_amdgcn_cvt_f32_fp8((int)w[k][q], 0); a[q][1] += gs * __builtin_amdgcn_cvt_f32_fp8((int)w[k][q], 1); a[q][2] += gs * __builtin_amdgcn_cvt_f32_fp8((int)w[k][q], 2); a[q][3] += gs * __builtin_amdgcn_cvt_f32_fp8((int)w[k][q], 3); }
        } while (mask);
        f32x4 v[4]; float s = 0.f;
#pragma unroll
        for (int q = 0; q < 4; ++q) { v[q] = xr[q] * DN_ALPHA + g2m[q] * a[q]; s += (v[q][0] + v[q][1]) + (v[q][2] + v[q][3]); }
        const float mean = wave_sum(s) * (1.f / D); float s2 = 0.f;
#pragma unroll
        for (int q = 0; q < 4; ++q) { v[q] = v[q] - mean; s2 += (v[q][0] * v[q][0] + v[q][1] * v[q][1]) + (v[q][2] * v[q][2] + v[q][3] * v[q][3]); }
        const float rstd = __builtin_amdgcn_rsqf(wave_sum(s2) * (1.f / D) + LN_EPS);
        float* dst = last ? args.out + (size_t)m * D : X + (size_t)m * D; s = 0.f;
#pragma unroll
        for (int q = 0; q < 4; ++q) { const int col = 4 * F.lane + 256 * q; v[q] = v[q] * rstd * g2r[q] + b2r[q]; *(f32x4*)(dst + col) = v[q]; s += (v[q][0] + v[q][1]) + (v[q][2] + v[q][3]); }
        if (!last) { const float mean2 = wave_sum(s) * (1.f / D); s2 = 0.f;
#pragma unroll
            for (int q = 0; q < 4; ++q) { v[q] = v[q] - mean2; s2 += (v[q][0] * v[q][0] + v[q][1] * v[q][1]) + (v[q][2] * v[q][2] + v[q][3] * v[q][3]); }
            const float rstd2 = __builtin_amdgcn_rsqf(wave_sum(s2) * (1.f / D) + LN_EPS);
#pragma unroll
            for (int q = 0; q < 4; ++q) { const int col = 4 * F.lane + 256 * q; const f32x4 h = v[q] * rstd2 * (scq[q] + 1.0f) + shn[q]; u32x2 w; w.x = cvt_pk_bf16(h[0], h[1]); w.y = cvt_pk_bf16(h[2], h[3]); *(u32x2*)(H + (size_t)m * D + col) = w; } } }
}
constexpr int LRU_U = 0, LRU_SA = 33280, LRU_SI = LRU_SA + 32768, LRU_HS = LRU_SI + 32768;
static_assert(LRU_HS + 32768 + 5 * 256 * 4 <= PH_LDS, "lru lds");
constexpr int NCHUNK = 2048 + 128;
constexpr size_t WS_AX = WS_HM + 64 * MiB;
template <bool FINAL>
__device__ __forceinline__ void lru_phase(Frame& F, const Args& args, int l, int nunits) {
    const bf16_t* Z = (const bf16_t*)(F.ws + WS_ZR); bf16_t* CC = (bf16_t*)(F.ws + WS_CC);
    f32x2* SUMM = (f32x2*)(F.ws + WS_SUM); const float* CAR = (const float*)(F.ws + WS_CAR); unsigned* AX = (unsigned*)(F.ws + WS_AX);
    LAS float* U32 = (LAS float*)(F.lds + LRU_U); LAS float* SA = (LAS float*)(F.lds + LRU_SA); LAS float* SI = (LAS float*)(F.lds + LRU_SI); LAS float* HS = (LAS float*)(F.lds + LRU_HS);
    const int fr = F.lane & 15, fq = F.lane >> 4, dw = F.wave >> 2, blk = F.wave & 3;
    bf16x8 bw[2][4][2];
    { const bf16_t* LW = (const bf16_t*)(F.ws + WS_SMALL + SM_LRUW);
#pragma unroll
      for (int gate = 0; gate < 2; ++gate)
#pragma unroll
        for (int nt = 0; nt < 4; ++nt)
#pragma unroll
          for (int s = 0; s < 2; ++s) bw[gate][nt][s] = *(const bf16x8*)(LW + ((size_t)((((l * 2 + dw) * 2 + gate) * 4 + blk) * 64 + 16 * nt + fr)) * 64 + 32 * s + 8 * fq); }
    float gba[4], gbx[4], gsp[4];
#pragma unroll
    for (int nt = 0; nt < 4; ++nt) { const int ch = blk * 64 + 16 * nt + fr, o = (l * 2 + dw) * 256 + ch; gba[nt] = args.in[I_LBA][o]; gbx[nt] = args.in[I_LBX][o]; gsp[nt] = log1pf(expf(-args.in[I_LLAM][o])); }
    const float* cw = args.in[I_CONVW] + l * 4 * 256; const float* cb = args.in[I_CONVB] + l * 256;
    const int dt = F.tid >> 8, cht = F.tid & 255;
    const int ctt = F.tid >> 5, cch0 = (F.tid & 31) * 8;
    LAS float* CW = (LAS float*)(F.lds + LRU_HS + 32768);
    for (int i = F.tid; i < 5 * 256; i += NTHR) CW[i] = (i < 1024) ? cw[i] : cb[i - 1024];
    __syncthreads();
    u32x4 zr[2][4];
#define LRU_DECODE(u_, m0_, sl_, t0_) do { if ((u_) < 2048) { m0_ = ((u_) >> 7) * T; sl_ = T; t0_ = ((u_) & 127) * 32; } else { const int u2_ = (u_) - 2048; m0_ = ML + (u2_ >> 3) * TC; sl_ = TC; t0_ = (u2_ & 7) * 32; } } while (0)
#define LRU_ZLOAD(u_) do { int m0_, sl_, t0_; LRU_DECODE(u_, m0_, sl_, t0_); _Pragma("unroll") for (int hh = 0; hh < 2; ++hh) _Pragma("unroll") for (int j = 0; j < 4; ++j) { const int ts = t0_ + ctt + 16 * hh + j - 2; \
        zr[hh][j] = (ts >= 0 && ts < sl_) ? *(const u32x4*)(Z + (size_t)(m0_ + ts) * INW + 1536 + cch0) : (u32x4){0u, 0u, 0u, 0u}; } } while (0)
    if (F.vcu < nunits) LRU_ZLOAD(F.vcu);
    for (int uidx = F.vcu; uidx < nunits; uidx += F.G) {
        int m0, seqlen, t0; LRU_DECODE(uidx, m0, seqlen, t0);
        {
#pragma unroll
          for (int hh = 0; hh < 2; ++hh) { const int tk = ctt + 16 * hh; float u[8];
#pragma unroll
            for (int i = 0; i < 8; ++i) u[i] = CW[1024 + cch0 + i];
#pragma unroll
            for (int j = 0; j < 4; ++j) { const u32x4 z = zr[hh][j];
                    const f32x4 wa = *(const LAS f32x4*)(CW + j * 256 + cch0), wb = *(const LAS f32x4*)(CW + j * 256 + cch0 + 4);
                    u[0] += bflo(z.x) * wa[0]; u[1] += bfhi(z.x) * wa[1]; u[2] += bflo(z.y) * wa[2]; u[3] += bfhi(z.y) * wa[3];
                    u[4] += bflo(z.z) * wb[0]; u[5] += bfhi(z.z) * wb[1]; u[6] += bflo(z.w) * wb[2]; u[7] += bfhi(z.w) * wb[3]; }
            *(LAS f32x4*)(U32 + tk * 260 + cch0) = (f32x4){u[0], u[1], u[2], u[3]}; *(LAS f32x4*)(U32 + tk * 260 + cch0 + 4) = (f32x4){u[4], u[5], u[6], u[7]}; } }
        if (uidx + F.G < nunits) LRU_ZLOAD(uidx + F.G);
        __syncthreads();
        float h = FINAL ? CAR[(size_t)uidx * 512 + F.tid] : 0.f, P = 1.f;
#pragma unroll
        for (int j = 0; j < 2; ++j) {
            { const int sc = dw ? 1 - j : j;
              bf16x8 af[2];
#pragma unroll
              for (int s = 0; s < 2; ++s) { const LAS float* up = U32 + (16 * sc + fr) * 260 + blk * 64 + 32 * s + 8 * fq; const f32x4 x0 = *(const LAS f32x4*)up, x1 = *(const LAS f32x4*)(up + 4);
                  u32x4 w; w.x = cvt_pk_bf16(x0[0], x0[1]); w.y = cvt_pk_bf16(x0[2], x0[3]); w.z = cvt_pk_bf16(x1[0], x1[1]); w.w = cvt_pk_bf16(x1[2], x1[3]); af[s] = __builtin_bit_cast(bf16x8, w); }
#pragma unroll
              for (int nt = 0; nt < 4; ++nt) { f32x4 pa = (f32x4){0.f, 0.f, 0.f, 0.f}, px = pa;
#pragma unroll
                for (int s = 0; s < 2; ++s) { pa = __builtin_amdgcn_mfma_f32_16x16x32_bf16(af[s], bw[0][nt][s], pa, 0, 0, 0); px = __builtin_amdgcn_mfma_f32_16x16x32_bf16(af[s], bw[1][nt][s], px, 0, 0, 0); }
                const int ch = blk * 64 + 16 * nt + fr;
#pragma unroll
                for (int i = 0; i < 4; ++i) { const int tk = 4 * fq + i; const float e1 = 1.0f + __expf(-(pa[i] + gba[nt])), e2 = 1.0f + __expf(-(px[i] + gbx[nt])), t12 = __builtin_amdgcn_rcpf(e1 * e2), r = t12 * e2, ig = t12 * e1;
                    const float la = -8.0f * r * gsp[nt], a = __expf(la), mult = __builtin_amdgcn_sqrtf(fmaxf(1.0f - a * a, 0.f)), u = U32[(16 * sc + tk) * 260 + ch];
                    SA[tk * 512 + dw * 256 + ch] = a; SI[tk * 512 + dw * 256 + ch] = mult * ig * u; } } }
            __syncthreads();
            { const int sct = dt ? 1 - j : j;
#pragma unroll
              for (int k = 0; k < 16; ++k) { const int tk = dt ? 15 - k : k; const float a = SA[tk * 512 + F.tid], x = SI[tk * 512 + F.tid]; h = a * h + x; P *= a;
                  if (!FINAL) AX[(size_t)(m0 + t0 + 16 * sct + tk) * 512 + F.tid] = pk2(1.0f - a, x);
                  if (FINAL) { LAS float* hp = HS + (16 * sct + tk) * 256 + cht; *hp = (j == 0) ? h : *hp + h; } } }
            __syncthreads();
        }
        if (!FINAL) SUMM[(size_t)uidx * 512 + F.tid] = (f32x2){P, h};
        else { const int tok = F.tid >> 4, ch0 = (F.tid & 15) * 16; const size_t m = (size_t)(m0 + t0 + tok);
#pragma unroll
            for (int hh = 0; hh < 2; ++hh) { const u32x4 g = *(const u32x4*)(Z + m * INW + 1792 + ch0 + 8 * hh); const unsigned gw_[4] = {g.x, g.y, g.z, g.w}; float y[8];
#pragma unroll
                for (int i = 0; i < 8; ++i) { const float gv = (i & 1) ? bfhi(gw_[i >> 1]) : bflo(gw_[i >> 1]); const float ge = gv * fast_sigmoid(1.5957691216057308f * (gv + 0.044715f * gv * gv * gv));
                    y[i] = HS[tok * 256 + ch0 + 8 * hh + i] * ge; }
                u32x4 w; w.x = cvt_pk_bf16(y[0], y[1]); w.y = cvt_pk_bf16(y[2], y[3]); w.z = cvt_pk_bf16(y[4], y[5]); w.w = cvt_pk_bf16(y[6], y[7]);
                *(u32x4*)(CC + m * D + 512 + ch0 + 8 * hh) = w; }
            __syncthreads(); }
    }
}
#undef LRU_DECODE
#undef LRU_ZLOAD

__device__ __forceinline__ void lru_final(Frame& F, int nunits) {
    const bf16_t* Z = (const bf16_t*)(F.ws + WS_ZR); bf16_t* CC = (bf16_t*)(F.ws + WS_CC);
    const float* CAR = (const float*)(F.ws + WS_CAR); const unsigned* AX = (const unsigned*)(F.ws + WS_AX);
    LAS float* HF = (LAS float*)F.lds; LAS float* HB = HF + 32 * 256;
    const int dt = F.tid >> 8, cht = F.tid & 255;
    unsigned ax[32]; float hin = 0.f;
#define LF_DECODE(u_, m0_, t0_) do { if ((u_) < 2048) { m0_ = ((u_) >> 7) * T; t0_ = ((u_) & 127) * 32; } else { const int u2_ = (u_) - 2048; m0_ = ML + (u2_ >> 3) * TC; t0_ = (u2_ & 7) * 32; } } while (0)
#define LF_LOAD(u_) do { int m0_, t0_; LF_DECODE(u_, m0_, t0_); _Pragma("unroll") for (int k = 0; k < 32; ++k) ax[k] = AX[(size_t)(m0_ + t0_ + (dt ? 31 - k : k)) * 512 + F.tid]; hin = CAR[(size_t)(u_) * 512 + F.tid]; } while (0)
    if (F.vcu < nunits) LF_LOAD(F.vcu);
    for (int uidx = F.vcu; uidx < nunits; uidx += F.G) {
        int m0, t0; LF_DECODE(uidx, m0, t0);
        const int tok = F.tid >> 4, ch0 = (F.tid & 15) * 16; const size_t m = (size_t)(m0 + t0 + tok);
        const u32x4 g0 = *(const u32x4*)(Z + m * INW + 1792 + ch0), g1 = *(const u32x4*)(Z + m * INW + 1792 + ch0 + 8);
        float h = hin; LAS float* hp = (dt ? HB : HF) + cht;
#pragma unroll
        for (int k = 0; k < 32; ++k) { const int tk = dt ? 31 - k : k; const unsigned w = ax[k]; h = (1.0f - bflo(w)) * h + bfhi(w); hp[tk * 256] = h; }
        if (uidx + F.G < nunits) LF_LOAD(uidx + F.G);
        __syncthreads();
        { const unsigned gw_[8] = {g0.x, g0.y, g0.z, g0.w, g1.x, g1.y, g1.z, g1.w};
#pragma unroll
          for (int hh = 0; hh < 2; ++hh) { float y[8];
#pragma unroll
            for (int i = 0; i < 8; ++i) { const unsigned wv = gw_[4 * hh + (i >> 1)]; const float gv = (i & 1) ? bfhi(wv) : bflo(wv); const float ge = gv * fast_sigmoid(1.5957691216057308f * (gv + 0.044715f * gv * gv * gv));
                y[i] = (HF[tok * 256 + ch0 + 8 * hh + i] + HB[tok * 256 + ch0 + 8 * hh + i]) * ge; }
            u32x4 w; w.x = cvt_pk_bf16(y[0], y[1]); w.y = cvt_pk_bf16(y[2], y[3]); w.z = cvt_pk_bf16(y[4], y[5]); w.w = cvt_pk_bf16(y[6], y[7]);
            *(u32x4*)(CC + m * D + 512 + ch0 + 8 * hh) = w; } }
        __syncthreads();
    }
#undef LF_DECODE
#undef LF_LOAD
}
__device__ __forceinline__ void lru_carry(Frame& F) {
    const int gid = (F.vcu - (F.G - NB)) * NTHR + F.tid; if (gid < 0 || gid >= NB * 512) return;
    const f32x2* SUMM = (const f32x2*)(F.ws + WS_SUM); float* CAR = (float*)(F.ws + WS_CAR);
    const int b = gid >> 9, dch = gid & 511, d = dch >> 8; float h = 0.f;
#pragma unroll 1
    for (int s0 = 0; s0 < 136; s0 += 8) { f32x2 sm[8]; int ux[8];
#pragma unroll
        for (int k = 0; k < 8; ++k) { const int s = s0 + k; ux[k] = (s < 8) ? 2048 + b * 8 + (d ? 7 - s : s) : b * 128 + (d ? 127 - (s - 8) : (s - 8)); sm[k] = SUMM[(size_t)ux[k] * 512 + dch]; }
#pragma unroll
        for (int k = 0; k < 8; ++k) { CAR[(size_t)ux[k] * 512 + dch] = h; h = sm[k].x * h + sm[k].y; } }
}

constexpr int CW_F2 = 232000;
constexpr int CW_BAR = 1024, NPH_L = 10, NPHASE = 2 + DEPTH * NPH_L;
__global__ void __launch_bounds__(NTHR, 2) fwd_kernel(Args args) {
    extern __shared__ __attribute__((aligned(16))) unsigned char lds_raw[];
    Frame F;
    F.lds = (LAS unsigned char*)lds_raw;
    int wave_s = __builtin_amdgcn_readfirstlane((int)threadIdx.x >> 6);
    F.tid = threadIdx.x; F.lane = F.tid & 63; F.wave = wave_s;
    F.G = gridDim.x; { const int bx = blockIdx.x; F.vcu = (F.G % 8 == 0) ? (bx % 8) * (F.G / 8) + bx / 8 : bx; }
    F.ws = args.ws;
    volatile LAS unsigned* MISC = (volatile LAS unsigned*)(F.lds + MISC_OFF);
    if (F.tid < 128) MISC[F.tid] = 0u;
    { LAS f32x2* rope = (LAS f32x2*)(F.lds + ROPE_OFF);
      for (int i = F.tid; i < 1024; i += NTHR) { const int pos = i >> 4, j = i & 15; const float inv = exp2f(-(float)j * (13.287712379549449f / 16.0f)); float s, c; sincosf((float)pos * inv, &s, &c); rope[i] = (f32x2){c, s}; } }
    __syncthreads();
    XcdBarrier bar = xcd_barrier_post((unsigned*)(F.ws + WS_CTL) + CW_BAR + args.li * XCD_BAR_WORDS, MISC + 8);
    const int lo = args.ph_lo, hi = args.ph_hi;
#ifndef PHMASK
#define PHMASK 0xFFFFFFFFu
#endif
#define IN(k) (lo <= (k) && (k) < hi)
#define ON(b) ((PHMASK >> (b)) & 1u)
#define SEAM(k) do { if (IN(k) && IN((k) + 1)) { XcdBarrier b2_ = bar; unsigned x_ = b2_.x; asm volatile("" : "+s"(x_)); b2_.x = x_; unsigned* p_ = b2_.bar; asm volatile("" : "+s"(p_)); b2_.bar = p_; xcd_barrier(b2_); } RELAUNDER(); } while (0)
#define RELAUNDER() do { asm volatile("" : "+s"(wave_s)); int l_ = lane_id(); asm volatile("" : "+v"(l_)); F.lane = l_; F.wave = wave_s; F.tid = wave_s * 64 + l_; int v_ = F.vcu; asm volatile("" : "+s"(v_)); F.vcu = v_; size_t z_ = 0; asm volatile("" : "+s"(z_)); F.ws = args.ws + z_;     } while (0)
    LAS unsigned char* lds = F.lds;
    if (IN(0)) p0a(F, args);
    SEAM(0);
    if (IN(1)) p0b(F, args);
    SEAM(1);
    for (int l = 0; l < DEPTH; ++l) {
        RELAUNDER();
        const int pb = 2 + l * NPH_L; const bool last = (l == DEPTH - 1); const int nrows = last ? ML : M;
        const char* wsb = (const char*)F.ws;
        if (IN(pb + 0)) {
            pg8::GemmP g{D, D, D, (size_t)128 * D * 2, (size_t)128 * D * 2};
            pg8::SchedPlain S{9, (M / 256) * 9, F.G, F.vcu, wsb + WS_H, wsb + WS_WIN + (size_t)l * INW * D * 2, (size_t)256 * D * 2, (size_t)256 * D * 2, true};
            pg8::EpiInProj E{(bf16_t*)(F.ws + WS_ZR), (const LAS f32x2*)(F.lds + ROPE_OFF)};
            pg8::gemm_phase<pg8::EpiInProj, pg8::SchedPlain, true>(lds, g, S, E, F.tid);
        }
        SEAM(pb + 0);
        if (IN(pb + 1)) pw_experts(F, args, l);
        if (IN(pb + 1)) lru_phase<false>(F, args, l, NCHUNK);
        if (IN(pb + 1)) {
            pg8::GemmP g{256, 256, INW, (size_t)128 * 256 * 2, (size_t)128 * INW * 2};
            pg8::SchedF1 S{2 * (nrows / 256), F.G, F.vcu, wsb + WS_SMALL + SM_DC, wsb + WS_ZR + 2048 * 2};
            pg8::EpiF1 E{(bf16_t*)(F.ws + WS_GT), (bf16_t*)(F.ws + WS_GTC)};
            pg8::gemm_phase<pg8::EpiF1, pg8::SchedF1, true>(lds, g, S, E, F.tid);
        }
        SEAM(pb + 1);
        if (IN(pb + 2)) lru_carry(F);
        if (IN(pb + 2)) {
            const float lam = ((const float*)(F.ws + WS_SMALL + SM_LAM))[l], gsc = 1.0f - (0.8f - 0.6f * expf(-0.3f * (float)l));
            int bx_ = blockIdx.x; asm volatile("" : "+s"(bx_)); float* o1s = (float*)(F.ws + WS_O1) + (size_t)bx_ * 32768;
            const int nun = 1024 + (last ? 0 : 64);
            for (int u = F.vcu; u < nun; u += F.G) {
                int qrow0, h, seg0, n0, seg1, NT;
                if (u < 1024) { const int b = u >> 6; h = (u >> 4) & 3; qrow0 = b * T + (u & 15) * 256; seg0 = b * T; n0 = 64; seg1 = ML + b * TC; NT = 68; }
                else { const int u2 = u - 1024, b = u2 >> 2; h = u2 & 3; qrow0 = ML + b * TC; seg0 = qrow0; n0 = 4; seg1 = qrow0; NT = 4; }
                att::diff_attn_unit((const bf16_t*)(F.ws + WS_ZR), (bf16_t*)(F.ws + WS_CC), o1s, args.in[I_ANG] + l * 512, lam, gsc, qrow0, h, seg0, n0, seg1, NT, (LAS char*)lds, F.tid);
            }
            __syncthreads();
        }
        SEAM(pb + 2);
        if (IN(pb + 3)) lru_final(F, last ? 2048 : NCHUNK);
        if (IN(pb + 3)) {
            { pg8::GemmP g{4096, 8192, 8192, (size_t)128 * 8192 * 2, (size_t)128 * 8192 * 2};
              pg8::SchedF2H S{F.G, F.vcu, wsb + WS_AT, wsb + WS_GT};
              pg8::EpiF2H E{(float*)(F.ws + WS_HM), (bf16_t*)(F.ws + WS_CC), (unsigned*)(F.ws + WS_CTL) + CW_F2, (unsigned)(l + 1)};
              pg8::gemm_phase<pg8::EpiF2H, pg8::SchedF2H, true>(lds, g, S, E, F.tid); }
            {
              const bf16_t* GT = (const bf16_t*)(F.ws + WS_GT); bf16_t* CC = (bf16_t*)(F.ws + WS_CC);
              for (int pr = F.vcu * NWAVES + F.wave; pr < NB * 256; pr += F.G * NWAVES) { const int b = pr >> 8, cp = pr & 255; const bf16_t* g = GT + ((size_t)(b * 256 + cp) * 2) * 4096 + F.lane * 64; float s = 0.f;
#pragma unroll
                  for (int q = 0; q < 8; ++q) { const u32x4 w = *(const u32x4*)(g + 8 * q); s += (bflo(w.x) - bfhi(w.x)) + (bflo(w.y) - bfhi(w.y)) + (bflo(w.z) - bfhi(w.z)) + (bflo(w.w) - bfhi(w.w)); }
                  s = wave_sum(s) * (1.0f / 64.0f); if (F.lane == 0) CC[(size_t)(b * T + T / 2) * D + 768 + cp] = (bf16_t)f2bf(s); } }
            if (!last) { pg8::GemmP g{512, 512, 512, (size_t)128 * 512 * 2, (size_t)128 * 512 * 2};
              pg8::SchedF2C S{F.G, F.vcu, wsb + WS_SMALL + SM_AC, wsb + WS_GTC};
              pg8::EpiBf16 E{(bf16_t*)(F.ws + WS_CC), D, 1.0f};
              pg8::gemm_phase<pg8::EpiBf16, pg8::SchedF2C, true>(lds, g, S, E, F.tid); }
        }
        SEAM(pb + 3);
        if (IN(pb + 4)) {
            pg8::GemmP g{D, D, D, (size_t)128 * D * 2, (size_t)128 * D * 2};
            pg8::SchedPlain S{4, (nrows / 256) * 4, F.G, F.vcu, wsb + WS_CC, wsb + WS_WOUT + (size_t)l * D * D * 2, (size_t)256 * D * 2, (size_t)256 * D * 2, false};
            pg8::EpiBf16 E{(bf16_t*)(F.ws + WS_ZR), D, 1.0f};
            pg8::gemm_phase<pg8::EpiBf16, pg8::SchedPlain, true>(lds, g, S, E, F.tid);
        }
        SEAM(pb + 4);
        if (IN(pb + 5)) pe_phase(F, args, l, nrows);
        SEAM(pb + 5);
        if (IN(pb + 6)) pk_phase(F, !last);
        SEAM(pb + 6);
        if (IN(pb + 7)) {
            pg8::GemmP g{D / 2, D / 2, D / 2, (size_t)128 * D, (size_t)FE * D};
            pg8::SchedGU S{last ? 32 : 34, F.G, F.vcu, wsb + WS_H, wsb + WS_WEXP, (const int*)(wsb + WS_IDX)};
            pg8::EpiGateUp E{F.ws + WS_HM};
            pg8::gemm_phase<pg8::EpiGateUp, pg8::SchedGU, true, true, true>(lds, g, S, E, F.tid);
        }
        SEAM(pb + 7);
        if (IN(pb + 8)) {
            pg8::GemmP g{FE / 2, FE / 2, FE / 2, (size_t)128 * FE, (size_t)128 * FE};
            pg8::SchedDN S{last ? 32 : 34, F.G, F.vcu, wsb + WS_HM, wsb + WS_WDN};
            pg8::EpiFp8 E{F.ws + WS_ZR, D, SY8 / (SH8 * SWD8)};
            pg8::gemm_phase<pg8::EpiFp8, pg8::SchedDN, true, true>(lds, g, S, E, F.tid);
        }
        SEAM(pb + 8);
        if (IN(pb + 9)) pj_phase(F, args, l, nrows);
        SEAM(pb + 9);
    }
#undef IN
#undef SEAM
}

#ifndef MK_PER_PHASE
#define MK_PER_PHASE 0
#endif
extern "C" void kernel_launch(void* const* d_in, const int* in_sizes, int n_in, void* d_out, int out_size, void* d_ws, size_t ws_size, hipStream_t stream) {
    static int grid = 0;
    if (grid == 0) {
        if (n_in != 28 || in_sizes[0] != ML * D || out_size != ML * D || ws_size < WS_END) { fprintf(stderr, "kernel_launch: unexpected shapes / workspace (n_in %d, ws %zu < %zu)\n", n_in, ws_size, (size_t)WS_END); grid = -1; return; }
        int dev = 0, cus = 0, per_cu = 0;
        if (hipGetDevice(&dev) != hipSuccess || hipDeviceGetAttribute(&cus, hipDeviceAttributeMultiprocessorCount, dev) != hipSuccess) { grid = -1; return; }
        if (hipFuncSetAttribute((const void*)fwd_kernel, hipFuncAttributeMaxDynamicSharedMemorySize, LDS_BYTES) != hipSuccess) { fprintf(stderr, "kernel_launch: hipFuncSetAttribute failed\n"); grid = -1; return; }
        if (hipOccupancyMaxActiveBlocksPerMultiprocessor(&per_cu, (const void*)fwd_kernel, NTHR, LDS_BYTES) != hipSuccess || per_cu < 1) { fprintf(stderr, "kernel_launch: occupancy query says %d\n", per_cu); }
        (void)hipGetLastError();
        grid = cus < 256 ? cus : 256;
    }
    if (grid < 0) return;
    if (hipMemsetAsync((char*)d_ws + WS_CTL, 0, CTL_ZERO_BYTES, stream) != hipSuccess) return;
    Args a{};
    for (int i = 0; i < 28; ++i) a.in[i] = (const float*)d_in[i];
    a.out = (float*)d_out; a.ws = (unsigned char*)d_ws;
#if MK_PER_PHASE
#ifdef DIAG
    hipMemsetAsync((char*)d_ws + WS_DIAG, 0, 256, stream);
#ifndef DIAG_L
#define DIAG_L 0
#endif
#ifndef DIAG_VAL
#define DIAG_VAL -1
#endif
#endif
    for (int p = 0; p < NPHASE; ++p) { a.ph_lo = p; a.ph_hi = p + 1; a.li = p; hipLaunchKernelGGL(fwd_kernel, dim3(grid), dim3(NTHR), LDS_BYTES, stream, a);
#ifdef DIAG
        const int l = (p - 2) / NPH_L, k = (p - 2) % NPH_L; int ids[2] = {-1, -1};
        if (p == 1) ids[0] = 0;
        if (p >= 2 && l == DIAG_L) { if (k == 0) ids[0] = 1; if (k == 2) ids[0] = 2; if (k == 3) { ids[0] = 3; ids[1] = 4; } if (k == 4) ids[0] = 5; if (k == 5) ids[0] = 6; if (k == 6) ids[0] = 7; if (k == 7) ids[0] = 8; if (k == 8) ids[0] = 9; }
        if (p >= 2 && l == 3 && k == 9) ids[0] = 10;
        for (int q = 0; q < 2; ++q) if (ids[q] >= 0) hipLaunchKernelGGL(chk_kernel, dim3(48), dim3(256), 0, stream, a, ids[q], ids[q] == 0 ? 0 : (ids[q] == 10 ? 3 : DIAG_L));
#endif
    }
#ifdef DIAG
    hipLaunchKernelGGL(fin_kernel, dim3(1), dim3(1), 0, stream, a, 16, DIAG_VAL);
#endif
#else
    a.ph_lo = 0; a.ph_hi = NPHASE; a.li = 0; hipLaunchKernelGGL(fwd_kernel, dim3(grid), dim3(NTHR), LDS_BYTES, stream, a);
#endif
}
```

```cpp
#include <hip/hip_runtime.h>
#include <cstdio>
#include <cstdint>

#define GAS __attribute__((address_space(1)))
#define LAS __attribute__((address_space(3)))
typedef unsigned short bf16_t;
typedef short bf16x8 __attribute__((ext_vector_type(8)));
typedef short s16x4 __attribute__((ext_vector_type(4)));
typedef float f32x4 __attribute__((ext_vector_type(4)));
typedef float f32x2 __attribute__((ext_vector_type(2)));
typedef float f32x16 __attribute__((ext_vector_type(16)));
typedef unsigned u32x4 __attribute__((ext_vector_type(4)));
typedef unsigned u32x2 __attribute__((ext_vector_type(2)));
typedef GAS unsigned gu32;
#define RLX_AGENT __ATOMIC_RELAXED, __HIP_MEMORY_SCOPE_AGENT
#define LDS_WAIT() asm volatile("s_waitcnt lgkmcnt(0)" ::: "memory")
#define VM_WAIT() asm volatile("s_waitcnt vmcnt(0)" ::: "memory")

constexpr int D = 1024, NB = 16, T = 4096, TC = 256, DEPTH = 4;
constexpr int ML = NB * T, MC = NB * TC, M = ML + MC;
constexpr int INW = 2304, NE = 16, FE = 2048;
constexpr int CAPL = 512, CAPC = 32;
constexpr int NPAIR = NE * 17;
constexpr float LN_EPS = 1e-5f, RMS_EPS = 1e-6f;
constexpr float DN_ALPHA = 1.6817928305074290f;
constexpr int NWAVES = 8, NTHR = 512;

constexpr size_t MiB = 1u << 20;
constexpr size_t WS_CTL = 0, CTL_ZERO_BYTES = 1 * MiB;
constexpr size_t WS_MOD = 1 * MiB;
constexpr size_t WS_SMALL = 3 * MiB;
constexpr size_t SM_LAM = 0, SM_LRUW = 4096, SM_DC = SM_LRUW + 4 * 2 * 2 * 4 * 4096 * 2, SM_AC = SM_DC + 512 * 256 * 2, SM_END = SM_AC + 256 * 512 * 2;
static_assert(SM_END <= 3 * MiB, "small region");
constexpr size_t WS_WIN = 6 * MiB;
constexpr size_t WS_WOUT = 24 * MiB;
constexpr size_t WS_AT = 32 * MiB;
constexpr size_t WS_WEXP = 96 * MiB;
constexpr size_t WS_WDN = WS_WEXP + 128 * MiB;
constexpr size_t WS_X = 288 * MiB;
constexpr size_t WS_H = 560 * MiB;
constexpr size_t WS_CC = 696 * MiB;
constexpr size_t WS_ZR = 832 * MiB;
constexpr size_t WS_O1 = 1138 * MiB;
constexpr size_t WS_GT = 1170 * MiB;
constexpr size_t WS_GTC = 1234 * MiB;
constexpr size_t WS_SC = 1238 * MiB;
constexpr size_t WS_TM = 1243 * MiB;
constexpr size_t WS_IDX = 1248 * MiB;
constexpr size_t WS_SUM = 1249 * MiB;
constexpr size_t WS_CAR = 1258 * MiB;
constexpr size_t WS_HM = 1270 * MiB;
constexpr size_t WS_END = 1814 * MiB;
static_assert(WS_HM + (size_t)NPAIR * 512 * FE * 2 <= WS_END, "ws map");
static_assert(WS_ZR + (size_t)M * INW * 2 <= WS_O1 && WS_ZR + (size_t)NPAIR * 512 * D * 2 <= WS_O1, "ws map zr");

constexpr int PH_LDS = 147456;
constexpr int ROPE_OFF = PH_LDS;
constexpr int MISC_OFF = ROPE_OFF + 8192;
constexpr int LDS_BYTES = MISC_OFF + 512;

__device__ __forceinline__ unsigned f2bf(float f) { unsigned u = __builtin_bit_cast(unsigned, f); return (u + 0x7fffu + ((u >> 16) & 1u)) >> 16; }
__device__ __forceinline__ unsigned pk2(float lo, float hi) { return f2bf(lo) | (f2bf(hi) << 16); }
__device__ __forceinline__ float bf2f(unsigned short h) { return __builtin_bit_cast(float, (unsigned)h << 16); }
__device__ __forceinline__ float bflo(unsigned w) { return __builtin_bit_cast(float, w << 16); }
__device__ __forceinline__ float bfhi(unsigned w) { return __builtin_bit_cast(float, w & 0xffff0000u); }
__device__ __forceinline__ unsigned cvt_pk_bf16(float lo, float hi) { unsigned r; asm volatile("v_cvt_pk_bf16_f32 %0, %1, %2" : "=v"(r) : "v"(lo), "v"(hi)); return r; }
typedef int v8i __attribute__((ext_vector_type(8)));
__device__ __forceinline__ float clamp448(float x) { return __builtin_amdgcn_fmed3f(x, -448.f, 448.f); }
__device__ __forceinline__ unsigned cvt4_fp8(float a, float b, float c, float d) { int w = 0; w = __builtin_amdgcn_cvt_pk_fp8_f32(a, b, w, false); w = __builtin_amdgcn_cvt_pk_fp8_f32(c, d, w, true); return (unsigned)w; }
__device__ __forceinline__ float fp8_dec(unsigned char b) { return __builtin_amdgcn_cvt_f32_fp8((int)b, 0); }
constexpr float SX8 = 16.f, SWG8 = 128.f, SH8 = 8.f, SWD8 = 512.f, SY8 = 64.f;
__device__ __forceinline__ float fast_sigmoid(float x) { return __builtin_amdgcn_rcpf(1.0f + __expf(-x)); }
__device__ __forceinline__ int lane_id() { int r; asm volatile("v_mbcnt_lo_u32_b32 %0, -1, 0\n\tv_mbcnt_hi_u32_b32 %0, -1, %0" : "=v"(r)); return r; }
template <int CTRL> __device__ __forceinline__ float dppf(float v) { return __builtin_bit_cast(float, __builtin_amdgcn_update_dpp(0, __builtin_bit_cast(int, v), CTRL, 0xF, 0xF, true)); }
template <int CTRL> __device__ __forceinline__ int dppi(int v) { return __builtin_amdgcn_update_dpp(0, v, CTRL, 0xF, 0xF, true); }
__device__ __forceinline__ float swz16f(float v) { return __builtin_bit_cast(float, __builtin_amdgcn_ds_swizzle(__builtin_bit_cast(int, v), 0x401F)); }
__device__ __forceinline__ float row32_sum(float v) {
    v += dppf<0xB1>(v); v += dppf<0x4E>(v); v += dppf<0x141>(v); v += dppf<0x140>(v); v += swz16f(v); return v; }
__device__ __forceinline__ void swap32(unsigned x, unsigned& r0, unsigned& r1) { unsigned y = x; asm volatile("" : "+v"(y)); auto r = __builtin_amdgcn_permlane32_swap(x, y, false, false); r0 = r[0]; r1 = r[1]; }
__device__ __forceinline__ float wave_sum(float v) {
    v = row32_sum(v); unsigned r0, r1; swap32(__builtin_bit_cast(unsigned, v), r0, r1);
    return __builtin_bit_cast(float, r0) + __builtin_bit_cast(float, r1);
}
__device__ __forceinline__ int wave_sum_i(int v) {
    v += dppi<0xB1>(v); v += dppi<0x4E>(v); v += dppi<0x141>(v); v += dppi<0x140>(v); v += __builtin_amdgcn_ds_swizzle(v, 0x401F);
    unsigned r0, r1; swap32((unsigned)v, r0, r1); return (int)r0 + (int)r1;
}
__device__ __forceinline__ float xor32f(float v, bool lo_half) { unsigned r0, r1; swap32(__builtin_bit_cast(unsigned, v), r0, r1); return __builtin_bit_cast(float, lo_half ? r1 : r0); }

#define XB_TMO      128
#define XB_XCNT(j)  (256  + 64 * (j))
#define XB_XSUB(j)  (1280 + 64 * (j))
#define XB_XGEN(j)  (2304 + 64 * (j))
#define XB_TOP      3328
#define XB_TOPGEN   3392
#define XCD_BAR_WORDS 3456
#define XB_SPIN_CAP (1u << 18)
__device__ __forceinline__ unsigned xb_ld(unsigned* p)              { return __hip_atomic_load(p, __ATOMIC_RELAXED, __HIP_MEMORY_SCOPE_AGENT); }
__device__ __forceinline__ unsigned xb_add(unsigned* p, unsigned v) { return __hip_atomic_fetch_add(p, v, __ATOMIC_RELAXED, __HIP_MEMORY_SCOPE_AGENT); }
__device__ __forceinline__ unsigned xb_xcc_id() { return (unsigned)__builtin_amdgcn_s_getreg((3 << 11) | 20) & 0xFu; }
#define XB_SPIN(cond, bar) do { unsigned _sp = 0; while (cond) { __builtin_amdgcn_s_sleep(1); \
    if ((++_sp & 255u) == 0u) { if (xb_ld(&(bar)[XB_TMO])) break; if (_sp > XB_SPIN_CAP) { atomicAdd(&(bar)[XB_TMO], 1u); break; } } } } while (0)
struct XcdBarrier { unsigned* bar; unsigned x; volatile LAS unsigned* st; };
__device__ __forceinline__ XcdBarrier xcd_barrier_post(unsigned* bar, volatile LAS unsigned* st) {
    XcdBarrier b; b.bar = bar; b.x = xb_xcc_id(); b.st = st;
    if (threadIdx.x == 0) (void)xb_add(&bar[XB_XCNT(b.x)], 1u);
    return b;
}
__device__ __forceinline__ void xcd_barrier_complete(unsigned* bar, unsigned x, unsigned& nloc, unsigned& nx) {
    const unsigned G = gridDim.x * gridDim.y * gridDim.z;
    unsigned sum, cnt, mine, sp = 0u;
    for (;;) {
        sum = 0u; cnt = 0u; mine = 0u;
#pragma unroll
        for (unsigned j = 0; j < 16; ++j) { const unsigned c = xb_ld(&bar[XB_XCNT(j)]); sum += c; cnt += (c > 0u) ? 1u : 0u; mine = (j == x) ? c : mine; }
        if (sum == G) break;
        __builtin_amdgcn_s_sleep(1);
        if ((++sp & 255u) == 0u) { if (xb_ld(&bar[XB_TMO])) break; if (sp > XB_SPIN_CAP) { atomicAdd(&bar[XB_TMO], 1u); break; } }
    }
    nloc = mine > 0u ? mine : 1u; nx = cnt > 0u ? cnt : 1u;
}
__device__ __forceinline__ void xcd_barrier(const XcdBarrier& b) {
    asm volatile("s_waitcnt vmcnt(0)" ::: "memory");
    __syncthreads();
    if (threadIdx.x == 0) {
        unsigned* bar = b.bar;
        __builtin_amdgcn_s_waitcnt(0);
        unsigned nloc = b.st[0], nx = b.st[1];
        if (nloc == 0u) { xcd_barrier_complete(bar, b.x, nloc, nx); b.st[0] = nloc; b.st[1] = nx; }
        const unsigned old = xb_add(&bar[XB_XSUB(b.x)], 1u);
        const unsigned gen = old / nloc;
        if (old + 1u == (gen + 1u) * nloc) {
            __builtin_amdgcn_fence(__ATOMIC_RELEASE, "agent");
            asm volatile("s_waitcnt vmcnt(0)" ::: "memory");
            const unsigned og = xb_add(&bar[XB_TOP], 1u);
            const unsigned tg = og / nx;
            if (og + 1u == (tg + 1u) * nx) xb_add(&bar[XB_TOPGEN], 1u);
            else XB_SPIN(xb_ld(&bar[XB_TOPGEN]) == tg, bar);
            __builtin_amdgcn_fence(__ATOMIC_ACQUIRE, "agent");
            xb_add(&bar[XB_XGEN(b.x)], 1u);
            asm volatile("s_waitcnt vmcnt(0)" ::: "memory");
        } else {
            XB_SPIN(xb_ld(&bar[XB_XGEN(b.x)]) == gen, bar);
            __builtin_amdgcn_fence(__ATOMIC_ACQUIRE, "agent");
            asm volatile("s_waitcnt vmcnt(0)" ::: "memory");
        }
    }
    __syncthreads();
}
namespace pg8 {
constexpr int BM = 256, BK = 64, HALF = 128, HTB = HALF * BK * 2, STAGE_BYTES = 8 * HTB;
__host__ __device__ __forceinline__ int lds_byte(int r, int c) { const int st = (r >> 4) * 2 + (c >> 5), rr = r & 15, cc = c & 31, ob = rr * 64 + cc * 2; return st * 1024 + (ob ^ (((ob >> 9) & 1) << 5)); }
__host__ __device__ __forceinline__ void stage_rc(int b, int& R, int& C) { const int st = b / 1024, sb = b % 1024, swz = sb ^ (((sb >> 9) & 1) << 5); R = (st >> 1) * 16 + swz / 64; C = (st & 1) * 32 + (swz % 64) / 2; }
__host__ __device__ __forceinline__ int perm32(int rho) { const int n = rho >> 4, i = rho & 15; return 8 * (i >> 2) + 4 * n + (i & 3); }

struct Unit { const char* a; const char* b; int orow, ocol; const int* idx; };
struct GemmP { int K; unsigned lda, ldb; size_t hstepA, hstepB; };

template <class Epi, class Sched, bool ALIGN_EPI, bool FP8 = false, bool GATHER = false>
__device__ __forceinline__ void gemm_phase(LAS unsigned char* lds, const GemmP g, const Sched& S, const Epi& E, int tid) {
    const int wid = __builtin_amdgcn_readfirstlane(tid >> 6), lane = tid & 63, wr = wid >> 2, wc = wid & 3, fr = lane & 15, fq = lane >> 4;
    const int K = g.K, nt = K / BK;
    unsigned voffA[2], voffB[2];
#pragma unroll
    for (int i = 0; i < 2; ++i) { int R, C; stage_rc(tid * 16 + i * 8192, R, C); const int Rb = Epi::PERM ? ((R & ~31) + perm32(R & 31)) : R;
        voffA[i] = (unsigned)(R * g.lda + C) * 2u; voffB[i] = (unsigned)(Rb * g.ldb + C) * 2u; }
    const size_t kstep = (size_t)(BK * 2);
    const size_t hA = GATHER ? (size_t)0 : g.hstepA, hB = g.hstepB;
    unsigned a0c[2], a1c[2], a0n[2], a1n[2]; int gR[2], gC[2];
#pragma unroll
    for (int i = 0; i < 2; ++i) { stage_rc(tid * 16 + i * 8192, gR[i], gC[i]); a0c[i] = a1c[i] = a0n[i] = a1n[i] = voffA[i]; }
#define PG8_IDX(u_, v0_, v1_) do { if constexpr (GATHER) { _Pragma("unroll") for (int _i = 0; _i < 2; ++_i) { v0_[_i] = (unsigned)(u_).idx[gR[_i]] * (g.lda * 2u) + (unsigned)gC[_i] * 2u; v1_[_i] = (unsigned)(u_).idx[128 + gR[_i]] * (g.lda * 2u) + (unsigned)gC[_i] * 2u; } } } while (0)
    const unsigned ldsw = (unsigned)wid * 1024u;
    const int aoff = FP8 ? lds_byte(wr * 64 + fr, (fq & 1) * 16) + (fq >> 1) * 1024 : lds_byte(wr * 64 + fr, fq * 8), boff = FP8 ? lds_byte(wc * 32 + fr, (fq & 1) * 16) + (fq >> 1) * 1024 : lds_byte(wc * 32 + fr, fq * 8);
#define PG8_SA(b, h) (((b) * 2 + (h)) * HTB)
#define PG8_SB(b, h) ((4 + (b) * 2 + (h)) * HTB)
#define PG8_STAGE(bufoff, gbase, voff) do { _Pragma("unroll") for (int _i = 0; _i < 2; ++_i) \
        __builtin_amdgcn_global_load_lds((const unsigned*)((const char*)(gbase) + (voff)[_i]), (LAS unsigned*)(lds + (bufoff) + ldsw + _i * 8192), 16, 0, 0); } while (0)
#define PG8_LD8(p_) ({ const u32x4 lo_ = *(const LAS u32x4*)(p_), hi_ = *(const LAS u32x4*)((p_) + 16); (v8i){(int)lo_.x, (int)lo_.y, (int)lo_.z, (int)lo_.w, (int)hi_.x, (int)hi_.y, (int)hi_.z, (int)hi_.w}; })
#define PG8_LDA(dst, b, h) do { if constexpr (FP8) { _Pragma("unroll") for (int m = 0; m < 4; ++m) dst##8[m] = PG8_LD8(lds + PG8_SA(b, h) + aoff + m * 2048); } \
        else { _Pragma("unroll") for (int m = 0; m < 4; ++m) _Pragma("unroll") for (int k = 0; k < 2; ++k) dst[m][k] = *(const LAS bf16x8*)(lds + PG8_SA(b, h) + aoff + m * 2048 + k * 1024); } } while (0)
#define PG8_LDB(dst, b, h) do { if constexpr (FP8) { _Pragma("unroll") for (int n = 0; n < 2; ++n) dst##8[n] = PG8_LD8(lds + PG8_SB(b, h) + boff + n * 2048); } \
        else { _Pragma("unroll") for (int n = 0; n < 2; ++n) _Pragma("unroll") for (int k = 0; k < 2; ++k) dst[n][k] = *(const LAS bf16x8*)(lds + PG8_SB(b, h) + boff + n * 2048 + k * 1024); } } while (0)
#define PG8_MMA(ai, bj, At, Bt) do { __builtin_amdgcn_s_setprio(1); if constexpr (FP8) { _Pragma("unroll") for (int m = 0; m < 4; ++m) _Pragma("unroll") for (int n = 0; n < 2; ++n) \
        asm volatile("v_mfma_f32_16x16x128_f8f6f4 %0, %1, %2, %0" : "+v"(acc[ai][bj][m][n]) : "v"(Bt##8[n]), "v"(At##8[m])); }   \
        else { _Pragma("unroll") for (int m = 0; m < 4; ++m) _Pragma("unroll") for (int n = 0; n < 2; ++n) _Pragma("unroll") for (int k = 0; k < 2; ++k) \
        acc[ai][bj][m][n] = __builtin_amdgcn_mfma_f32_16x16x32_bf16(Bt[n][k], At[m][k], acc[ai][bj][m][n], 0, 0, 0); } __builtin_amdgcn_s_setprio(0); } while (0)
#define PG8_WAIT_V(n) asm volatile("s_waitcnt vmcnt(" #n ")" ::: "memory")
#define PG8_WAIT_L(n) asm volatile("s_waitcnt lgkmcnt(" #n ")" ::: "memory")
#define PG8_BAR __builtin_amdgcn_s_barrier()
#define PG8_SCHED __builtin_amdgcn_sched_barrier(0)
    Unit cur, nxt; int ui = 0;
    if (!S.next(0, cur)) return;
    f32x4 acc[2][2][4][2];
#pragma unroll
    for (int a = 0; a < 2; ++a)
#pragma unroll
        for (int b = 0; b < 2; ++b)
#pragma unroll
            for (int m = 0; m < 4; ++m)
#pragma unroll
                for (int n = 0; n < 2; ++n) acc[a][b][m][n] = (f32x4){0.f, 0.f, 0.f, 0.f};
    bf16x8 At[4][2], B0[2][2], B1[2][2]; v8i At8[4], B08[2], B18[2];
    const char* cA = cur.a; const char* cB = cur.b;
    PG8_IDX(cur, a0c, a1c);
    PG8_STAGE(PG8_SB(0, 0), cB, voffB); PG8_STAGE(PG8_SB(0, 1), cB + hB, voffB); PG8_STAGE(PG8_SA(0, 0), cA, a0c); PG8_STAGE(PG8_SA(0, 1), cA + hA, a1c);
    if (wr == 1) PG8_BAR;
    PG8_WAIT_V(2); PG8_BAR;
    PG8_STAGE(PG8_SB(1, 0), cB + kstep, voffB); PG8_STAGE(PG8_SA(1, 0), cA + kstep, a0c); PG8_STAGE(PG8_SB(1, 1), cB + hB + kstep, voffB);
    PG8_WAIT_V(6); PG8_BAR;
    for (;;) {
        const bool has_next = S.next(ui + 1, nxt);
        const char* nA = has_next ? nxt.a : cA; const char* nB = has_next ? nxt.b : cB;
        if constexpr (GATHER) { if (has_next)
            __builtin_amdgcn_global_load_lds((const unsigned*)(nxt.idx + 4 * lane), (LAS unsigned*)(lds + STAGE_BYTES + wid * 1024), 16, 0, 0); }
#pragma unroll 1
        for (int t = 0; t < nt; t += 2) {
            const bool last = (t == nt - 2);
            const char* a1 = cA + (size_t)(t + 1) * kstep;
            const char* a2 = last ? nA : cA + (size_t)(t + 2) * kstep; const char* b2 = last ? nB : cB + (size_t)(t + 2) * kstep;
            const char* a3 = a2 + kstep; const char* b3 = b2 + kstep;
            PG8_LDB(B0, 0, 0); PG8_LDB(B1, 0, 1); PG8_SCHED; PG8_LDA(At, 0, 0); PG8_STAGE(PG8_SA(1, 1), a1 + hA, a1c);
            if constexpr (GATHER) { if (last && has_next) {
                { const LAS unsigned* ix = (const LAS unsigned*)(lds + STAGE_BYTES + wid * 1024); a0n[0] = ix[gR[0]]; a0n[1] = ix[gR[1]]; a1n[0] = ix[128 + gR[0]]; a1n[1] = ix[128 + gR[1]]; }
                a0c[0] = a0n[0] * (g.lda * 2u) + (unsigned)gC[0] * 2u; a0c[1] = a0n[1] * (g.lda * 2u) + (unsigned)gC[1] * 2u; a1c[0] = a1n[0] * (g.lda * 2u) + (unsigned)gC[0] * 2u; a1c[1] = a1n[1] * (g.lda * 2u) + (unsigned)gC[1] * 2u; } }
            PG8_WAIT_V(8); PG8_WAIT_L(0); PG8_BAR; PG8_MMA(0, 0, At, B0); PG8_MMA(0, 1, At, B1); PG8_BAR; PG8_SCHED;
            PG8_LDA(At, 0, 1); PG8_STAGE(PG8_SB(0, 0), b2, voffB); PG8_STAGE(PG8_SB(0, 1), b2 + hB, voffB); PG8_STAGE(PG8_SA(0, 0), a2, a0c);
            PG8_WAIT_V(8); PG8_WAIT_L(0); PG8_BAR; PG8_MMA(1, 0, At, B0); PG8_MMA(1, 1, At, B1); PG8_BAR; PG8_SCHED;
            PG8_LDB(B0, 1, 0); PG8_LDB(B1, 1, 1); PG8_SCHED; PG8_LDA(At, 1, 0); PG8_STAGE(PG8_SA(0, 1), a2 + hA, a1c);
            PG8_WAIT_V(8); PG8_WAIT_L(0); PG8_BAR; PG8_MMA(0, 0, At, B0); PG8_MMA(0, 1, At, B1); PG8_BAR; PG8_SCHED;
            PG8_LDA(At, 1, 1); PG8_STAGE(PG8_SB(1, 0), b3, voffB); PG8_STAGE(PG8_SB(1, 1), b3 + hB, voffB); PG8_STAGE(PG8_SA(1, 0), a3, a0c);
            PG8_WAIT_V(8); PG8_WAIT_L(0); PG8_BAR; PG8_MMA(1, 0, At, B0); PG8_MMA(1, 1, At, B1); PG8_BAR; PG8_SCHED;
        }
        if constexpr (ALIGN_EPI) { if (wr == 0) PG8_BAR; }
        if constexpr (FP8) asm volatile("s_nop 15\n\ts_nop 15" ::: "memory");
        { int fr_ = fr, fq_ = fq; asm volatile("" : "+v"(fr_), "+v"(fq_)); E(acc, cur, wr, wc, fr_, fq_); }
        if (!has_next) break;
#pragma unroll
        for (int a = 0; a < 2; ++a)
#pragma unroll
            for (int b = 0; b < 2; ++b)
#pragma unroll
                for (int m = 0; m < 4; ++m)
#pragma unroll
                    for (int n = 0; n < 2; ++n) acc[a][b][m][n] = (f32x4){0.f, 0.f, 0.f, 0.f};
        cur = nxt; cA = nA; cB = nB; ++ui;
        if constexpr (ALIGN_EPI) { if (wr == 1) PG8_BAR; }
    }
    PG8_WAIT_V(0);
    if constexpr (!ALIGN_EPI) { if (wr == 0) PG8_BAR; }
    PG8_BAR;
#undef PG8_SA
#undef PG8_SB
#undef PG8_STAGE
#undef PG8_LDA
#undef PG8_IDX
#undef PG8_LD8
#undef PG8_LDB
#undef PG8_MMA
#undef PG8_WAIT_V
#undef PG8_WAIT_L
#undef PG8_BAR
#undef PG8_SCHED
}

typedef const f32x4 (&AccRef)[2][2][4][2];
__device__ __forceinline__ u32x4 pack8(const f32x4 v0, const f32x4 v1) { u32x4 w; w.x = cvt_pk_bf16(v0[0], v0[1]); w.y = cvt_pk_bf16(v0[2], v0[3]); w.z = cvt_pk_bf16(v1[0], v1[1]); w.w = cvt_pk_bf16(v1[2], v1[3]); return w; }

struct EpiBf16 {
    static constexpr bool PERM = true;
    bf16_t* O; int ldc; float scale;
    __device__ __forceinline__ void operator()(AccRef acc, const Unit& u, int wr, int wc, int fr, int fq) const {
        const int row0 = u.orow + wr * 64 + fr, col0 = u.ocol + wc * 32 + 8 * fq;
#pragma unroll
        for (int ai = 0; ai < 2; ++ai)
#pragma unroll
            for (int m = 0; m < 4; ++m) { bf16_t* rowp = O + (size_t)(row0 + ai * HALF + m * 16) * ldc + col0;
#pragma unroll
                for (int bj = 0; bj < 2; ++bj) *(u32x4*)(rowp + bj * HALF) = pack8(acc[ai][bj][m][0] * scale, acc[ai][bj][m][1] * scale); }
    }
};
struct EpiFp8 {
    static constexpr bool PERM = true;
    unsigned char* O; int ldc; float scale;
    __device__ __forceinline__ void operator()(AccRef acc, const Unit& u, int wr, int wc, int fr, int fq) const {
        const int row0 = u.orow + wr * 64 + fr, col0 = u.ocol + wc * 32 + 8 * fq;
#pragma unroll
        for (int ai = 0; ai < 2; ++ai)
#pragma unroll
            for (int m = 0; m < 4; ++m) { unsigned char* rowp = O + (size_t)(row0 + ai * HALF + m * 16) * ldc + col0;
#pragma unroll
                for (int bj = 0; bj < 2; ++bj) { const f32x4 v0 = acc[ai][bj][m][0] * scale, v1 = acc[ai][bj][m][1] * scale; u32x2 w;
                    w.x = cvt4_fp8(clamp448(v0[0]), clamp448(v0[1]), clamp448(v0[2]), clamp448(v0[3])); w.y = cvt4_fp8(clamp448(v1[0]), clamp448(v1[1]), clamp448(v1[2]), clamp448(v1[3]));
                    *(u32x2*)(rowp + bj * HALF) = w; } }
    }
};
struct EpiInProj {
    static constexpr bool PERM = true;
    bf16_t* O; const LAS f32x2* rope;
    __device__ __forceinline__ void operator()(AccRef acc, const Unit& u, int wr, int wc, int fr, int fq) const {
        const int row0 = u.orow + wr * 64 + fr, col0 = u.ocol + wc * 32 + 8 * fq;
        const bool do_rope = (u.ocol < 1024) && (u.orow < ML);
        const float sgn = (fq < 2) ? -1.f : 1.f;
#pragma unroll
        for (int ai = 0; ai < 2; ++ai)
#pragma unroll
            for (int m = 0; m < 4; ++m) { const int row = row0 + ai * HALF + m * 16; bf16_t* rowp = O + (size_t)row * INW + col0;
                f32x2 cs[8];
                if (do_rope) { const int t = row & (T - 1); const int pos = (wc & 1) ? (t & 63) : (t >> 6);
                    const LAS f32x4* rp = (const LAS f32x4*)(rope + pos * 16 + 8 * (fq & 1));
#pragma unroll
                    for (int k = 0; k < 4; ++k) { const f32x4 q = rp[k]; cs[2 * k] = (f32x2){q[0], q[1]}; cs[2 * k + 1] = (f32x2){q[2], q[3]}; } }
#pragma unroll
                for (int bj = 0; bj < 2; ++bj) { f32x4 v0 = acc[ai][bj][m][0], v1 = acc[ai][bj][m][1];
                    if (do_rope) {
#pragma unroll
                        for (int k = 0; k < 4; ++k) { const float p0 = xor32f(v0[k], fq < 2), p1 = xor32f(v1[k], fq < 2);
                            v0[k] = v0[k] * cs[k].x + sgn * p0 * cs[k].y; v1[k] = v1[k] * cs[4 + k].x + sgn * p1 * cs[4 + k].y; } }
                    *(u32x4*)(rowp + bj * HALF) = pack8(v0, v1); } }
    }
};
struct EpiF32 {
    static constexpr bool PERM = false;
    float* C; int ldc;
    __device__ __forceinline__ void operator()(AccRef acc, const Unit& u, int wr, int wc, int fr, int fq) const {
        const int row0 = u.orow + wr * 64 + fr, col0 = u.ocol + wc * 32 + 4 * fq;
#pragma unroll
        for (int ai = 0; ai < 2; ++ai)
#pragma unroll
            for (int m = 0; m < 4; ++m) { float* rowp = C + (size_t)(row0 + ai * HALF + m * 16) * ldc + col0;
#pragma unroll
                for (int bj = 0; bj < 2; ++bj)
#pragma unroll
                    for (int n = 0; n < 2; ++n) *(f32x4*)(rowp + bj * HALF + n * 16) = acc[ai][bj][m][n]; }
    }
};
struct EpiGateUp {
    static constexpr bool PERM = true;
    unsigned char* O;
    __device__ __forceinline__ void operator()(AccRef acc, const Unit& u, int wr, int wc, int fr, int fq) const {
        const int row0 = u.orow + wr * 64 + fr, col0 = u.ocol + wc * 32 + 8 * fq; constexpr float sg = 1.0f / (SX8 * SWG8);
#pragma unroll
        for (int ai = 0; ai < 2; ++ai)
#pragma unroll
            for (int m = 0; m < 4; ++m) { unsigned char* rowp = O + (size_t)(row0 + ai * HALF + m * 16) * FE + col0;
                float h[8];
#pragma unroll
                for (int k = 0; k < 4; ++k) { const float g0 = acc[ai][0][m][0][k] * sg, g1 = acc[ai][0][m][1][k] * sg;
                    h[k] = clamp448(g0 * fast_sigmoid(g0) * acc[ai][1][m][0][k] * (sg * SH8)); h[4 + k] = clamp448(g1 * fast_sigmoid(g1) * acc[ai][1][m][1][k] * (sg * SH8)); }
                u32x2 w; w.x = cvt4_fp8(h[0], h[1], h[2], h[3]); w.y = cvt4_fp8(h[4], h[5], h[6], h[7]); *(u32x2*)rowp = w; }
    }
};
struct EpiF1 {
    static constexpr bool PERM = true;
    bf16_t* GT; bf16_t* GTC;
    __device__ __forceinline__ void operator()(AccRef acc, const Unit& u, int wr, int wc, int fr, int fq) const {
        const int p = u.orow >> 8, pn = u.ocol >> 8, c0 = wr * 64 + fr, t0 = wc * 32 + 8 * fq;
        bf16_t* base; int cs;
        if (pn < 256) { base = GT + ((size_t)(pn >> 4) << 21) + (size_t)p * 4096 + (pn & 15) * 256; cs = 8192; }
        else { base = GTC + (size_t)(pn - 256) * 131072 + p * 256; cs = 512; }
        bf16_t* lp = base + (size_t)c0 * cs + t0;
#pragma unroll
        for (int ai = 0; ai < 2; ++ai)
#pragma unroll
            for (int m = 0; m < 4; ++m) { bf16_t* rp = lp + (size_t)(ai * HALF + m * 16) * cs;
#pragma unroll
                for (int bj = 0; bj < 2; ++bj) *(u32x4*)(rp + bj * HALF) = pack8(acc[ai][bj][m][0], acc[ai][bj][m][1]); }
    }
};

struct EpiF2H {
    static constexpr bool PERM = true;
    float* PQ; bf16_t* CC; unsigned* flags; unsigned epoch;
    __device__ __forceinline__ void operator()(AccRef acc, const Unit& u, int wr, int wc, int fr, int fq) const {
        const int part = u.ocol, b = u.orow >> 3, pm8 = u.orow & 7;
        float* tile = PQ + (size_t)u.orow * 65536; const int r0 = wr * 64 + fr, c0 = wc * 32 + 8 * fq;
        if (part == 0) {
#pragma unroll
            for (int ai = 0; ai < 2; ++ai)
#pragma unroll
                for (int m = 0; m < 4; ++m) { float* rp = tile + (size_t)(r0 + ai * HALF + m * 16) * 256 + c0;
#pragma unroll
                    for (int bj = 0; bj < 2; ++bj) { *(f32x4*)(rp + bj * HALF) = acc[ai][bj][m][0]; *(f32x4*)(rp + bj * HALF + 4) = acc[ai][bj][m][1]; } }
            asm volatile("s_waitcnt vmcnt(0)" ::: "memory"); __builtin_amdgcn_s_barrier();
            if (threadIdx.x == 0) { __builtin_amdgcn_fence(__ATOMIC_RELEASE, "agent"); asm volatile("s_waitcnt vmcnt(0)" ::: "memory"); __hip_atomic_store(flags + u.orow * 64, epoch, __ATOMIC_RELAXED, __HIP_MEMORY_SCOPE_AGENT); }
        } else {
            if (threadIdx.x == 0) { unsigned sp = 0; while (__hip_atomic_load(flags + u.orow * 64, __ATOMIC_RELAXED, __HIP_MEMORY_SCOPE_AGENT) < epoch) { __builtin_amdgcn_s_sleep(2); if (++sp > (1u << 20)) break; }
                __builtin_amdgcn_fence(__ATOMIC_ACQUIRE, "agent"); asm volatile("s_waitcnt vmcnt(0)" ::: "memory"); }
            __builtin_amdgcn_s_barrier(); asm volatile("" ::: "memory");
#pragma unroll
            for (int ai = 0; ai < 2; ++ai)
#pragma unroll
                for (int m = 0; m < 4; ++m) { const int r = r0 + ai * HALF + m * 16, k = pm8 * 256 + r; const float* rp = tile + (size_t)r * 256 + c0;
                    bf16_t* y0 = CC + (size_t)(b * T + k) * D + 768 + c0; bf16_t* y1 = CC + (size_t)(b * T + (T - k)) * D + 768 + c0;
#pragma unroll
                    for (int bj = 0; bj < 2; ++bj) { const f32x4 p0 = __builtin_nontemporal_load((const f32x4*)(rp + bj * HALF)), p1 = __builtin_nontemporal_load((const f32x4*)(rp + bj * HALF + 4));
                        *(u32x4*)(y0 + bj * HALF) = pack8(p0 + acc[ai][bj][m][0], p1 + acc[ai][bj][m][1]);
                        if (k > 0) *(u32x4*)(y1 + bj * HALF) = pack8(p0 - acc[ai][bj][m][0], p1 - acc[ai][bj][m][1]); } }
        }
    }
};

struct SchedPlain {
    int nN, total, G, c; const char* A; const char* B; size_t tA, tB; bool grp8;
    __device__ __forceinline__ bool next(int i, Unit& u) const { const int L = i * G + c; if (L >= total) return false; int pm = L / nN, pn = L - pm * nN;
        if (grp8) { const int gsz = 8 * nN, gi = L / gsz, r = L - gi * gsz; pm = gi * 8 + (r & 7); pn = r >> 3; }
        u.a = A + (size_t)pm * tA; u.b = B + (size_t)pn * tB; u.orow = pm * BM; u.ocol = pn * BM; u.idx = nullptr; return true; }
};
struct SchedF1 {
    int total, G, c; const char* A; const char* B;
    __device__ __forceinline__ bool next(int i, Unit& u) const { const int L = i * G + c; if (L >= total) return false; const int pn = L >> 1, pm = L & 1;
        u.a = A + (size_t)pm * (256 * 256 * 2); u.b = B + (size_t)pn * (256 * (size_t)INW * 2); u.orow = pm * BM; u.ocol = pn * BM; u.idx = nullptr; return true; }
};
struct SchedF2L {
    int G, c; const char* AT; const char* GT;
    __device__ __forceinline__ bool next(int i, Unit& u) const { const int L = i * G + c; if (L >= 256) return false;
        int b = L >> 4, pm = L & 15; if (G == 256) { const int x = L >> 5, w = L & 31; pm = (x & 3) * 4 + (w & 3); b = (x >> 2) * 8 + (w >> 2); }
        u.a = AT + (size_t)pm * (256 * 8192 * 2); u.b = GT + (size_t)b * (256 * 8192 * 2); u.orow = b * T + pm * BM; u.ocol = 768; u.idx = nullptr; return true; }
};
struct SchedF2H {
    int G, c; const char* AT; const char* GT;
    __device__ __forceinline__ bool next(int i, Unit& u) const { const int L = i * G + c; if (L >= 256) return false;
        const int x = L >> 5, w = L & 31, part = w & 1, pm8 = (x & 1) * 4 + ((w >> 1) & 3), b = (x >> 1) * 4 + (w >> 3);
        u.a = AT + (size_t)pm8 * (256 * 8192 * 2) + (size_t)part * (4096 * 2); u.b = GT + (size_t)b * (256 * 8192 * 2) + (size_t)part * (4096 * 2); u.orow = b * 8 + pm8; u.ocol = part; u.idx = nullptr; return true; }
};
struct SchedF2C {
    int G, c; const char* AC; const char* GTC;
    __device__ __forceinline__ bool next(int i, Unit& u) const { const int L = i * G + c; if (L >= 16) return false;
        u.a = AC; u.b = GTC + (size_t)L * (256 * 512 * 2); u.orow = ML + L * TC; u.ocol = 768; u.idx = nullptr; return true; }
};
struct SchedGU {
    int nrt, G, c; const char* XS; const char* W; const int* IDX;
    __device__ __forceinline__ bool next(int i, Unit& u) const { const int L = i * G + c; if (L >= 16 * 16 * nrt) return false;
        const int e = L / (16 * nrt), r = L - e * 16 * nrt;
        const int gi = r >> 6, rr = r & 63, gsz = (nrt - 4 * gi) < 4 ? (nrt - 4 * gi) : 4, half = rr / (gsz * 8), w = rr - half * gsz * 8, rt = gi * 4 + w % gsz, ct = half * 8 + w / gsz;
        const int rowbase = (rt < 32) ? (e * 17 + (rt >> 1)) * 512 + (rt & 1) * 256 : (e * 17 + 16) * 512 + (rt - 32) * 256;
        u.a = XS; u.idx = IDX + rowbase; u.b = W + (size_t)e * (2 * FE * D) + (size_t)ct * (128 * D); u.orow = rowbase; u.ocol = ct * 128; return true; }
};
struct SchedDN {
    int nrt, G, c; const char* HM; const char* W;
    __device__ __forceinline__ bool next(int i, Unit& u) const { const int L = i * G + c; if (L >= 16 * 4 * nrt) return false;
        const int e = L / (4 * nrt), r = L - e * 4 * nrt, rt = r >> 2, ct = r & 3;
        const int rowbase = (rt < 32) ? (e * 17 + (rt >> 1)) * 512 + (rt & 1) * 256 : (e * 17 + 16) * 512 + (rt - 32) * 256;
        u.a = HM + (size_t)rowbase * FE; u.b = W + (size_t)e * (D * FE) + (size_t)ct * (256 * FE); u.orow = rowbase; u.ocol = ct * 256; u.idx = nullptr; return true; }
};
}
namespace att {
constexpr int NW = 8, QBLK = 32, KVBLK = 64, LDZ = INW;
constexpr float SCALE = 0.125f, THR = 8.f;
#ifndef ATT_SDEPTH
#define ATT_SDEPTH 2
#endif
constexpr int SDEPTH = ATT_SDEPTH;
constexpr int SHM_V = KVBLK * 128 * 2, SHM_K = KVBLK * 64 * 2;
#ifndef ATT_RING3
#define ATT_RING3 1
#endif
constexpr int NBUF = ATT_RING3 ? 3 : 2;
constexpr int OFF_V = 0, OFF_K = NBUF * SHM_V, OFF_WS = OFF_K + NBUF * SHM_K, ATT_LDS = OFF_WS + NW * 64 * 4;
#define KSWZ(row, colB) ((row) * 128 + ((colB) ^ ((((row) >> 1) & 7) << 4)))
#define SBAR() __builtin_amdgcn_sched_barrier(0)
__device__ __forceinline__ int crow(int r, int hi) { return (r & 3) + 8 * (r >> 2) + 4 * hi; }
__device__ __forceinline__ void partialSM(f32x16& p0, f32x16& p1, float& m_reg, float& mn, float& alpha) {
  constexpr float C = SCALE * 1.4426950408889634f;
  float pmax = p0[0];
#pragma unroll
  for (int r = 1; r < 16; ++r) pmax = fmaxf(pmax, p0[r]);
#pragma unroll
  for (int r = 0; r < 16; ++r) pmax = fmaxf(pmax, p1[r]);
  { unsigned r0, r1; swap32(__float_as_uint(pmax), r0, r1); pmax = fmaxf(__uint_as_float(r0), __uint_as_float(r1)); }
  if (__builtin_expect(__all(pmax - m_reg <= THR / SCALE), 1)) { mn = m_reg; alpha = 1.f; }
  else { mn = fmaxf(m_reg, pmax); alpha = __builtin_amdgcn_exp2f((m_reg - mn) * C); m_reg = mn; }
  float mnC = -mn * C;
#pragma unroll
  for (int r = 0; r < 16; ++r) p0[r] = fmaf(p0[r], C, mnC);
#pragma unroll
  for (int r = 0; r < 16; ++r) p1[r] = fmaf(p1[r], C, mnC);
#ifndef ABL_NOEXP
#pragma unroll
  for (int r = 0; r < 16; ++r) p0[r] = __builtin_amdgcn_exp2f(p0[r]);
#endif
}
__device__ __forceinline__ void finishSM(f32x16& p0, f32x16& p1, float alpha, float& l_reg, bf16x8& pa0, bf16x8& pa1, bf16x8& pa2, bf16x8& pa3) {
#ifndef ABL_NOEXP
#pragma unroll
  for (int r = 0; r < 16; ++r) p1[r] = __builtin_amdgcn_exp2f(p1[r]);
#endif
  float ps = 0;
#pragma unroll
  for (int r = 0; r < 16; ++r) ps += p0[r];
#pragma unroll
  for (int r = 0; r < 16; ++r) ps += p1[r];
  { unsigned r0, r1; swap32(__float_as_uint(ps), r0, r1); ps = __uint_as_float(r0) + __uint_as_float(r1); }
  l_reg = l_reg * alpha + ps;
#define PK4(P, BASE, OUT) do { unsigned a0 = cvt_pk_bf16(P[BASE + 0], P[BASE + 1]), a1 = cvt_pk_bf16(P[BASE + 2], P[BASE + 3]);   \
    unsigned b0 = cvt_pk_bf16(P[BASE + 4], P[BASE + 5]), b1 = cvt_pk_bf16(P[BASE + 6], P[BASE + 7]);                              \
    auto r0 = __builtin_amdgcn_permlane32_swap(a0, b0, false, false); auto r1 = __builtin_amdgcn_permlane32_swap(a1, b1, false, false); \
    u32x4 w = {r0[0], r1[0], r0[1], r1[1]}; OUT = __builtin_bit_cast(bf16x8, w); } while (0)
  PK4(p0, 0, pa0); PK4(p0, 8, pa1); PK4(p1, 0, pa2); PK4(p1, 8, pa3);
#undef PK4
}
__device__ __forceinline__ void qkt(f32x16& p0, f32x16& p1, const LAS char* Ks, const bf16x8* qr, int r32, int hi) {
#pragma unroll
  for (int r = 0; r < 16; ++r) { p0[r] = 0.f; p1[r] = 0.f; }
#pragma unroll
  for (int d0 = 0; d0 < 4; ++d0) { const int cb = (d0 * 16 + hi * 8) * 2;
    bf16x8 b0 = *(const LAS bf16x8*)(Ks + KSWZ(r32, cb));
    bf16x8 b1 = *(const LAS bf16x8*)(Ks + KSWZ(32 + r32, cb));
    p0 = __builtin_amdgcn_mfma_f32_32x32x16_bf16(b0, qr[d0], p0, 0, 0, 0);
    p1 = __builtin_amdgcn_mfma_f32_32x32x16_bf16(b1, qr[d0], p1, 0, 0, 0); }
}
__device__ __forceinline__ int v_st(int k, int c) { const int kk = (k & ~0xC) | ((k & 4) << 1) | ((k & 8) >> 1); return ((kk >> 3) * 4 + (c >> 5)) * 512 + ((kk & 7) * 32 + (c & 31)) * 2; }
__device__ __forceinline__ int v_rd_base(int lane) { return ((lane & 3) << 3) | (((lane >> 2) & 3) << 6) | (((lane >> 4) & 1) << 5) | (((lane >> 5) & 1) << 8); }
constexpr int v_rd_off(int d0, int ks, int half) { return d0 * 512 + ks * 4096 + half * 2048; }
template <int OFF> __device__ __forceinline__ s16x4 tr_read(int vb) {
  s16x4 r; asm volatile("ds_read_b64_tr_b16 %0, %1 offset:%2" : "=&v"(r) : "v"(vb), "i"(OFF) : "memory"); return r;
}
template <int D0> __device__ __forceinline__ void pv_one(f32x16& od, int vb, bf16x8 pa0, bf16x8 pa1, bf16x8 pa2, bf16x8 pa3) {
  const s16x4 l0 = tr_read<v_rd_off(D0, 0, 0)>(vb), h0 = tr_read<v_rd_off(D0, 0, 1)>(vb), l1 = tr_read<v_rd_off(D0, 1, 0)>(vb), h1 = tr_read<v_rd_off(D0, 1, 1)>(vb);
  const s16x4 l2 = tr_read<v_rd_off(D0, 2, 0)>(vb), h2 = tr_read<v_rd_off(D0, 2, 1)>(vb), l3 = tr_read<v_rd_off(D0, 3, 0)>(vb), h3 = tr_read<v_rd_off(D0, 3, 1)>(vb);
  asm volatile("s_waitcnt lgkmcnt(0)" ::: "memory"); SBAR();
#define PK(L, H) (bf16x8){L[0], L[1], L[2], L[3], H[0], H[1], H[2], H[3]}
  od = __builtin_amdgcn_mfma_f32_32x32x16_bf16(pa0, PK(l0, h0), od, 0, 0, 0);
  od = __builtin_amdgcn_mfma_f32_32x32x16_bf16(pa1, PK(l1, h1), od, 0, 0, 0);
  od = __builtin_amdgcn_mfma_f32_32x32x16_bf16(pa2, PK(l2, h2), od, 0, 0, 0);
  od = __builtin_amdgcn_mfma_f32_32x32x16_bf16(pa3, PK(l3, h3), od, 0, 0, 0);
#undef PK
}
__device__ __forceinline__ void pv_d0(f32x16* o, int vb, bf16x8 pa0, bf16x8 pa1, bf16x8 pa2, bf16x8 pa3) {
  pv_one<0>(o[0], vb, pa0, pa1, pa2, pa3); pv_one<1>(o[1], vb, pa0, pa1, pa2, pa3); pv_one<2>(o[2], vb, pa0, pa1, pa2, pa3); pv_one<3>(o[3], vb, pa0, pa1, pa2, pa3);
}

__device__ __forceinline__ void diff_attn_unit(const bf16_t* __restrict__ Z, bf16_t* __restrict__ CC, float* o1s, const float* __restrict__ gvec, float lam, float gsc,
                                               int qrow0, int h, int seg0, int n0, int seg1, int NT, LAS char* lds, int tid) {
  asm volatile("" : "+v"(tid));
  const int wid = tid >> 6, lane = tid & 63, r32 = lane & 31, hi = lane >> 5;
  LAS char* V_lds = lds + OFF_V; LAS char* K_lds = lds + OFF_K;
  LAS float* ws = (LAS float*)(lds + OFF_WS) + wid * 64; LAS float* li_l = ws; LAS float* al_l = ws + 32;
  const int sr = tid >> 4, sc = (tid & 15) * 8, vst0 = v_st(sr, sc), vst1 = v_st(32 + sr, sc);
  const int kr = tid >> 3, kc = (tid & 7) * 8, kst = KSWZ(kr, kc * 2);
  const int vb0 = (int)(uintptr_t)V_lds + v_rd_base(lane);
  const bf16_t* Vcol = Z + 1024 + h * 128 + sc;
  for (int mp = 0; mp < 2; ++mp) {
    __syncthreads();
    const bf16_t* Kcol = Z + 512 + h * 128 + mp * 64 + kc;
    float m_reg = -1e30f, l_reg = 0; f32x16 o[4]; bf16x8 qr[4];
#pragma unroll
    for (int d = 0; d < 4; ++d)
#pragma unroll
      for (int r = 0; r < 16; ++r) o[d][r] = 0.f;
    const bf16_t* Qw = Z + (size_t)(qrow0 + wid * QBLK + r32) * LDZ + h * 128 + mp * 64 + hi * 8;
#pragma unroll
    for (int d0 = 0; d0 < 4; ++d0) qr[d0] = *(const bf16x8*)(Qw + d0 * 16);
    struct { bf16x8 vs0, vs1, ks; } sr_[SDEPTH];
#define TROW(j) ((j) < n0 ? seg0 + (j) * KVBLK : seg1 + ((j) - n0) * KVBLK)
#define SLOAD(i, j) do { const int _k0 = TROW(j); sr_[i].vs0 = *(const bf16x8*)(Vcol + (size_t)(_k0 + sr) * LDZ); sr_[i].vs1 = *(const bf16x8*)(Vcol + (size_t)(_k0 + 32 + sr) * LDZ); \
    sr_[i].ks = *(const bf16x8*)(Kcol + (size_t)(_k0 + kr) * LDZ); } while (0)
#define SWRITE(b, i) do { *(LAS bf16x8*)(V_lds + (b) * SHM_V + vst0) = sr_[i].vs0; *(LAS bf16x8*)(V_lds + (b) * SHM_V + vst1) = sr_[i].vs1; \
    *(LAS bf16x8*)(K_lds + (b) * SHM_K + kst) = sr_[i].ks; } while (0)
#define SWAIT() do { if constexpr (SDEPTH == 2) asm volatile("s_waitcnt vmcnt(3)" ::: "memory"); else asm volatile("s_waitcnt vmcnt(0)" ::: "memory"); } while (0)
#define RESC(a) do { if (__any((a) < 1.f)) { if (hi == 0) al_l[r32] = (a); asm volatile("s_waitcnt lgkmcnt(0)" ::: "memory"); \
    _Pragma("unroll") for (int d = 0; d < 4; ++d) _Pragma("unroll") for (int r = 0; r < 16; ++r) o[d][r] *= al_l[crow(r, hi)]; } } while (0)
    f32x16 pA0, pA1, pB0, pB1; float mnA, mnB, alA, alB; bf16x8 pa0, pa1, pa2, pa3;
    constexpr int SE = 0, SO = SDEPTH - 1;
    SLOAD(SE, 0); asm volatile("s_waitcnt vmcnt(0)" ::: "memory"); SWRITE(0, SE); __syncthreads();
    qkt(pA0, pA1, K_lds, qr, r32, hi); partialSM(pA0, pA1, m_reg, mnA, alA);
    SLOAD(SO, 1); if constexpr (SDEPTH == 2) { if (2 < NT) SLOAD(SE, 2); }
    SWAIT(); SWRITE(1, SO); __syncthreads();
#if ATT_RING3
    int b0 = 0, b1 = 1, b2 = 2;
    for (int j = 1; j + 1 < NT; j += 2) {
      SBAR(); qkt(pB0, pB1, K_lds + b1 * SHM_K, qr, r32, hi);
      finishSM(pA0, pA1, alA, l_reg, pa0, pa1, pa2, pa3); SBAR();
      SLOAD(SO, j + SDEPTH); SBAR();
      pv_d0(o, vb0 + b0 * SHM_V, pa0, pa1, pa2, pa3); partialSM(pB0, pB1, m_reg, mnB, alB);
      SWAIT(); SWRITE(b2, SE);
      RESC(alB); __syncthreads();
      SBAR(); qkt(pA0, pA1, K_lds + b2 * SHM_K, qr, r32, hi);
      finishSM(pB0, pB1, alB, l_reg, pa0, pa1, pa2, pa3); SBAR();
      if (SDEPTH == 1 || j + 3 < NT) SLOAD(SE, j + 1 + SDEPTH); SBAR();
      pv_d0(o, vb0 + b1 * SHM_V, pa0, pa1, pa2, pa3); partialSM(pA0, pA1, m_reg, mnA, alA);
      SWAIT(); SWRITE(b0, SO);
      RESC(alA); __syncthreads();
      { const int t0_ = b0; b0 = b2; b2 = b1; b1 = t0_; }
    }
    SBAR(); qkt(pB0, pB1, K_lds + b1 * SHM_K, qr, r32, hi);
    finishSM(pA0, pA1, alA, l_reg, pa0, pa1, pa2, pa3); SBAR();
    pv_d0(o, vb0 + b0 * SHM_V, pa0, pa1, pa2, pa3); partialSM(pB0, pB1, m_reg, mnB, alB);
    RESC(alB);
    finishSM(pB0, pB1, alB, l_reg, pa0, pa1, pa2, pa3); SBAR();
    pv_d0(o, vb0 + b1 * SHM_V, pa0, pa1, pa2, pa3);
#else
    for (int j = 1; j + 1 < NT; j += 2) {
      SBAR(); qkt(pB0, pB1, K_lds + SHM_K, qr, r32, hi);
      finishSM(pA0, pA1, alA, l_reg, pa0, pa1, pa2, pa3); SBAR();
      SLOAD(SO, j + SDEPTH); SBAR();
      pv_d0(o, vb0, pa0, pa1, pa2, pa3); partialSM(pB0, pB1, m_reg, mnB, alB);
      __syncthreads(); SWAIT(); SWRITE(0, SE);
      RESC(alB); __syncthreads();
      SBAR(); qkt(pA0, pA1, K_lds, qr, r32, hi);
      finishSM(pB0, pB1, alB, l_reg, pa0, pa1, pa2, pa3); SBAR();
      if (SDEPTH == 1 || j + 3 < NT) SLOAD(SE, j + 1 + SDEPTH); SBAR();
      pv_d0(o, vb0 + SHM_V, pa0, pa1, pa2, pa3); partialSM(pA0, pA1, m_reg, mnA, alA);
      __syncthreads(); SWAIT(); SWRITE(1, SO);
      RESC(alA); __syncthreads();
    }
    SBAR(); qkt(pB0, pB1, K_lds + SHM_K, qr, r32, hi);
    finishSM(pA0, pA1, alA, l_reg, pa0, pa1, pa2, pa3); SBAR();
    pv_d0(o, vb0, pa0, pa1, pa2, pa3); partialSM(pB0, pB1, m_reg, mnB, alB);
    __syncthreads(); RESC(alB);
    finishSM(pB0, pB1, alB, l_reg, pa0, pa1, pa2, pa3); SBAR();
    pv_d0(o, vb0 + SHM_V, pa0, pa1, pa2, pa3);
#endif
    if (hi == 0) li_l[r32] = l_reg; asm volatile("s_waitcnt lgkmcnt(0)" ::: "memory");
    float rli[16];
#pragma unroll
    for (int r = 0; r < 16; ++r) rli[r] = __builtin_amdgcn_rcpf(li_l[crow(r, hi)]);
    float* op = o1s + tid * 64;
    if (mp == 0) {
#pragma unroll
      for (int d0 = 0; d0 < 4; ++d0)
#pragma unroll
        for (int r4 = 0; r4 < 4; ++r4) *(f32x4*)(op + d0 * 16 + r4 * 4) = (f32x4){o[d0][4 * r4] * rli[4 * r4], o[d0][4 * r4 + 1] * rli[4 * r4 + 1], o[d0][4 * r4 + 2] * rli[4 * r4 + 2], o[d0][4 * r4 + 3] * rli[4 * r4 + 3]};
    } else {
      float ss[16];
#pragma unroll
      for (int r = 0; r < 16; ++r) ss[r] = 0.f;
#pragma unroll
      for (int d0 = 0; d0 < 4; ++d0)
#pragma unroll
        for (int r4 = 0; r4 < 4; ++r4) { const f32x4 o1 = __builtin_nontemporal_load((const f32x4*)(op + d0 * 16 + r4 * 4));
#pragma unroll
          for (int k = 0; k < 4; ++k) { const int r = 4 * r4 + k; const float v = o1[k] - lam * (o[d0][r] * rli[r]); o[d0][r] = v; ss[r] += v * v; } }
#pragma unroll
      for (int r = 0; r < 16; ++r) {
        ss[r] = row32_sum(ss[r]);
        ss[r] = __builtin_amdgcn_rsqf(ss[r] * (1.0f / 128.0f) + RMS_EPS) * gsc; }
      float gg[4];
#pragma unroll
      for (int d0 = 0; d0 < 4; ++d0) gg[d0] = gvec[h * 128 + d0 * 32 + r32];
      bf16_t* Ow = CC + (size_t)(qrow0 + wid * QBLK) * D + h * 128 + r32;
#pragma unroll
      for (int r = 0; r < 16; ++r) { int roff = crow(r, hi) * D; asm volatile("" : "+v"(roff)); bf16_t* rp = Ow + roff;
#pragma unroll
        for (int d0 = 0; d0 < 4; ++d0) rp[d0 * 32] = (bf16_t)f2bf(o[d0][r] * ss[r] * gg[d0]); }
    }
#undef TROW
#undef SLOAD
#undef SWRITE
#undef SWAIT
#undef RESC
  }
}
#undef KSWZ
}
struct Args { const float* in[28]; float* out; unsigned char* ws; int ph_lo, ph_hi, li, pad; };
struct Frame {
    LAS unsigned char* lds;
    int tid, lane, wave, vcu, G;
    unsigned char* ws;
};
enum { I_X = 0, I_C, I_CTX, I_CCTX, I_WMOD, I_BMOD, I_WIN, I_LQ1, I_LK1, I_LQ2, I_LK2, I_ANG, I_CONVW, I_CONVB, I_LWA, I_LBA, I_LWX, I_LBX, I_LLAM, I_WOUT,
       I_LN1G, I_LN1B, I_WR, I_WG, I_WU, I_WD, I_LN2G, I_LN2B };

__device__ __forceinline__ void transpose_item(const float* W, int N, bf16_t* WT, int ldt, LAS float* scr, int kb, int nb, int lane) {
    const int k0 = 64 * kb, n0 = 32 * nb;
#pragma unroll 8
    for (int i = 0; i < 32; ++i) { const int kk = 2 * i + (lane >> 5); scr[kk * 33 + (lane & 31)] = W[(size_t)(k0 + kk) * N + n0 + (lane & 31)]; }
    LDS_WAIT(); asm volatile("" ::: "memory");
    const int c = lane & 7;
#pragma unroll
    for (int j = 0; j < 4; ++j) { const int n = (lane >> 3) + 8 * j; const LAS float* s = scr + (8 * c) * 33 + n;
        u32x4 o; o.x = pk2(s[0 * 33], s[1 * 33]); o.y = pk2(s[2 * 33], s[3 * 33]); o.z = pk2(s[4 * 33], s[5 * 33]); o.w = pk2(s[6 * 33], s[7 * 33]);
        *(u32x4*)(WT + (size_t)(n0 + n) * ldt + k0 + 8 * c) = o; }
    LDS_WAIT(); asm volatile("" ::: "memory");
}

__device__ __forceinline__ void p0a(Frame& F, const Args& args) {
    const int gw = F.vcu * NWAVES + F.wave, NGW = F.G * NWAVES;
    LAS float* scr = (LAS float*)(F.lds + F.wave * 16384);
    { constexpr int IA = 16 * 72, IB = 16 * 32, PER = IA + IB;
      for (int it = gw; it < DEPTH * PER; it += NGW) { const int l = it / PER, r = it - l * PER;
        if (r < IA) transpose_item(args.in[I_WIN] + (size_t)l * D * INW, INW, (bf16_t*)(F.ws + WS_WIN) + (size_t)l * INW * D, D, scr, r / 72, r % 72, F.lane);
        else { const int r2 = r - IA; transpose_item(args.in[I_WOUT] + (size_t)l * D * D, D, (bf16_t*)(F.ws + WS_WOUT) + (size_t)l * D * D, D, scr, r2 / 32, r2 % 32, F.lane); } } }
    __syncthreads();
    { LAS float* sl = (LAS float*)F.lds;
      LAS float* cmb = sl + 17 * 1024;
      bool loaded = false;
      for (int it = F.vcu; it < DEPTH * 24; it += F.G) {
        if (!loaded) { for (int i = F.tid; i < 17 * 1024; i += NTHR) { const float c = (i < 16 * 1024) ? args.in[I_C][i] : args.in[I_CCTX][i - 16 * 1024]; sl[i] = c * fast_sigmoid(c); } loaded = true; }
        __syncthreads();
        const int l = it / 24, nb = it % 24, col = nb * 256 + (F.tid & 255), kh = F.tid >> 8;
        const float* wp = args.in[I_WMOD] + (size_t)l * D * 6144 + (size_t)(kh * 512) * 6144 + col;
        float acc[17];
#pragma unroll
        for (int j = 0; j < 17; ++j) acc[j] = 0.f;
        const float* wq = wp; float w0 = wq[0], w1 = wq[6144], w2 = wq[2 * 6144], w3 = wq[3 * 6144];
#pragma unroll 1
        for (int k = 0; k < 512; k += 4) {
            wq += 4 * 6144; const bool more = (k + 4 < 512);
            const float n0 = more ? wq[0] : 0.f, n1 = more ? wq[6144] : 0.f, n2 = more ? wq[2 * 6144] : 0.f, n3 = more ? wq[3 * 6144] : 0.f;
#pragma unroll
            for (int j = 0; j < 17; ++j) { const f32x4 s = *(const LAS f32x4*)(sl + j * 1024 + kh * 512 + k); acc[j] += s[0] * w0 + s[1] * w1 + s[2] * w2 + s[3] * w3; }
            w0 = n0; w1 = n1; w2 = n2; w3 = n3; }
        if (kh == 1) {
#pragma unroll
            for (int j = 0; j < 17; ++j) cmb[j * 256 + (F.tid & 255)] = acc[j]; }
        __syncthreads();
        if (kh == 0) { const float bm = args.in[I_BMOD][l * 6144 + col]; float* mo = (float*)(F.ws + WS_MOD) + (size_t)l * 17 * 6144 + col;
#pragma unroll
            for (int j = 0; j < 17; ++j) mo[(size_t)j * 6144] = acc[j] + cmb[j * 256 + (F.tid & 255)] + bm; }
        __syncthreads(); } }
    __syncthreads();
    { LAS f32x2* tab = (LAS f32x2*)F.lds;
      for (int r = F.tid; r < 4096; r += NTHR) { float s, c; sincospif((float)r * (1.0f / 2048.0f), &s, &c); tab[r] = (f32x2){c, s}; }
      __syncthreads();
      bf16_t* AT = (bf16_t*)(F.ws + WS_AT);
      for (int k = F.vcu; k < 2048; k += F.G) {
        for (int c8 = F.tid; c8 < 1024; c8 += NTHR) { const int half = c8 >> 9, t0 = (c8 & 511) * 8; unsigned w[4];
#pragma unroll
            for (int q = 0; q < 4; ++q) { const f32x2 e0 = tab[(k * (t0 + 2 * q)) & 4095], e1 = tab[(k * (t0 + 2 * q + 1)) & 4095];
                w[q] = half ? pk2(-e0.y * (1.f / 64.f), -e1.y * (1.f / 64.f)) : pk2(e0.x * (1.f / 64.f), e1.x * (1.f / 64.f)); }
            *(u32x4*)(AT + (size_t)k * 8192 + half * 4096 + t0) = (u32x4){w[0], w[1], w[2], w[3]}; } }
      bf16_t* AC = (bf16_t*)(F.ws + WS_SMALL + SM_AC);
      for (int i = gw * 64 + F.lane; i < 256 * 512; i += NGW * 64) { const int k = i >> 9, c = i & 511, half = c >> 8, t = c & 255; const f32x2 e = tab[((k * t) & 255) * 16];
        AC[i] = (bf16_t)f2bf(half ? -e.y * (1.f / 16.f) : e.x * (1.f / 16.f)); }
      bf16_t* DC = (bf16_t*)(F.ws + WS_SMALL + SM_DC);
      for (int i = gw * 64 + F.lane; i < 512 * 256; i += NGW * 64) { const int r = i >> 8, col = i & 255, p = r >> 8, g = (r >> 6) & 3, cp = r & 63, g2 = col >> 6, c = col & 63;
        const f32x2 e = tab[((c * cp) & 63) * 64]; DC[i] = (bf16_t)((g == g2) ? f2bf((p ? e.y : e.x) * 0.125f) : 0u); }
    }
    { bf16_t* LW = (bf16_t*)(F.ws + WS_SMALL + SM_LRUW);
      for (int i = gw * 64 + F.lane; i < 4 * 2 * 2 * 4 * 4096; i += NGW * 64) { const int k = i & 63, n = (i >> 6) & 63, blk = (i >> 12) & 3, gate = (i >> 14) & 1, ld = i >> 15;
        const float* src = (gate ? args.in[I_LWX] : args.in[I_LWA]) + ((size_t)(ld * 4 + blk) * 64 + k) * 64 + n; LW[i] = (bf16_t)f2bf(*src); } }
    if (F.vcu == 0 && F.wave == 0) { float* lamv = (float*)(F.ws + WS_SMALL + SM_LAM);
      for (int l = 0; l < DEPTH; ++l) { const float a = wave_sum(args.in[I_LQ1][l * 64 + F.lane] * args.in[I_LK1][l * 64 + F.lane]), b = wave_sum(args.in[I_LQ2][l * 64 + F.lane] * args.in[I_LK2][l * 64 + F.lane]);
        const float li = 0.8f - 0.6f * expf(-0.3f * (float)l); if (F.lane == 0) lamv[l] = expf(a) - expf(b) + li; } }
    __syncthreads();
}

__device__ __forceinline__ void ln_mod_store(const f32x4 (&v)[4], const float* md_sh, const float* md_sc, bf16_t* hrow, int lane) {
    float s = 0.f;
#pragma unroll
    for (int q = 0; q < 4; ++q) s += (v[q][0] + v[q][1]) + (v[q][2] + v[q][3]);
    const float mean = wave_sum(s) * (1.f / D); float s2 = 0.f; f32x4 d[4];
#pragma unroll
    for (int q = 0; q < 4; ++q) { d[q] = v[q] - mean; s2 += (d[q][0] * d[q][0] + d[q][1] * d[q][1]) + (d[q][2] * d[q][2] + d[q][3] * d[q][3]); }
    const float rstd = __builtin_amdgcn_rsqf(wave_sum(s2) * (1.f / D) + LN_EPS);
#pragma unroll
    for (int q = 0; q < 4; ++q) { const int col = 4 * lane + 256 * q; const f32x4 sh = *(const f32x4*)(md_sh + col), sc = *(const f32x4*)(md_sc + col);
        const f32x4 h = d[q] * rstd * (sc + 1.0f) + sh; u32x2 w; w.x = cvt_pk_bf16(h[0], h[1]); w.y = cvt_pk_bf16(h[2], h[3]); *(u32x2*)(hrow + col) = w; }
}
__device__ __forceinline__ void p0b(Frame& F, const Args& args) {
    const int gw = F.vcu * NWAVES + F.wave, NGW = F.G * NWAVES;
    bf16_t* H = (bf16_t*)(F.ws + WS_H); const float* mod = (const float*)(F.ws + WS_MOD);
#define SRCROW(mm) ((mm) < ML ? args.in[I_X] + (size_t)(mm) * D : args.in[I_CTX] + (size_t)((mm) - ML) * D)
    f32x4 vn[4];
    if (gw < M) {
#pragma unroll
        for (int q = 0; q < 4; ++q) vn[q] = *(const f32x4*)(SRCROW(gw) + 4 * F.lane + 256 * q); }
    for (int m = gw; m < M; m += NGW) { const int j = m < ML ? (m >> 12) : 16;
        f32x4 v[4], shp[4], scp[4]; const float* md = mod + (size_t)j * 6144;
#pragma unroll
        for (int q = 0; q < 4; ++q) { v[q] = vn[q]; shp[q] = *(const f32x4*)(md + 4 * F.lane + 256 * q); scp[q] = *(const f32x4*)(md + D + 4 * F.lane + 256 * q); }
        asm volatile("" ::: "memory");
        if (m + NGW < M) {
#pragma unroll
            for (int q = 0; q < 4; ++q) vn[q] = *(const f32x4*)(SRCROW(m + NGW) + 4 * F.lane + 256 * q); }
        asm volatile("" ::: "memory");
        float s = 0.f;
#pragma unroll
        for (int q = 0; q < 4; ++q) s += (v[q][0] + v[q][1]) + (v[q][2] + v[q][3]);
        const float mean = wave_sum(s) * (1.f / D); float s2 = 0.f;
#pragma unroll
        for (int q = 0; q < 4; ++q) { v[q] = v[q] - mean; s2 += (v[q][0] * v[q][0] + v[q][1] * v[q][1]) + (v[q][2] * v[q][2] + v[q][3] * v[q][3]); }
        const float rstd = __builtin_amdgcn_rsqf(wave_sum(s2) * (1.f / D) + LN_EPS);
#pragma unroll
        for (int q = 0; q < 4; ++q) { const f32x4 h = v[q] * rstd * (scp[q] + 1.0f) + shp[q]; u32x2 w; w.x = cvt_pk_bf16(h[0], h[1]); w.y = cvt_pk_bf16(h[2], h[3]); *(u32x2*)(H + (size_t)m * D + 4 * F.lane + 256 * q) = w; } }
#undef SRCROW
}

__device__ __forceinline__ void pw_item(const float* W, int N, unsigned char* WT, int ldt, LAS float* scr, int kb, int nb, int tid, float scale) {
    const int wave = tid >> 6, lane = tid & 63, k0 = 128 * kb, n0 = 256 * nb;
    const float* src = W + (size_t)(k0 + wave * 16) * N + n0 + lane * 4;
#pragma unroll
    for (int i = 0; i < 16; ++i) *(LAS f32x4*)(scr + (wave * 16 + i) * 260 + lane * 4) = *(const f32x4*)(src + (size_t)i * N);
    __syncthreads();
    const int n = tid & 255, kh = tid >> 8; const LAS float* s = scr + (64 * kh) * 260 + n; unsigned char* dst = WT + (size_t)(n0 + n) * ldt + k0 + 64 * kh;
#pragma unroll
    for (int h = 0; h < 4; ++h) { unsigned w[4];
#pragma unroll
        for (int g = 0; g < 4; ++g) { const LAS float* p = s + (16 * h + 4 * g) * 260; w[g] = cvt4_fp8(p[0] * scale, p[260] * scale, p[520] * scale, p[780] * scale); }
        *(u32x4*)(dst + 16 * h) = (u32x4){w[0], w[1], w[2], w[3]}; }
    __syncthreads();
}
__device__ __forceinline__ void pw_experts(Frame& F, const Args& args, int l) {
    LAS float* scr = (LAS float*)F.lds;
    unsigned char* WGU = F.ws + WS_WEXP; unsigned char* WDN = F.ws + WS_WDN;
    for (int it = F.vcu; it < NE * 192; it += F.G) { const int e = it / 192, r = it - e * 192, which = r >> 6, q = r & 63;
        if (which < 2) pw_item(args.in[which ? I_WU : I_WG] + ((size_t)l * NE + e) * D * FE, FE, WGU + ((size_t)e * 2 + which) * FE * D, D, scr, q >> 3, q & 7, F.tid, SWG8);
        else pw_item(args.in[I_WD] + ((size_t)l * NE + e) * FE * D, D, WDN + (size_t)e * D * FE, FE, scr, q >> 2, q & 3, F.tid, SWD8); }
}

__device__ __forceinline__ void pe_phase(Frame& F, const Args& args, int l, int nrows) {
    const int gw = F.vcu * NWAVES + F.wave, NGW = F.G * NWAVES;
    LAS f32x4* WR4 = (LAS f32x4*)F.lds;
    { const float* wr = args.in[I_WR] + (size_t)l * D * NE;
      for (int i = F.tid; i < 16 * 4 * 64; i += NTHR) { const int ln = i & 63, e4 = (i >> 6) & 3, qi = i >> 8, q = qi >> 2, ii = qi & 3; WR4[i] = *(const f32x4*)(wr + (size_t)(4 * ln + ii + 256 * q) * NE + 4 * e4); } }
    __syncthreads();
    float* X = (float*)(F.ws + WS_X); const bf16_t* MIX = (const bf16_t*)(F.ws + WS_ZR); unsigned char* H8 = F.ws + WS_H; float* SC = (float*)(F.ws + WS_SC);
    const float* mod = (const float*)(F.ws + WS_MOD) + (size_t)l * 17 * 6144;
    const float* g1p = args.in[I_LN1G] + l * D; const float* b1p = args.in[I_LN1B] + l * D;
    f32x4 xn[4]; u32x2 mn[4];
    const float* Xin0 = (l == 0) ? args.in[I_X] : X; const float* Xin1 = (l == 0) ? args.in[I_CTX] - (size_t)ML * D : X;
#define XROW(mm) (((mm) < ML ? Xin0 : Xin1) + (size_t)(mm) * D)
    if (gw < nrows) {
#pragma unroll
        for (int q = 0; q < 4; ++q) { const int col = 4 * F.lane + 256 * q; xn[q] = *(const f32x4*)(XROW(gw) + col); mn[q] = *(const u32x2*)(MIX + (size_t)gw * D + col); } }
    f32x4 g1r[4], b1r[4];
#pragma unroll
    for (int q = 0; q < 4; ++q) { g1r[q] = *(const f32x4*)(g1p + 4 * F.lane + 256 * q); b1r[q] = *(const f32x4*)(b1p + 4 * F.lane + 256 * q); }
    for (int m = gw; m < nrows; m += NGW) { const int j = m < ML ? (m >> 12) : 16; const float* md = mod + (size_t)j * 6144;
        f32x4 v[4], gm[4], sh2[4], sc2[4]; float s = 0.f;
#pragma unroll
        for (int q = 0; q < 4; ++q) { const int col = 4 * F.lane + 256 * q; gm[q] = *(const f32x4*)(md + 2 * D + col); }
#pragma unroll
        for (int q = 0; q < 4; ++q) { const int col = 4 * F.lane + 256 * q; sh2[q] = *(const f32x4*)(md + 3 * D + col); sc2[q] = *(const f32x4*)(md + 4 * D + col); }
#pragma unroll
        for (int q = 0; q < 4; ++q) { const f32x4 mx4 = (f32x4){bflo(mn[q].x), bfhi(mn[q].x), bflo(mn[q].y), bfhi(mn[q].y)};
            v[q] = xn[q] * DN_ALPHA + gm[q] * mx4; s += (v[q][0] + v[q][1]) + (v[q][2] + v[q][3]); }
        asm volatile("" ::: "memory");
        if (m + NGW < nrows) {
#pragma unroll
            for (int q = 0; q < 4; ++q) { const int col = 4 * F.lane + 256 * q; xn[q] = *(const f32x4*)(XROW(m + NGW) + col); mn[q] = *(const u32x2*)(MIX + (size_t)(m + NGW) * D + col); } }
        asm volatile("" ::: "memory");
        const float mean = wave_sum(s) * (1.f / D); float s2 = 0.f;
#pragma unroll
        for (int q = 0; q < 4; ++q) { v[q] = v[q] - mean; s2 += (v[q][0] * v[q][0] + v[q][1] * v[q][1]) + (v[q][2] * v[q][2] + v[q][3] * v[q][3]); }
        const float rstd = __builtin_amdgcn_rsqf(wave_sum(s2) * (1.f / D) + LN_EPS); s = 0.f;
#pragma unroll
        for (int q = 0; q < 4; ++q) { const int col = 4 * F.lane + 256 * q; v[q] = v[q] * rstd * g1r[q] + b1r[q]; *(f32x4*)(X + (size_t)m * D + col) = v[q];
            s += (v[q][0] + v[q][1]) + (v[q][2] + v[q][3]); }
        const float mean2 = wave_sum(s) * (1.f / D); s2 = 0.f;
#pragma unroll
        for (int q = 0; q < 4; ++q) { v[q] = v[q] - mean2; s2 += (v[q][0] * v[q][0] + v[q][1] * v[q][1]) + (v[q][2] * v[q][2] + v[q][3] * v[q][3]); }
        const float rstd2 = __builtin_amdgcn_rsqf(wave_sum(s2) * (1.f / D) + LN_EPS);
        float lg[16];
#pragma unroll
        for (int e = 0; e < 16; ++e) lg[e] = 0.f;
#pragma unroll
        for (int q = 0; q < 4; ++q) { const int col = 4 * F.lane + 256 * q;
            const f32x4 h = v[q] * rstd2 * (sc2[q] + 1.0f) + sh2[q]; *(unsigned*)(H8 + (size_t)m * D + col) = cvt4_fp8(clamp448(h[0] * SX8), clamp448(h[1] * SX8), clamp448(h[2] * SX8), clamp448(h[3] * SX8));
#pragma unroll
            for (int ii = 0; ii < 4; ++ii)
#pragma unroll
                for (int e4 = 0; e4 < 4; ++e4) { const f32x4 w4 = WR4[((q * 4 + ii) * 4 + e4) * 64 + F.lane];
#pragma unroll
                    for (int k = 0; k < 4; ++k) lg[e4 * 4 + k] += h[ii] * w4[k]; } }
        float r1[8], r2[4];
#pragma unroll
        for (int k = 0; k < 8; ++k) { const float ta = lg[k] + xor32f(lg[k], F.lane < 32), tb = lg[k + 8] + xor32f(lg[k + 8], F.lane < 32); r1[k] = (F.lane & 32) ? tb : ta; }
#pragma unroll
        for (int k = 0; k < 4; ++k) { const float ta = r1[k] + swz16f(r1[k]), tb = r1[k + 4] + swz16f(r1[k + 4]); r2[k] = (F.lane & 16) ? tb : ta; }
        float mx = -1e30f;
#pragma unroll
        for (int k = 0; k < 4; ++k) { float t = r2[k]; t += dppf<0xB1>(t); t += dppf<0x4E>(t); t += dppf<0x141>(t); t += dppf<0x140>(t); r2[k] = t; mx = fmaxf(mx, t); }
        mx = fmaxf(mx, swz16f(mx)); mx = fmaxf(mx, xor32f(mx, F.lane < 32));
        float se = 0.f;
#pragma unroll
        for (int k = 0; k < 4; ++k) { r2[k] = __expf(r2[k] - mx); se += r2[k]; }
        se += swz16f(se); se += xor32f(se, F.lane < 32);
        const float inv = 1.0f / se;
        if ((F.lane & 15) == 0) *(f32x4*)(SC + (size_t)m * NE + 4 * (F.lane >> 4)) = (f32x4){r2[0] * inv, r2[1] * inv, r2[2] * inv, r2[3] * inv}; }
#undef XROW
    __syncthreads();
}

__device__ __forceinline__ int block_sum_i(LAS int* red, int v, int wave, int lane) {
    v = wave_sum_i(v);
    if (lane == 0) red[wave] = v;
    __syncthreads();
    int s = 0;
#pragma unroll
    for (int w = 0; w < 8; ++w) s += red[w];
    return s;
}
__device__ __forceinline__ int lower_lanes(unsigned long long m) { return (int)__builtin_amdgcn_mbcnt_hi((unsigned)(m >> 32), __builtin_amdgcn_mbcnt_lo((unsigned)m, 0u)); }
__device__ __forceinline__ void topk_pair(Frame& F, const float* SC, int* TM, int m0, int n, int e, int cap, int yrow0, LAS int* sel, LAS int* red) {
    unsigned key[8];
#pragma unroll
    for (int k = 0; k < 8; ++k) { const int t = k * NTHR + F.tid; key[k] = (t < n) ? __builtin_bit_cast(unsigned, SC[(size_t)(m0 + t) * NE + e]) : 0u; }
    unsigned v = 0u; int it = 0;
    for (int shift = 28; shift >= -2; shift -= 3, ++it) { const int sh = shift < 0 ? 0 : shift; const unsigned jmax = shift < 0 ? 1u : 7u;
        int c[8];
#pragma unroll
        for (int j = 0; j < 8; ++j) c[j] = 0;
#pragma unroll
        for (int k = 0; k < 8; ++k) { const unsigned t = key[k] >= v ? min((key[k] - v) >> sh, jmax) : 0u;
#pragma unroll
            for (int j = 1; j < 8; ++j) c[j] += (t >= (unsigned)j) ? 1 : 0; }
        int pk[4];
#pragma unroll
        for (int q = 0; q < 4; ++q) pk[q] = wave_sum_i(c[2 * q] | (c[2 * q + 1] << 16));
        LAS int* rb = red + (it & 1) * 32;
        if (F.lane == 0) {
#pragma unroll
            for (int q = 0; q < 4; ++q) rb[F.wave * 4 + q] = pk[q]; }
        __syncthreads();
        int tot[4] = {0, 0, 0, 0};
#pragma unroll
        for (int w = 0; w < 8; ++w)
#pragma unroll
            for (int q = 0; q < 4; ++q) tot[q] += rb[w * 4 + q];
        unsigned best = 0u;
#pragma unroll
        for (int j = 1; j < 8; ++j) { const int cj = (j & 1) ? (tot[j >> 1] >> 16) : (tot[j >> 1] & 0xffff); if (cj >= cap && (unsigned)j <= jmax) best = (unsigned)j; }
        v |= best << sh; }
    LAS int* cgt = red + 64; LAS int* ceq = red + 64 + 64;
    __syncthreads();
    int lg[8], le[8];
#pragma unroll
    for (int k = 0; k < 8; ++k) { const unsigned long long mg = __builtin_amdgcn_ballot_w64(key[k] > v), me = __builtin_amdgcn_ballot_w64(key[k] == v);
        lg[k] = lower_lanes(mg); le[k] = lower_lanes(me);
        if (F.lane == 0) { cgt[k * 8 + F.wave] = __builtin_popcountll(mg); ceq[k * 8 + F.wave] = __builtin_popcountll(me); } }
    __syncthreads();
    int tot_gt = 0;
    for (int i = 0; i < 64; ++i) tot_gt += cgt[i];
    const int need_eq = cap - tot_gt;
    int gb = 0, eb = 0, idx = 0;
#pragma unroll
    for (int k = 0; k < 8; ++k) {
        for (; idx < k * 8 + F.wave; ++idx) { gb += cgt[idx]; eb += ceq[idx]; }
        const int t = k * NTHR + F.tid;
        if (t < n) { const bool gt = key[k] > v, eq = key[k] == v; const int myg = gb + lg[k], mye = eb + le[k];
            const bool selx = gt || (eq && mye < need_eq); const int slot = myg + (mye < need_eq ? mye : need_eq);
            if (selx) sel[slot] = m0 + t;
            TM[(size_t)(m0 + t) * NE + e] = selx ? (yrow0 + slot) : -1; } }
    __syncthreads();
}
__device__ __forceinline__ void pk_phase(Frame& F, bool with_ctx) {
    LAS int* sel = (LAS int*)F.lds; LAS int* red = sel + 512;
    const float* SC = (const float*)(F.ws + WS_SC); int* TM = (int*)(F.ws + WS_TM);
    int* IDXp = (int*)(F.ws + WS_IDX);
    for (int pr = F.vcu; pr < (with_ctx ? 512 : 256); pr += F.G) {
        const bool lat = pr < 256; const int q = lat ? pr : pr - 256, b = q >> 4, e = q & 15;
        const int cap = lat ? CAPL : CAPC, yrow0 = lat ? (e * 17 + b) * 512 : (e * 17 + 16) * 512 + b * CAPC;
        topk_pair(F, SC, TM, lat ? b * T : ML + b * TC, lat ? T : TC, e, cap, yrow0, sel, red);
        for (int s = F.tid; s < cap; s += NTHR) IDXp[yrow0 + s] = sel[s];
        __syncthreads(); }
}

__device__ __forceinline__ void pj_phase(Frame& F, const Args& args, int l, int nrows) {
    const int gw = F.vcu * NWAVES + F.wave, NGW = F.G * NWAVES; const bool last = (l == DEPTH - 1);
    float* X = (float*)(F.ws + WS_X); bf16_t* H = (bf16_t*)(F.ws + WS_H); const float* SC = (const float*)(F.ws + WS_SC); const int* TM = (const int*)(F.ws + WS_TM);
    const unsigned char* Y = F.ws + WS_ZR;
    const float* mod = (const float*)(F.ws + WS_MOD) + (size_t)l * 17 * 6144; const float* modn = mod + 17 * 6144;
    const float* g2p = args.in[I_LN2G] + l * D; const float* b2p = args.in[I_LN2B] + l * D;
    int tmn = -1; float scn = 0.f; f32x4 xnx[4];
    if (gw < nrows) { if (F.lane < 16) { tmn = TM[(size_t)gw * NE + F.lane]; scn = SC[(size_t)gw * NE + F.lane]; }
#pragma unroll
        for (int q = 0; q < 4; ++q) xnx[q] = *(const f32x4*)(X + (size_t)gw * D + 4 * F.lane + 256 * q); }
    f32x4 g2r[4], b2r[4];
#pragma unroll
    for (int q = 0; q < 4; ++q) { g2r[q] = *(const f32x4*)(g2p + 4 * F.lane + 256 * q); b2r[q] = *(const f32x4*)(b2p + 4 * F.lane + 256 * q); }
    for (int m = gw; m < nrows; m += NGW) { const int j = m < ML ? (m >> 12) : 16; const float* md = mod + (size_t)j * 6144; const float* mdn = modn + (size_t)j * 6144;
        const int tmv = tmn; const float scv = scn;
        f32x4 xr[4], g2m[4], shn[4], scq[4];
#pragma unroll
        for (int q = 0; q < 4; ++q) { xr[q] = xnx[q]; g2m[q] = *(const f32x4*)(md + 5 * D + 4 * F.lane + 256 * q); }
        if (!last) {
#pragma unroll
            for (int q = 0; q < 4; ++q) { shn[q] = *(const f32x4*)(mdn + 4 * F.lane + 256 * q); scq[q] = *(const f32x4*)(mdn + D + 4 * F.lane + 256 * q); } }
        unsigned long long mask = __builtin_amdgcn_ballot_w64(tmv >= 0);
        f32x4 a[4];
#pragma unroll
        for (int q = 0; q < 4; ++q) a[q] = (f32x4){0.f, 0.f, 0.f, 0.f};
        bool first = true;
        do {
            int yr[4]; float gg[4];
#pragma unroll
            for (int k = 0; k < 4; ++k) { if (mask) { const int e = __builtin_ctzll(mask); mask &= mask - 1; yr[k] = __builtin_amdgcn_readlane(tmv, e); gg[k] = __builtin_bit_cast(float, __builtin_amdgcn_readlane(__builtin_bit_cast(int, scv), e)); } else { yr[k] = 0; gg[k] = 0.f; } }
            unsigned w[4][4];
#pragma unroll
            for (int k = 0; k < 4; ++k)
#pragma unroll
                for (int q = 0; q < 4; ++q) w[k][q] = *(const unsigned*)(Y + (size_t)yr[k] * D + 4 * F.lane + 256 * q);
            asm volatile("" ::: "memory");
            if (first && m + NGW < nrows) { if (F.lane < 16) { tmn = TM[(size_t)(m + NGW) * NE + F.lane]; scn = SC[(size_t)(m + NGW) * NE + F.lane]; }
#pragma unroll
                for (int q = 0; q < 4; ++q) xnx[q] = *(const f32x4*)(X + (size_t)(m + NGW) * D + 4 * F.lane + 256 * q); }
            first = false;
            asm volatile("" ::: "memory");
#pragma unroll
            for (int k = 0; k < 4; ++k)
#pragma unroll
                for (int q = 0; q < 4; ++q) { const float gs = gg[k] * (1.0f / SY8); a[q][0] += gs * __builtin_amdgcn_cvt_f32_fp8((int)w[k][q], 0); a[q][1] += gs * __builtin_amdgcn_cvt_f32_fp8((int)w[k][q], 1); a[q][2] += gs * __builtin_amdgcn_cvt_f32_fp8((int)w[k][q], 2); a[q][3] += gs * __builtin_amdgcn_cvt_f32_fp8((int)w[k][q], 3); }
        } while (mask);
        f32x4 v[4]; float s = 0.f;
#pragma unroll
        for (int q = 0; q < 4; ++q) { v[q] = xr[q] * DN_ALPHA + g2m[q] * a[q]; s += (v[q][0] + v[q][1]) + (v[q][2] + v[q][3]); }
        const float mean = wave_sum(s) * (1.f / D); float s2 = 0.f;
#pragma unroll
        for (int q = 0; q < 4; ++q) { v[q] = v[q] - mean; s2 += (v[q][0] * v[q][0] + v[q][1] * v[q][1]) + (v[q][2] * v[q][2] + v[q][3] * v[q][3]); }
        const float rstd = __builtin_amdgcn_rsqf(wave_sum(s2) * (1.f / D) + LN_EPS);
        float* dst = last ? args.out + (size_t)m * D : X + (size_t)m * D; s = 0.f;
#pragma unroll
        for (int q = 0; q < 4; ++q) { const int col = 4 * F.lane + 256 * q; v[q] = v[q] * rstd * g2r[q] + b2r[q]; *(f32x4*)(dst + col) = v[q]; s += (v[q][0] + v[q][1]) + (v[q][2] + v[q][3]); }
        if (!last) { const float mean2 = wave_sum(s) * (1.f / D); s2 = 0.f;
#pragma unroll
            for (int q = 0; q < 4; ++q) { v[q] = v[q] - mean2; s2 += (v[q][0] * v[q][0] + v[q][1] * v[q][1]) + (v[q][2] * v[q][2] + v[q][3] * v[q][3]); }
            const float rstd2 = __builtin_amdgcn_rsqf(wave_sum(s2) * (1.f / D) + LN_EPS);
#pragma unroll
            for (int q = 0; q < 4; ++q) { const int col = 4 * F.lane + 256 * q; const f32x4 h = v[q] * rstd2 * (scq[q] + 1.0f) + shn[q]; u32x2 w; w.x = cvt_pk_bf16(h[0], h[1]); w.y = cvt_pk_bf16(h[2], h[3]); *(u32x2*)(H + (size_t)m * D + col) = w; } } }
}
constexpr int LRU_U = 0, LRU_SA = 33280, LRU_SI = LRU_SA + 32768, LRU_HS = LRU_SI + 32768;
static_assert(LRU_HS + 32768 + 5 * 256 * 4 <= PH_LDS, "lru lds");
constexpr int NCHUNK = 2048 + 128;
constexpr size_t WS_AX = WS_HM + 64 * MiB;
template <bool FINAL>
__device__ __forceinline__ void lru_phase(Frame& F, const Args& args, int l, int nunits) {
    const bf16_t* Z = (const bf16_t*)(F.ws + WS_ZR); bf16_t* CC = (bf16_t*)(F.ws + WS_CC);
    f32x2* SUMM = (f32x2*)(F.ws + WS_SUM); const float* CAR = (const float*)(F.ws + WS_CAR); unsigned* AX = (unsigned*)(F.ws + WS_AX);
    LAS float* U32 = (LAS float*)(F.lds + LRU_U); LAS float* SA = (LAS float*)(F.lds + LRU_SA); LAS float* SI = (LAS float*)(F.lds + LRU_SI); LAS float* HS = (LAS float*)(F.lds + LRU_HS);
    const int fr = F.lane & 15, fq = F.lane >> 4, dw = F.wave >> 2, blk = F.wave & 3;
    bf16x8 bw[2][4][2];
    { const bf16_t* LW = (const bf16_t*)(F.ws + WS_SMALL + SM_LRUW);
#pragma unroll
      for (int gate = 0; gate < 2; ++gate)
#pragma unroll
        for (int nt = 0; nt < 4; ++nt)
#pragma unroll
          for (int s = 0; s < 2; ++s) bw[gate][nt][s] = *(const bf16x8*)(LW + ((size_t)((((l * 2 + dw) * 2 + gate) * 4 + blk) * 64 + 16 * nt + fr)) * 64 + 32 * s + 8 * fq); }
    float gba[4], gbx[4], gsp[4];
#pragma unroll
    for (int nt = 0; nt < 4; ++nt) { const int ch = blk * 64 + 16 * nt + fr, o = (l * 2 + dw) * 256 + ch; gba[nt] = args.in[I_LBA][o]; gbx[nt] = args.in[I_LBX][o]; gsp[nt] = log1pf(expf(-args.in[I_LLAM][o])); }
    const float* cw = args.in[I_CONVW] + l * 4 * 256; const float* cb = args.in[I_CONVB] + l * 256;
    const int dt = F.tid >> 8, cht = F.tid & 255;
    const int ctt = F.tid >> 5, cch0 = (F.tid & 31) * 8;
    LAS float* CW = (LAS float*)(F.lds + LRU_HS + 32768);
    for (int i = F.tid; i < 5 * 256; i += NTHR) CW[i] = (i < 1024) ? cw[i] : cb[i - 1024];
    __syncthreads();
    u32x4 zr[2][4];
#define LRU_DECODE(u_, m0_, sl_, t0_) do { if ((u_) < 2048) { m0_ = ((u_) >> 7) * T; sl_ = T; t0_ = ((u_) & 127) * 32; } else { const int u2_ = (u_) - 2048; m0_ = ML + (u2_ >> 3) * TC; sl_ = TC; t0_ = (u2_ & 7) * 32; } } while (0)
#define LRU_ZLOAD(u_) do { int m0_, sl_, t0_; LRU_DECODE(u_, m0_, sl_, t0_); _Pragma("unroll") for (int hh = 0; hh < 2; ++hh) _Pragma("unroll") for (int j = 0; j < 4; ++j) { const int ts = t0_ + ctt + 16 * hh + j - 2; \
        zr[hh][j] = (ts >= 0 && ts < sl_) ? *(const u32x4*)(Z + (size_t)(m0_ + ts) * INW + 1536 + cch0) : (u32x4){0u, 0u, 0u, 0u}; } } while (0)
    if (F.vcu < nunits) LRU_ZLOAD(F.vcu);
    for (int uidx = F.vcu; uidx < nunits; uidx += F.G) {
        int m0, seqlen, t0; LRU_DECODE(uidx, m0, seqlen, t0);
        {
#pragma unroll
          for (int hh = 0; hh < 2; ++hh) { const int tk = ctt + 16 * hh; float u[8];
#pragma unroll
            for (int i = 0; i < 8; ++i) u[i] = CW[1024 + cch0 + i];
#pragma unroll
            for (int j = 0; j < 4; ++j) { const u32x4 z = zr[hh][j];
                    const f32x4 wa = *(const LAS f32x4*)(CW + j * 256 + cch0), wb = *(const LAS f32x4*)(CW + j * 256 + cch0 + 4);
                    u[0] += bflo(z.x) * wa[0]; u[1] += bfhi(z.x) * wa[1]; u[2] += bflo(z.y) * wa[2]; u[3] += bfhi(z.y) * wa[3];
                    u[4] += bflo(z.z) * wb[0]; u[5] += bfhi(z.z) * wb[1]; u[6] += bflo(z.w) * wb[2]; u[7] += bfhi(z.w) * wb[3]; }
            *(LAS f32x4*)(U32 + tk * 260 + cch0) = (f32x4){u[0], u[1], u[2], u[3]}; *(LAS f32x4*)(U32 + tk * 260 + cch0 + 4) = (f32x4){u[4], u[5], u[6], u[7]}; } }
        if (uidx + F.G < nunits) LRU_ZLOAD(uidx + F.G);
        __syncthreads();
        float h = FINAL ? CAR[(size_t)uidx * 512 + F.tid] : 0.f, P = 1.f;
#pragma unroll
        for (int j = 0; j < 2; ++j) {
            { const int sc = dw ? 1 - j : j;
              bf16x8 af[2];
#pragma unroll
              for (int s = 0; s < 2; ++s) { const LAS float* up = U32 + (16 * sc + fr) * 260 + blk * 64 + 32 * s + 8 * fq; const f32x4 x0 = *(const LAS f32x4*)up, x1 = *(const LAS f32x4*)(up + 4);
                  u32x4 w; w.x = cvt_pk_bf16(x0[0], x0[1]); w.y = cvt_pk_bf16(x0[2], x0[3]); w.z = cvt_pk_bf16(x1[0], x1[1]); w.w = cvt_pk_bf16(x1[2], x1[3]); af[s] = __builtin_bit_cast(bf16x8, w); }
#pragma unroll
              for (int nt = 0; nt < 4; ++nt) { f32x4 pa = (f32x4){0.f, 0.f, 0.f, 0.f}, px = pa;
#pragma unroll
                for (int s = 0; s < 2; ++s) { pa = __builtin_amdgcn_mfma_f32_16x16x32_bf16(af[s], bw[0][nt][s], pa, 0, 0, 0); px = __builtin_amdgcn_mfma_f32_16x16x32_bf16(af[s], bw[1][nt][s], px, 0, 0, 0); }
                const int ch = blk * 64 + 16 * nt + fr;
#pragma unroll
                for (int i = 0; i < 4; ++i) { const int tk = 4 * fq + i; const float e1 = 1.0f + __expf(-(pa[i] + gba[nt])), e2 = 1.0f + __expf(-(px[i] + gbx[nt])), t12 = __builtin_amdgcn_rcpf(e1 * e2), r = t12 * e2, ig = t12 * e1;
                    const float la = -8.0f * r * gsp[nt], a = __expf(la), mult = __builtin_amdgcn_sqrtf(fmaxf(1.0f - a * a, 0.f)), u = U32[(16 * sc + tk) * 260 + ch];
                    SA[tk * 512 + dw * 256 + ch] = a; SI[tk * 512 + dw * 256 + ch] = mult * ig * u; } } }
            __syncthreads();
            { const int sct = dt ? 1 - j : j;
#pragma unroll
              for (int k = 0; k < 16; ++k) { const int tk = dt ? 15 - k : k; const float a = SA[tk * 512 + F.tid], x = SI[tk * 512 + F.tid]; h = a * h + x; P *= a;
                  if (!FINAL) AX[(size_t)(m0 + t0 + 16 * sct + tk) * 512 + F.tid] = pk2(1.0f - a, x);
                  if (FINAL) { LAS float* hp = HS + (16 * sct + tk) * 256 + cht; *hp = (j == 0) ? h : *hp + h; } } }
            __syncthreads();
        }
        if (!FINAL) SUMM[(size_t)uidx * 512 + F.tid] = (f32x2){P, h};
        else { const int tok = F.tid >> 4, ch0 = (F.tid & 15) * 16; const size_t m = (size_t)(m0 + t0 + tok);
#pragma unroll
            for (int hh = 0; hh < 2; ++hh) { const u32x4 g = *(const u32x4*)(Z + m * INW + 1792 + ch0 + 8 * hh); const unsigned gw_[4] = {g.x, g.y, g.z, g.w}; float y[8];
#pragma unroll
                for (int i = 0; i < 8; ++i) { const float gv = (i & 1) ? bfhi(gw_[i >> 1]) : bflo(gw_[i >> 1]); const float ge = gv * fast_sigmoid(1.5957691216057308f * (gv + 0.044715f * gv * gv * gv));
                    y[i] = HS[tok * 256 + ch0 + 8 * hh + i] * ge; }
                u32x4 w; w.x = cvt_pk_bf16(y[0], y[1]); w.y = cvt_pk_bf16(y[2], y[3]); w.z = cvt_pk_bf16(y[4], y[5]); w.w = cvt_pk_bf16(y[6], y[7]);
                *(u32x4*)(CC + m * D + 512 + ch0 + 8 * hh) = w; }
            __syncthreads(); }
    }
}
#undef LRU_DECODE
#undef LRU_ZLOAD

__device__ __forceinline__ void lru_final(Frame& F, int nunits) {
    const bf16_t* Z = (const bf16_t*)(F.ws + WS_ZR); bf16_t* CC = (bf16_t*)(F.ws + WS_CC);
    const float* CAR = (const float*)(F.ws + WS_CAR); const unsigned* AX = (const unsigned*)(F.ws + WS_AX);
    LAS float* HF = (LAS float*)F.lds; LAS float* HB = HF + 32 * 256;
    const int dt = F.tid >> 8, cht = F.tid & 255;
    unsigned ax[32]; float hin = 0.f;
#define LF_DECODE(u_, m0_, t0_) do { if ((u_) < 2048) { m0_ = ((u_) >> 7) * T; t0_ = ((u_) & 127) * 32; } else { const int u2_ = (u_) - 2048; m0_ = ML + (u2_ >> 3) * TC; t0_ = (u2_ & 7) * 32; } } while (0)
#define LF_LOAD(u_) do { int m0_, t0_; LF_DECODE(u_, m0_, t0_); _Pragma("unroll") for (int k = 0; k < 32; ++k) ax[k] = AX[(size_t)(m0_ + t0_ + (dt ? 31 - k : k)) * 512 + F.tid]; hin = CAR[(size_t)(u_) * 512 + F.tid]; } while (0)
    if (F.vcu < nunits) LF_LOAD(F.vcu);
    for (int uidx = F.vcu; uidx < nunits; uidx += F.G) {
        int m0, t0; LF_DECODE(uidx, m0, t0);
        const int tok = F.tid >> 4, ch0 = (F.tid & 15) * 16; const size_t m = (size_t)(m0 + t0 + tok);
        const u32x4 g0 = *(const u32x4*)(Z + m * INW + 1792 + ch0), g1 = *(const u32x4*)(Z + m * INW + 1792 + ch0 + 8);
        float h = hin; LAS float* hp = (dt ? HB : HF) + cht;
#pragma unroll
        for (int k = 0; k < 32; ++k) { const int tk = dt ? 31 - k : k; const unsigned w = ax[k]; h = (1.0f - bflo(w)) * h + bfhi(w); hp[tk * 256] = h; }
        if (uidx + F.G < nunits) LF_LOAD(uidx + F.G);
        __syncthreads();
        { const unsigned gw_[8] = {g0.x, g0.y, g0.z, g0.w, g1.x, g1.y, g1.z, g1.w};
#pragma unroll
          for (int hh = 0; hh < 2; ++hh) { float y[8];
#pragma unroll
            for (int i = 0; i < 8; ++i) { const unsigned wv = gw_[4 * hh + (i >> 1)]; const float gv = (i & 1) ? bfhi(wv) : bflo(wv); const float ge = gv * fast_sigmoid(1.5957691216057308f * (gv + 0.044715f * gv * gv * gv));
                y[i] = (HF[tok * 256 + ch0 + 8 * hh + i] + HB[tok * 256 + ch0 + 8 * hh + i]) * ge; }
            u32x4 w; w.x = cvt_pk_bf16(y[0], y[1]); w.y = cvt_pk_bf16(y[2], y[3]); w.z = cvt_pk_bf16(y[4], y[5]); w.w = cvt_pk_bf16(y[6], y[7]);
            *(u32x4*)(CC + m * D + 512 + ch0 + 8 * hh) = w; } }
        __syncthreads();
    }
#undef LF_DECODE
#undef LF_LOAD
}
__device__ __forceinline__ void lru_carry(Frame& F) {
    const int gid = (F.vcu - (F.G - NB)) * NTHR + F.tid; if (gid < 0 || gid >= NB * 512) return;
    const f32x2* SUMM = (const f32x2*)(F.ws + WS_SUM); float* CAR = (float*)(F.ws + WS_CAR);
    const int b = gid >> 9, dch = gid & 511, d = dch >> 8; float h = 0.f;
#pragma unroll 1
    for (int s0 = 0; s0 < 136; s0 += 8) { f32x2 sm[8]; int ux[8];
#pragma unroll
        for (int k = 0; k < 8; ++k) { const int s = s0 + k; ux[k] = (s < 8) ? 2048 + b * 8 + (d ? 7 - s : s) : b * 128 + (d ? 127 - (s - 8) : (s - 8)); sm[k] = SUMM[(size_t)ux[k] * 512 + dch]; }
#pragma unroll
        for (int k = 0; k < 8; ++k) { CAR[(size_t)ux[k] * 512 + dch] = h; h = sm[k].x * h + sm[k].y; } }
}

constexpr int CW_F2 = 232000;
constexpr int CW_BAR = 1024, NPH_L = 10, NPHASE = 2 + DEPTH * NPH_L;
__global__ void __launch_bounds__(NTHR, 2) fwd_kernel(Args args) {
    extern __shared__ __attribute__((aligned(16))) unsigned char lds_raw[];
    Frame F;
    F.lds = (LAS unsigned char*)lds_raw;
    int wave_s = __builtin_amdgcn_readfirstlane((int)threadIdx.x >> 6);
    F.tid = threadIdx.x; F.lane = F.tid & 63; F.wave = wave_s;
    F.G = gridDim.x; { const int bx = blockIdx.x; F.vcu = (F.G % 8 == 0) ? (bx % 8) * (F.G / 8) + bx / 8 : bx; }
    F.ws = args.ws;
    volatile LAS unsigned* MISC = (volatile LAS unsigned*)(F.lds + MISC_OFF);
    if (F.tid < 128) MISC[F.tid] = 0u;
    { LAS f32x2* rope = (LAS f32x2*)(F.lds + ROPE_OFF);
      for (int i = F.tid; i < 1024; i += NTHR) { const int pos = i >> 4, j = i & 15; const float inv = exp2f(-(float)j * (13.287712379549449f / 16.0f)); float s, c; sincosf((float)pos * inv, &s, &c); rope[i] = (f32x2){c, s}; } }
    __syncthreads();
    XcdBarrier bar = xcd_barrier_post((unsigned*)(F.ws + WS_CTL) + CW_BAR + args.li * XCD_BAR_WORDS, MISC + 8);
    const int lo = args.ph_lo, hi = args.ph_hi;
#ifndef PHMASK
#define PHMASK 0xFFFFFFFFu
#endif
#define IN(k) (lo <= (k) && (k) < hi)
#define ON(b) ((PHMASK >> (b)) & 1u)
#define SEAM(k) do { if (IN(k) && IN((k) + 1)) { XcdBarrier b2_ = bar; unsigned x_ = b2_.x; asm volatile("" : "+s"(x_)); b2_.x = x_; unsigned* p_ = b2_.bar; asm volatile("" : "+s"(p_)); b2_.bar = p_; xcd_barrier(b2_); } RELAUNDER(); } while (0)
#define RELAUNDER() do { asm volatile("" : "+s"(wave_s)); int l_ = lane_id(); asm volatile("" : "+v"(l_)); F.lane = l_; F.wave = wave_s; F.tid = wave_s * 64 + l_; int v_ = F.vcu; asm volatile("" : "+s"(v_)); F.vcu = v_; size_t z_ = 0; asm volatile("" : "+s"(z_)); F.ws = args.ws + z_;     } while (0)
    LAS unsigned char* lds = F.lds;
    if (IN(0)) p0a(F, args);
    SEAM(0);
    if (IN(1)) p0b(F, args);
    SEAM(1);
    for (int l = 0; l < DEPTH; ++l) {
        RELAUNDER();
        const int pb = 2 + l * NPH_L; const bool last = (l == DEPTH - 1); const int nrows = last ? ML : M;
        const char* wsb = (const char*)F.ws;
        if (IN(pb + 0)) {
            pg8::GemmP g{D, D, D, (size_t)128 * D * 2, (size_t)128 * D * 2};
            pg8::SchedPlain S{9, (M / 256) * 9, F.G, F.vcu, wsb + WS_H, wsb + WS_WIN + (size_t)l * INW * D * 2, (size_t)256 * D * 2, (size_t)256 * D * 2, true};
            pg8::EpiInProj E{(bf16_t*)(F.ws + WS_ZR), (const LAS f32x2*)(F.lds + ROPE_OFF)};
            pg8::gemm_phase<pg8::EpiInProj, pg8::SchedPlain, true>(lds, g, S, E, F.tid);
        }
        SEAM(pb + 0);
        if (IN(pb + 1)) pw_experts(F, args, l);
        if (IN(pb + 1)) lru_phase<false>(F, args, l, NCHUNK);
        if (IN(pb + 1)) {
            pg8::GemmP g{256, 256, INW, (size_t)128 * 256 * 2, (size_t)128 * INW * 2};
            pg8::SchedF1 S{2 * (nrows / 256), F.G, F.vcu, wsb + WS_SMALL + SM_DC, wsb + WS_ZR + 2048 * 2};
            pg8::EpiF1 E{(bf16_t*)(F.ws + WS_GT), (bf16_t*)(F.ws + WS_GTC)};
            pg8::gemm_phase<pg8::EpiF1, pg8::SchedF1, true>(lds, g, S, E, F.tid);
        }
        SEAM(pb + 1);
        if (IN(pb + 2)) lru_carry(F);
        if (IN(pb + 2)) {
            const float lam = ((const float*)(F.ws + WS_SMALL + SM_LAM))[l], gsc = 1.0f - (0.8f - 0.6f * expf(-0.3f * (float)l));
            int bx_ = blockIdx.x; asm volatile("" : "+s"(bx_)); float* o1s = (float*)(F.ws + WS_O1) + (size_t)bx_ * 32768;
            const int nun = 1024 + (last ? 0 : 64);
            for (int u = F.vcu; u < nun; u += F.G) {
                int qrow0, h, seg0, n0, seg1, NT;
                if (u < 1024) { const int b = u >> 6; h = (u >> 4) & 3; qrow0 = b * T + (u & 15) * 256; seg0 = b * T; n0 = 64; seg1 = ML + b * TC; NT = 68; }
                else { const int u2 = u - 1024, b = u2 >> 2; h = u2 & 3; qrow0 = ML + b * TC; seg0 = qrow0; n0 = 4; seg1 = qrow0; NT = 4; }
                att::diff_attn_unit((const bf16_t*)(F.ws + WS_ZR), (bf16_t*)(F.ws + WS_CC), o1s, args.in[I_ANG] + l * 512, lam, gsc, qrow0, h, seg0, n0, seg1, NT, (LAS char*)lds, F.tid);
            }
            __syncthreads();
        }
        SEAM(pb + 2);
        if (IN(pb + 3)) lru_final(F, last ? 2048 : NCHUNK);
        if (IN(pb + 3)) {
            { pg8::GemmP g{4096, 8192, 8192, (size_t)128 * 8192 * 2, (size_t)128 * 8192 * 2};
              pg8::SchedF2H S{F.G, F.vcu, wsb + WS_AT, wsb + WS_GT};
              pg8::EpiF2H E{(float*)(F.ws + WS_HM), (bf16_t*)(F.ws + WS_CC), (unsigned*)(F.ws + WS_CTL) + CW_F2, (unsigned)(l + 1)};
              pg8::gemm_phase<pg8::EpiF2H, pg8::SchedF2H, true>(lds, g, S, E, F.tid); }
            {
              const bf16_t* GT = (const bf16_t*)(F.ws + WS_GT); bf16_t* CC = (bf16_t*)(F.ws + WS_CC);
              for (int pr = F.vcu * NWAVES + F.wave; pr < NB * 256; pr += F.G * NWAVES) { const int b = pr >> 8, cp = pr & 255; const bf16_t* g = GT + ((size_t)(b * 256 + cp) * 2) * 4096 + F.lane * 64; float s = 0.f;
#pragma unroll
                  for (int q = 0; q < 8; ++q) { const u32x4 w = *(const u32x4*)(g + 8 * q); s += (bflo(w.x) - bfhi(w.x)) + (bflo(w.y) - bfhi(w.y)) + (bflo(w.z) - bfhi(w.z)) + (bflo(w.w) - bfhi(w.w)); }
                  s = wave_sum(s) * (1.0f / 64.0f); if (F.lane == 0) CC[(size_t)(b * T + T / 2) * D + 768 + cp] = (bf16_t)f2bf(s); } }
            if (!last) { pg8::GemmP g{512, 512, 512, (size_t)128 * 512 * 2, (size_t)128 * 512 * 2};
              pg8::SchedF2C S{F.G, F.vcu, wsb + WS_SMALL + SM_AC, wsb + WS_GTC};
              pg8::EpiBf16 E{(bf16_t*)(F.ws + WS_CC), D, 1.0f};
              pg8::gemm_phase<pg8::EpiBf16, pg8::SchedF2C, true>(lds, g, S, E, F.tid); }
        }
        SEAM(pb + 3);
        if (IN(pb + 4)) {
            pg8::GemmP g{D, D, D, (size_t)128 * D * 2, (size_t)128 * D * 2};
            pg8::SchedPlain S{4, (nrows / 256) * 4, F.G, F.vcu, wsb + WS_CC, wsb + WS_WOUT + (size_t)l * D * D * 2, (size_t)256 * D * 2, (size_t)256 * D * 2, false};
            pg8::EpiBf16 E{(bf16_t*)(F.ws + WS_ZR), D, 1.0f};
            pg8::gemm_phase<pg8::EpiBf16, pg8::SchedPlain, true>(lds, g, S, E, F.tid);
        }
        SEAM(pb + 4);
        if (IN(pb + 5)) pe_phase(F, args, l, nrows);
        SEAM(pb + 5);
        if (IN(pb + 6)) pk_phase(F, !last);
        SEAM(pb + 6);
        if (IN(pb + 7)) {
            pg8::GemmP g{D / 2, D / 2, D / 2, (size_t)128 * D, (size_t)FE * D};
            pg8::SchedGU S{last ? 32 : 34, F.G, F.vcu, wsb + WS_H, wsb + WS_WEXP, (const int*)(wsb + WS_IDX)};
            pg8::EpiGateUp E{F.ws + WS_HM};
            pg8::gemm_phase<pg8::EpiGateUp, pg8::SchedGU, true, true, true>(lds, g, S, E, F.tid);
        }
        SEAM(pb + 7);
        if (IN(pb + 8)) {
            pg8::GemmP g{FE / 2, FE / 2, FE / 2, (size_t)128 * FE, (size_t)128 * FE};
            pg8::SchedDN S{last ? 32 : 34, F.G, F.vcu, wsb + WS_HM, wsb + WS_WDN};
            pg8::EpiFp8 E{F.ws + WS_ZR, D, SY8 / (SH8 * SWD8)};
            pg8::gemm_phase<pg8::EpiFp8, pg8::SchedDN, true, true>(lds, g, S, E, F.tid);
        }
        SEAM(pb + 8);
        if (IN(pb + 9)) pj_phase(F, args, l, nrows);
        SEAM(pb + 9);
    }
#undef IN
#undef SEAM
}

#ifndef MK_PER_PHASE
#define MK_PER_PHASE 0
#endif
extern "C" void kernel_launch(void* const* d_in, const int* in_sizes, int n_in, void* d_out, int out_size, void* d_ws, size_t ws_size, hipStream_t stream) {
    static int grid = 0;
    if (grid == 0) {
        if (n_in != 28 || in_sizes[0] != ML * D || out_size != ML * D || ws_size < WS_END) { fprintf(stderr, "kernel_launch: unexpected shapes / workspace (n_in %d, ws %zu < %zu)\n", n_in, ws_size, (size_t)WS_END); grid = -1; return; }
        int dev = 0, cus = 0, per_cu = 0;
        if (hipGetDevice(&dev) != hipSuccess || hipDeviceGetAttribute(&cus, hipDeviceAttributeMultiprocessorCount, dev) != hipSuccess) { grid = -1; return; }
        if (hipFuncSetAttribute((const void*)fwd_kernel, hipFuncAttributeMaxDynamicSharedMemorySize, LDS_BYTES) != hipSuccess) { fprintf(stderr, "kernel_launch: hipFuncSetAttribute failed\n"); grid = -1; return; }
        if (hipOccupancyMaxActiveBlocksPerMultiprocessor(&per_cu, (const void*)fwd_kernel, NTHR, LDS_BYTES) != hipSuccess || per_cu < 1) { fprintf(stderr, "kernel_launch: occupancy query says %d\n", per_cu); }
        (void)hipGetLastError();
        grid = cus < 256 ? cus : 256;
    }
    if (grid < 0) return;
    if (hipMemsetAsync((char*)d_ws + WS_CTL, 0, CTL_ZERO_BYTES, stream) != hipSuccess) return;
    Args a{};
    for (int i = 0; i < 28; ++i) a.in[i] = (const float*)d_in[i];
    a.out = (float*)d_out; a.ws = (unsigned char*)d_ws;
#if MK_PER_PHASE
#ifdef DIAG
    hipMemsetAsync((char*)d_ws + WS_DIAG, 0, 256, stream);
#ifndef DIAG_L
#define DIAG_L 0
#endif
#ifndef DIAG_VAL
#define DIAG_VAL -1
#endif
#endif
    for (int p = 0; p < NPHASE; ++p) { a.ph_lo = p; a.ph_hi = p + 1; a.li = p; hipLaunchKernelGGL(fwd_kernel, dim3(grid), dim3(NTHR), LDS_BYTES, stream, a);
#ifdef DIAG
        const int l = (p - 2) / NPH_L, k = (p - 2) % NPH_L; int ids[2] = {-1, -1};
        if (p == 1) ids[0] = 0;
        if (p >= 2 && l == DIAG_L) { if (k == 0) ids[0] = 1; if (k == 2) ids[0] = 2; if (k == 3) { ids[0] = 3; ids[1] = 4; } if (k == 4) ids[0] = 5; if (k == 5) ids[0] = 6; if (k == 6) ids[0] = 7; if (k == 7) ids[0] = 8; if (k == 8) ids[0] = 9; }
        if (p >= 2 && l == 3 && k == 9) ids[0] = 10;
        for (int q = 0; q < 2; ++q) if (ids[q] >= 0) hipLaunchKernelGGL(chk_kernel, dim3(48), dim3(256), 0, stream, a, ids[q], ids[q] == 0 ? 0 : (ids[q] == 10 ? 3 : DIAG_L));
#endif
    }
#ifdef DIAG
    hipLaunchKernelGGL(fin_kernel, dim3(1), dim3(1), 0, stream, a, 16, DIAG_VAL);
#endif
#else
    a.ph_lo = 0; a.ph_hi = NPHASE; a.li = 0; hipLaunchKernelGGL(fwd_kernel, dim3(grid), dim3(NTHR), LDS_BYTES, stream, a);
#endif
}
```

```cpp
#include <hip/hip_runtime.h>
#include <cstdio>
#include <cstdint>

#define GAS __attribute__((address_space(1)))
#define LAS __attribute__((address_space(3)))
typedef unsigned short bf16_t;
typedef short bf16x8 __attribute__((ext_vector_type(8)));
typedef short s16x4 __attribute__((ext_vector_type(4)));
typedef float f32x4 __attribute__((ext_vector_type(4)));
typedef float f32x2 __attribute__((ext_vector_type(2)));
typedef float f32x16 __attribute__((ext_vector_type(16)));
typedef unsigned u32x4 __attribute__((ext_vector_type(4)));
typedef unsigned u32x2 __attribute__((ext_vector_type(2)));
typedef GAS unsigned gu32;
#define RLX_AGENT __ATOMIC_RELAXED, __HIP_MEMORY_SCOPE_AGENT
#define LDS_WAIT() asm volatile("s_waitcnt lgkmcnt(0)" ::: "memory")
#define VM_WAIT() asm volatile("s_waitcnt vmcnt(0)" ::: "memory")

constexpr int D = 1024, NB = 16, T = 4096, TC = 256, DEPTH = 4;
constexpr int ML = NB * T, MC = NB * TC, M = ML + MC;
constexpr int INW = 2304, NE = 16, FE = 2048;
constexpr int CAPL = 512, CAPC = 32;
constexpr int NPAIR = NE * 17;
constexpr float LN_EPS = 1e-5f, RMS_EPS = 1e-6f;
constexpr float DN_ALPHA = 1.6817928305074290f;
constexpr int NWAVES = 8, NTHR = 512;

constexpr size_t MiB = 1u << 20;
constexpr size_t WS_CTL = 0, CTL_ZERO_BYTES = 1 * MiB;
constexpr size_t WS_MOD = 1 * MiB;
constexpr size_t WS_SMALL = 3 * MiB;
constexpr size_t SM_LAM = 0, SM_LRUW = 4096, SM_DC = SM_LRUW + 4 * 2 * 2 * 4 * 4096 * 2, SM_AC = SM_DC + 512 * 256 * 2, SM_END = SM_AC + 256 * 512 * 2;
static_assert(SM_END <= 3 * MiB, "small region");
constexpr size_t WS_WIN = 6 * MiB;
constexpr size_t WS_WOUT = 24 * MiB;
constexpr size_t WS_AT = 32 * MiB;
constexpr size_t WS_WEXP = 96 * MiB;
constexpr size_t WS_WDN = WS_WEXP + 128 * MiB;
constexpr size_t WS_X = 288 * MiB;
constexpr size_t WS_H = 560 * MiB;
constexpr size_t WS_CC = 696 * MiB;
constexpr size_t WS_ZR = 832 * MiB;
constexpr size_t WS_O1 = 1138 * MiB;
constexpr size_t WS_GT = 1170 * MiB;
constexpr size_t WS_GTC = 1234 * MiB;
constexpr size_t WS_SC = 1238 * MiB;
constexpr size_t WS_TM = 1243 * MiB;
constexpr size_t WS_IDX = 1248 * MiB;
constexpr size_t WS_SUM = 1249 * MiB;
constexpr size_t WS_CAR = 1258 * MiB;
constexpr size_t WS_HM = 1270 * MiB;
constexpr size_t WS_END = 1814 * MiB;
static_assert(WS_HM + (size_t)NPAIR * 512 * FE * 2 <= WS_END, "ws map");
static_assert(WS_ZR + (size_t)M * INW * 2 <= WS_O1 && WS_ZR + (size_t)NPAIR * 512 * D * 2 <= WS_O1, "ws map zr");

constexpr int PH_LDS = 147456;
constexpr int ROPE_OFF = PH_LDS;
constexpr int MISC_OFF = ROPE_OFF + 8192;
constexpr int LDS_BYTES = MISC_OFF + 512;

__device__ __forceinline__ unsigned f2bf(float f) { unsigned u = __builtin_bit_cast(unsigned, f); return (u + 0x7fffu + ((u >> 16) & 1u)) >> 16; }
__device__ __forceinline__ unsigned pk2(float lo, float hi) { return f2bf(lo) | (f2bf(hi) << 16); }
__device__ __forceinline__ float bf2f(unsigned short h) { return __builtin_bit_cast(float, (unsigned)h << 16); }
__device__ __forceinline__ float bflo(unsigned w) { return __builtin_bit_cast(float, w << 16); }
__device__ __forceinline__ float bfhi(unsigned w) { return __builtin_bit_cast(float, w & 0xffff0000u); }
__device__ __forceinline__ unsigned cvt_pk_bf16(float lo, float hi) { unsigned r; asm volatile("v_cvt_pk_bf16_f32 %0, %1, %2" : "=v"(r) : "v"(lo), "v"(hi)); return r; }
typedef int v8i __attribute__((ext_vector_type(8)));
__device__ __forceinline__ float clamp448(float x) { return __builtin_amdgcn_fmed3f(x, -448.f, 448.f); }
__device__ __forceinline__ unsigned cvt4_fp8(float a, float b, float c, float d) { int w = 0; w = __builtin_amdgcn_cvt_pk_fp8_f32(a, b, w, false); w = __builtin_amdgcn_cvt_pk_fp8_f32(c, d, w, true); return (unsigned)w; }
__device__ __forceinline__ float fp8_dec(unsigned char b) { return __builtin_amdgcn_cvt_f32_fp8((int)b, 0); }
constexpr float SX8 = 16.f, SWG8 = 128.f, SH8 = 8.f, SWD8 = 512.f, SY8 = 64.f;
__device__ __forceinline__ float fast_sigmoid(float x) { return __builtin_amdgcn_rcpf(1.0f + __expf(-x)); }
__device__ __forceinline__ int lane_id() { int r; asm volatile("v_mbcnt_lo_u32_b32 %0, -1, 0\n\tv_mbcnt_hi_u32_b32 %0, -1, %0" : "=v"(r)); return r; }
template <int CTRL> __device__ __forceinline__ float dppf(float v) { return __builtin_bit_cast(float, __builtin_amdgcn_update_dpp(0, __builtin_bit_cast(int, v), CTRL, 0xF, 0xF, true)); }
template <int CTRL> __device__ __forceinline__ int dppi(int v) { return __builtin_amdgcn_update_dpp(0, v, CTRL, 0xF, 0xF, true); }
__device__ __forceinline__ float swz16f(float v) { return __builtin_bit_cast(float, __builtin_amdgcn_ds_swizzle(__builtin_bit_cast(int, v), 0x401F)); }
__device__ __forceinline__ float row32_sum(float v) {
    v += dppf<0xB1>(v); v += dppf<0x4E>(v); v += dppf<0x141>(v); v += dppf<0x140>(v); v += swz16f(v); return v; }
__device__ __forceinline__ void swap32(unsigned x, unsigned& r0, unsigned& r1) { unsigned y = x; asm volatile("" : "+v"(y)); auto r = __builtin_amdgcn_permlane32_swap(x, y, false, false); r0 = r[0]; r1 = r[1]; }
__device__ __forceinline__ float wave_sum(float v) {
    v = row32_sum(v); unsigned r0, r1; swap32(__builtin_bit_cast(unsigned, v), r0, r1);
    return __builtin_bit_cast(float, r0) + __builtin_bit_cast(float, r1);
}
__device__ __forceinline__ int wave_sum_i(int v) {
    v += dppi<0xB1>(v); v += dppi<0x4E>(v); v += dppi<0x141>(v); v += dppi<0x140>(v); v += __builtin_amdgcn_ds_swizzle(v, 0x401F);
    unsigned r0, r1; swap32((unsigned)v, r0, r1); return (int)r0 + (int)r1;
}
__device__ __forceinline__ float xor32f(float v, bool lo_half) { unsigned r0, r1; swap32(__builtin_bit_cast(unsigned, v), r0, r1); return __builtin_bit_cast(float, lo_half ? r1 : r0); }

#define XB_TMO      128
#define XB_XCNT(j)  (256  + 64 * (j))
#define XB_XSUB(j)  (1280 + 64 * (j))
#define XB_XGEN(j)  (2304 + 64 * (j))
#define XB_TOP      3328
#define XB_TOPGEN   3392
#define XCD_BAR_WORDS 3456
#define XB_SPIN_CAP (1u << 18)
__device__ __forceinline__ unsigned xb_ld(unsigned* p)              { return __hip_atomic_load(p, __ATOMIC_RELAXED, __HIP_MEMORY_SCOPE_AGENT); }
__device__ __forceinline__ unsigned xb_add(unsigned* p, unsigned v) { return __hip_atomic_fetch_add(p, v, __ATOMIC_RELAXED, __HIP_MEMORY_SCOPE_AGENT); }
__device__ __forceinline__ unsigned xb_xcc_id() { return (unsigned)__builtin_amdgcn_s_getreg((3 << 11) | 20) & 0xFu; }
#define XB_SPIN(cond, bar) do { unsigned _sp = 0; while (cond) { __builtin_amdgcn_s_sleep(1); \
    if ((++_sp & 255u) == 0u) { if (xb_ld(&(bar)[XB_TMO])) break; if (_sp > XB_SPIN_CAP) { atomicAdd(&(bar)[XB_TMO], 1u); break; } } } } while (0)
struct XcdBarrier { unsigned* bar; unsigned x; volatile LAS unsigned* st; };
__device__ __forceinline__ XcdBarrier xcd_barrier_post(unsigned* bar, volatile LAS unsigned* st) {
    XcdBarrier b; b.bar = bar; b.x = xb_xcc_id(); b.st = st;
    if (threadIdx.x == 0) (void)xb_add(&bar[XB_XCNT(b.x)], 1u);
    return b;
}
__device__ __forceinline__ void xcd_barrier_complete(unsigned* bar, unsigned x, unsigned& nloc, unsigned& nx) {
    const unsigned G = gridDim.x * gridDim.y * gridDim.z;
    unsigned sum, cnt, mine, sp = 0u;
    for (;;) {
        sum = 0u; cnt = 0u; mine = 0u;
#pragma unroll
        for (unsigned j = 0; j < 16; ++j) { const unsigned c = xb_ld(&bar[XB_XCNT(j)]); sum += c; cnt += (c > 0u) ? 1u : 0u; mine = (j == x) ? c : mine; }
        if (sum == G) break;
        __builtin_amdgcn_s_sleep(1);
        if ((++sp & 255u) == 0u) { if (xb_ld(&bar[XB_TMO])) break; if (sp > XB_SPIN_CAP) { atomicAdd(&bar[XB_TMO], 1u); break; } }
    }
    nloc = mine > 0u ? mine : 1u; nx = cnt > 0u ? cnt : 1u;
}
__device__ __forceinline__ void xcd_barrier(const XcdBarrier& b) {
    asm volatile("s_waitcnt vmcnt(0)" ::: "memory");
    __syncthreads();
    if (threadIdx.x == 0) {
        unsigned* bar = b.bar;
        __builtin_amdgcn_s_waitcnt(0);
        unsigned nloc = b.st[0], nx = b.st[1];
        if (nloc == 0u) { xcd_barrier_complete(bar, b.x, nloc, nx); b.st[0] = nloc; b.st[1] = nx; }
        const unsigned old = xb_add(&bar[XB_XSUB(b.x)], 1u);
        const unsigned gen = old / nloc;
        if (old + 1u == (gen + 1u) * nloc) {
            __builtin_amdgcn_fence(__ATOMIC_RELEASE, "agent");
            asm volatile("s_waitcnt vmcnt(0)" ::: "memory");
            const unsigned og = xb_add(&bar[XB_TOP], 1u);
            const unsigned tg = og / nx;
            if (og + 1u == (tg + 1u) * nx) xb_add(&bar[XB_TOPGEN], 1u);
            else XB_SPIN(xb_ld(&bar[XB_TOPGEN]) == tg, bar);
            __builtin_amdgcn_fence(__ATOMIC_ACQUIRE, "agent");
            xb_add(&bar[XB_XGEN(b.x)], 1u);
            asm volatile("s_waitcnt vmcnt(0)" ::: "memory");
        } else {
            XB_SPIN(xb_ld(&bar[XB_XGEN(b.x)]) == gen, bar);
            __builtin_amdgcn_fence(__ATOMIC_ACQUIRE, "agent");
            asm volatile("s_waitcnt vmcnt(0)" ::: "memory");
        }
    }
    __syncthreads();
}
namespace pg8 {
constexpr int BM = 256, BK = 64, HALF = 128, HTB = HALF * BK * 2, STAGE_BYTES = 8 * HTB;
__host__ __device__ __forceinline__ int lds_byte(int r, int c) { const int st = (r >> 4) * 2 + (c >> 5), rr = r & 15, cc = c & 31, ob = rr * 64 + cc * 2; return st * 1024 + (ob ^ (((ob >> 9) & 1) << 5)); }
__host__ __device__ __forceinline__ void stage_rc(int b, int& R, int& C) { const int st = b / 1024, sb = b % 1024, swz = sb ^ (((sb >> 9) & 1) << 5); R = (st >> 1) * 16 + swz / 64; C = (st & 1) * 32 + (swz % 64) / 2; }
__host__ __device__ __forceinline__ int perm32(int rho) { const int n = rho >> 4, i = rho & 15; return 8 * (i >> 2) + 4 * n + (i & 3); }

struct Unit { const char* a; const char* b; int orow, ocol; const int* idx; };
struct GemmP { int K; unsigned lda, ldb; size_t hstepA, hstepB; };

template <class Epi, class Sched, bool ALIGN_EPI, bool FP8 = false, bool GATHER = false>
__device__ __forceinline__ void gemm_phase(LAS unsigned char* lds, const GemmP g, const Sched& S, const Epi& E, int tid) {
    const int wid = __builtin_amdgcn_readfirstlane(tid >> 6), lane = tid & 63, wr = wid >> 2, wc = wid & 3, fr = lane & 15, fq = lane >> 4;
    const int K = g.K, nt = K / BK;
    unsigned voffA[2], voffB[2];
#pragma unroll
    for (int i = 0; i < 2; ++i) { int R, C; stage_rc(tid * 16 + i * 8192, R, C); const int Rb = Epi::PERM ? ((R & ~31) + perm32(R & 31)) : R;
        voffA[i] = (unsigned)(R * g.lda + C) * 2u; voffB[i] = (unsigned)(Rb * g.ldb + C) * 2u; }
    const size_t kstep = (size_t)(BK * 2);
    const size_t hA = GATHER ? (size_t)0 : g.hstepA, hB = g.hstepB;
    unsigned a0c[2], a1c[2], a0n[2], a1n[2]; int gR[2], gC[2];
#pragma unroll
    for (int i = 0; i < 2; ++i) { stage_rc(tid * 16 + i * 8192, gR[i], gC[i]); a0c[i] = a1c[i] = a0n[i] = a1n[i] = voffA[i]; }
#define PG8_IDX(u_, v0_, v1_) do { if constexpr (GATHER) { _Pragma("unroll") for (int _i = 0; _i < 2; ++_i) { v0_[_i] = (unsigned)(u_).idx[gR[_i]] * (g.lda * 2u) + (unsigned)gC[_i] * 2u; v1_[_i] = (unsigned)(u_).idx[128 + gR[_i]] * (g.lda * 2u) + (unsigned)gC[_i] * 2u; } } } while (0)
    const unsigned ldsw = (unsigned)wid * 1024u;
    const int aoff = FP8 ? lds_byte(wr * 64 + fr, (fq & 1) * 16) + (fq >> 1) * 1024 : lds_byte(wr * 64 + fr, fq * 8), boff = FP8 ? lds_byte(wc * 32 + fr, (fq & 1) * 16) + (fq >> 1) * 1024 : lds_byte(wc * 32 + fr, fq * 8);
#define PG8_SA(b, h) (((b) * 2 + (h)) * HTB)
#define PG8_SB(b, h) ((4 + (b) * 2 + (h)) * HTB)
#define PG8_STAGE(bufoff, gbase, voff) do { _Pragma("unroll") for (int _i = 0; _i < 2; ++_i) \
        __builtin_amdgcn_global_load_lds((const unsigned*)((const char*)(gbase) + (voff)[_i]), (LAS unsigned*)(lds + (bufoff) + ldsw + _i * 8192), 16, 0, 0); } while (0)
#define PG8_LD8(p_) ({ const u32x4 lo_ = *(const LAS u32x4*)(p_), hi_ = *(const LAS u32x4*)((p_) + 16); (v8i){(int)lo_.x, (int)lo_.y, (int)lo_.z, (int)lo_.w, (int)hi_.x, (int)hi_.y, (int)hi_.z, (int)hi_.w}; })
#define PG8_LDA(dst, b, h) do { if constexpr (FP8) { _Pragma("unroll") for (int m = 0; m < 4; ++m) dst##8[m] = PG8_LD8(lds + PG8_SA(b, h) + aoff + m * 2048); } \
        else { _Pragma("unroll") for (int m = 0; m < 4; ++m) _Pragma("unroll") for (int k = 0; k < 2; ++k) dst[m][k] = *(const LAS bf16x8*)(lds + PG8_SA(b, h) + aoff + m * 2048 + k * 1024); } } while (0)
#define PG8_LDB(dst, b, h) do { if constexpr (FP8) { _Pragma("unroll") for (int n = 0; n < 2; ++n) dst##8[n] = PG8_LD8(lds + PG8_SB(b, h) + boff + n * 2048); } \
        else { _Pragma("unroll") for (int n = 0; n < 2; ++n) _Pragma("unroll") for (int k = 0; k < 2; ++k) dst[n][k] = *(const LAS bf16x8*)(lds + PG8_SB(b, h) + boff + n * 2048 + k * 1024); } } while (0)
#define PG8_MMA(ai, bj, At, Bt) do { __builtin_amdgcn_s_setprio(1); if constexpr (FP8) { _Pragma("unroll") for (int m = 0; m < 4; ++m) _Pragma("unroll") for (int n = 0; n < 2; ++n) \
        asm volatile("v_mfma_f32_16x16x128_f8f6f4 %0, %1, %2, %0" : "+v"(acc[ai][bj][m][n]) : "v"(Bt##8[n]), "v"(At##8[m])); }   \
        else { _Pragma("unroll") for (int m = 0; m < 4; ++m) _Pragma("unroll") for (int n = 0; n < 2; ++n) _Pragma("unroll") for (int k = 0; k < 2; ++k) \
        acc[ai][bj][m][n] = __builtin_amdgcn_mfma_f32_16x16x32_bf16(Bt[n][k], At[m][k], acc[ai][bj][m][n], 0, 0, 0); } __builtin_amdgcn_s_setprio(0); } while (0)
#define PG8_WAIT_V(n) asm volatile("s_waitcnt vmcnt(" #n ")" ::: "memory")
#define PG8_WAIT_L(n) asm volatile("s_waitcnt lgkmcnt(" #n ")" ::: "memory")
#define PG8_BAR __builtin_amdgcn_s_barrier()
#define PG8_SCHED __builtin_amdgcn_sched_barrier(0)
    Unit cur, nxt; int ui = 0;
    if (!S.next(0, cur)) return;
    f32x4 acc[2][2][4][2];
#pragma unroll
    for (int a = 0; a < 2; ++a)
#pragma unroll
        for (int b = 0; b < 2; ++b)
#pragma unroll
            for (int m = 0; m < 4; ++m)
#pragma unroll
                for (int n = 0; n < 2; ++n) acc[a][b][m][n] = (f32x4){0.f, 0.f, 0.f, 0.f};
    bf16x8 At[4][2], B0[2][2], B1[2][2]; v8i At8[4], B08[2], B18[2];
    const char* cA = cur.a; const char* cB = cur.b;
    PG8_IDX(cur, a0c, a1c);
    PG8_STAGE(PG8_SB(0, 0), cB, voffB); PG8_STAGE(PG8_SB(0, 1), cB + hB, voffB); PG8_STAGE(PG8_SA(0, 0), cA, a0c); PG8_STAGE(PG8_SA(0, 1), cA + hA, a1c);
    if (wr == 1) PG8_BAR;
    PG8_WAIT_V(2); PG8_BAR;
    PG8_STAGE(PG8_SB(1, 0), cB + kstep, voffB); PG8_STAGE(PG8_SA(1, 0), cA + kstep, a0c); PG8_STAGE(PG8_SB(1, 1), cB + hB + kstep, voffB);
    PG8_WAIT_V(6); PG8_BAR;
    for (;;) {
        const bool has_next = S.next(ui + 1, nxt);
        const char* nA = has_next ? nxt.a : cA; const char* nB = has_next ? nxt.b : cB;
        if constexpr (GATHER) { if (has_next)
            __builtin_amdgcn_global_load_lds((const unsigned*)(nxt.idx + 4 * lane), (LAS unsigned*)(lds + STAGE_BYTES + wid * 1024), 16, 0, 0); }
#pragma unroll 1
        for (int t = 0; t < nt; t += 2) {
            const bool last = (t == nt - 2);
            const char* a1 = cA + (size_t)(t + 1) * kstep;
            const char* a2 = last ? nA : cA + (size_t)(t + 2) * kstep; const char* b2 = last ? nB : cB + (size_t)(t + 2) * kstep;
            const char* a3 = a2 + kstep; const char* b3 = b2 + kstep;
            PG8_LDB(B0, 0, 0); PG8_LDB(B1, 0, 1); PG8_SCHED; PG8_LDA(At, 0, 0); PG8_STAGE(PG8_SA(1, 1), a1 + hA, a1c);
            if constexpr (GATHER) { if (last && has_next) {
                { const LAS unsigned* ix = (const LAS unsigned*)(lds + STAGE_BYTES + wid * 1024); a0n[0] = ix[gR[0]]; a0n[1] = ix[gR[1]]; a1n[0] = ix[128 + gR[0]]; a1n[1] = ix[128 + gR[1]]; }
                a0c[0] = a0n[0] * (g.lda * 2u) + (unsigned)gC[0] * 2u; a0c[1] = a0n[1] * (g.lda * 2u) + (unsigned)gC[1] * 2u; a1c[0] = a1n[0] * (g.lda * 2u) + (unsigned)gC[0] * 2u; a1c[1] = a1n[1] * (g.lda * 2u) + (unsigned)gC[1] * 2u; } }
            PG8_WAIT_V(8); PG8_WAIT_L(0); PG8_BAR; PG8_MMA(0, 0, At, B0); PG8_MMA(0, 1, At, B1); PG8_BAR; PG8_SCHED;
            PG8_LDA(At, 0, 1); PG8_STAGE(PG8_SB(0, 0), b2, voffB); PG8_STAGE(PG8_SB(0, 1), b2 + hB, voffB); PG8_STAGE(PG8_SA(0, 0), a2, a0c);
            PG8_WAIT_V(8); PG8_WAIT_L(0); PG8_BAR; PG8_MMA(1, 0, At, B0); PG8_MMA(1, 1, At, B1); PG8_BAR; PG8_SCHED;
            PG8_LDB(B0, 1, 0); PG8_LDB(B1, 1, 1); PG8_SCHED; PG8_LDA(At, 1, 0); PG8_STAGE(PG8_SA(0, 1), a2 + hA, a1c);
            PG8_WAIT_V(8); PG8_WAIT_L(0); PG8_BAR; PG8_MMA(0, 0, At, B0); PG8_MMA(0, 1, At, B1); PG8_BAR; PG8_SCHED;
            PG8_LDA(At, 1, 1); PG8_STAGE(PG8_SB(1, 0), b3, voffB); PG8_STAGE(PG8_SB(1, 1), b3 + hB, voffB); PG8_STAGE(PG8_SA(1, 0), a3, a0c);
            PG8_WAIT_V(8); PG8_WAIT_L(0); PG8_BAR; PG8_MMA(1, 0, At, B0); PG8_MMA(1, 1, At, B1); PG8_BAR; PG8_SCHED;
        }
        if constexpr (ALIGN_EPI) { if (wr == 0) PG8_BAR; }
        if constexpr (FP8) asm volatile("s_nop 15\n\ts_nop 15" ::: "memory");
        { int fr_ = fr, fq_ = fq; asm volatile("" : "+v"(fr_), "+v"(fq_)); E(acc, cur, wr, wc, fr_, fq_); }
        if (!has_next) break;
#pragma unroll
        for (int a = 0; a < 2; ++a)
#pragma unroll
            for (int b = 0; b < 2; ++b)
#pragma unroll
                for (int m = 0; m < 4; ++m)
#pragma unroll
                    for (int n = 0; n < 2; ++n) acc[a][b][m][n] = (f32x4){0.f, 0.f, 0.f, 0.f};
        cur = nxt; cA = nA; cB = nB; ++ui;
        if constexpr (ALIGN_EPI) { if (wr == 1) PG8_BAR; }
    }
    PG8_WAIT_V(0);
    if constexpr (!ALIGN_EPI) { if (wr == 0) PG8_BAR; }
    PG8_BAR;
#undef PG8_SA
#undef PG8_SB
#undef PG8_STAGE
#undef PG8_LDA
#undef PG8_IDX
#undef PG8_LD8
#undef PG8_LDB
#undef PG8_MMA
#undef PG8_WAIT_V
#undef PG8_WAIT_L
#undef PG8_BAR
#undef PG8_SCHED
}

typedef const f32x4 (&AccRef)[2][2][4][2];
__device__ __forceinline__ u32x4 pack8(const f32x4 v0, const f32x4 v1) { u32x4 w; w.x = cvt_pk_bf16(v0[0], v0[1]); w.y = cvt_pk_bf16(v0[2], v0[3]); w.z = cvt_pk_bf16(v1[0], v1[1]); w.w = cvt_pk_bf16(v1[2], v1[3]); return w; }

struct EpiBf16 {
    static constexpr bool PERM = true;
    bf16_t* O; int ldc; float scale;
    __device__ __forceinline__ void operator()(AccRef acc, const Unit& u, int wr, int wc, int fr, int fq) const {
        const int row0 = u.orow + wr * 64 + fr, col0 = u.ocol + wc * 32 + 8 * fq;
#pragma unroll
        for (int ai = 0; ai < 2; ++ai)
#pragma unroll
            for (int m = 0; m < 4; ++m) { bf16_t* rowp = O + (size_t)(row0 + ai * HALF + m * 16) * ldc + col0;
#pragma unroll
                for (int bj = 0; bj < 2; ++bj) *(u32x4*)(rowp + bj * HALF) = pack8(acc[ai][bj][m][0] * scale, acc[ai][bj][m][1] * scale); }
    }
};
struct EpiFp8 {
    static constexpr bool PERM = true;
    unsigned char* O; int ldc; float scale;
    __device__ __forceinline__ void operator()(AccRef acc, const Unit& u, int wr, int wc, int fr, int fq) const {
        const int row0 = u.orow + wr * 64 + fr, col0 = u.ocol + wc * 32 + 8 * fq;
#pragma unroll
        for (int ai = 0; ai < 2; ++ai)
#pragma unroll
            for (int m = 0; m < 4; ++m) { unsigned char* rowp = O + (size_t)(row0 + ai * HALF + m * 16) * ldc + col0;
#pragma unroll
                for (int bj = 0; bj < 2; ++bj) { const f32x4 v0 = acc[ai][bj][m][0] * scale, v1 = acc[ai][bj][m][1] * scale; u32x2 w;
                    w.x = cvt4_fp8(clamp448(v0[0]), clamp448(v0[1]), clamp448(v0[2]), clamp448(v0[3])); w.y = cvt4_fp8(clamp448(v1[0]), clamp448(v1[1]), clamp448(v1[2]), clamp448(v1[3]));
                    *(u32x2*)(rowp + bj * HALF) = w; } }
    }
};
struct EpiInProj {
    static constexpr bool PERM = true;
    bf16_t* O; const LAS f32x2* rope;
    __device__ __forceinline__ void operator()(AccRef acc, const Unit& u, int wr, int wc, int fr, int fq) const {
        const int row0 = u.orow + wr * 64 + fr, col0 = u.ocol + wc * 32 + 8 * fq;
        const bool do_rope = (u.ocol < 1024) && (u.orow < ML);
        const float sgn = (fq < 2) ? -1.f : 1.f;
#pragma unroll
        for (int ai = 0; ai < 2; ++ai)
#pragma unroll
            for (int m = 0; m < 4; ++m) { const int row = row0 + ai * HALF + m * 16; bf16_t* rowp = O + (size_t)row * INW + col0;
                f32x2 cs[8];
                if (do_rope) { const int t = row & (T - 1); const int pos = (wc & 1) ? (t & 63) : (t >> 6);
                    const LAS f32x4* rp = (const LAS f32x4*)(rope + pos * 16 + 8 * (fq & 1));
#pragma unroll
                    for (int k = 0; k < 4; ++k) { const f32x4 q = rp[k]; cs[2 * k] = (f32x2){q[0], q[1]}; cs[2 * k + 1] = (f32x2){q[2], q[3]}; } }
#pragma unroll
                for (int bj = 0; bj < 2; ++bj) { f32x4 v0 = acc[ai][bj][m][0], v1 = acc[ai][bj][m][1];
                    if (do_rope) {
#pragma unroll
                        for (int k = 0; k < 4; ++k) { const float p0 = xor32f(v0[k], fq < 2), p1 = xor32f(v1[k], fq < 2);
                            v0[k] = v0[k] * cs[k].x + sgn * p0 * cs[k].y; v1[k] = v1[k] * cs[4 + k].x + sgn * p1 * cs[4 + k].y; } }
                    *(u32x4*)(rowp + bj * HALF) = pack8(v0, v1); } }
    }
};
struct EpiF32 {
    static constexpr bool PERM = false;
    float* C; int ldc;
    __device__ __forceinline__ void operator()(AccRef acc, const Unit& u, int wr, int wc, int fr, int fq) const {
        const int row0 = u.orow + wr * 64 + fr, col0 = u.ocol + wc * 32 + 4 * fq;
#pragma unroll
        for (int ai = 0; ai < 2; ++ai)
#pragma unroll
            for (int m = 0; m < 4; ++m) { float* rowp = C + (size_t)(row0 + ai * HALF + m * 16) * ldc + col0;
#pragma unroll
                for (int bj = 0; bj < 2; ++bj)
#pragma unroll
                    for (int n = 0; n < 2; ++n) *(f32x4*)(rowp + bj * HALF + n * 16) = acc[ai][bj][m][n]; }
    }
};
struct EpiGateUp {
    static constexpr bool PERM = true;
    unsigned char* O;
    __device__ __forceinline__ void operator()(AccRef acc, const Unit& u, int wr, int wc, int fr, int fq) const {
        const int row0 = u.orow + wr * 64 + fr, col0 = u.ocol + wc * 32 + 8 * fq; constexpr float sg = 1.0f / (SX8 * SWG8);
#pragma unroll
        for (int ai = 0; ai < 2; ++ai)
#pragma unroll
            for (int m = 0; m < 4; ++m) { unsigned char* rowp = O + (size_t)(row0 + ai * HALF + m * 16) * FE + col0;
                float h[8];
#pragma unroll
                for (int k = 0; k < 4; ++k) { const float g0 = acc[ai][0][m][0][k] * sg, g1 = acc[ai][0][m][1][k] * sg;
                    h[k] = clamp448(g0 * fast_sigmoid(g0) * acc[ai][1][m][0][k] * (sg * SH8)); h[4 + k] = clamp448(g1 * fast_sigmoid(g1) * acc[ai][1][m][1][k] * (sg * SH8)); }
                u32x2 w; w.x = cvt4_fp8(h[0], h[1], h[2], h[3]); w.y = cvt4_fp8(h[4], h[5], h[6], h[7]); *(u32x2*)rowp = w; }
    }
};
struct EpiF1 {
    static constexpr bool PERM = true;
    bf16_t* GT; bf16_t* GTC;
    __device__ __forceinline__ void operator()(AccRef acc, const Unit& u, int wr, int wc, int fr, int fq) const {
        const int p = u.orow >> 8, pn = u.ocol >> 8, c0 = wr * 64 + fr, t0 = wc * 32 + 8 * fq;
        bf16_t* base; int cs;
        if (pn < 256) { base = GT + ((size_t)(pn >> 4) << 21) + (size_t)p * 4096 + (pn & 15) * 256; cs = 8192; }
        else { base = GTC + (size_t)(pn - 256) * 131072 + p * 256; cs = 512; }
        bf16_t* lp = base + (size_t)c0 * cs + t0;
#pragma unroll
        for (int ai = 0; ai < 2; ++ai)
#pragma unroll
            for (int m = 0; m < 4; ++m) { bf16_t* rp = lp + (size_t)(ai * HALF + m * 16) * cs;
#pragma unroll
                for (int bj = 0; bj < 2; ++bj) *(u32x4*)(rp + bj * HALF) = pack8(acc[ai][bj][m][0], acc[ai][bj][m][1]); }
    }
};

struct EpiF2H {
    static constexpr bool PERM = true;
    float* PQ; bf16_t* CC; unsigned* flags; unsigned epoch;
    __device__ __forceinline__ void operator()(AccRef acc, const Unit& u, int wr, int wc, int fr, int fq) const {
        const int part = u.ocol, b = u.orow >> 3, pm8 = u.orow & 7;
        float* tile = PQ + (size_t)u.orow * 65536; const int r0 = wr * 64 + fr, c0 = wc * 32 + 8 * fq;
        if (part == 0) {
#pragma unroll
            for (int ai = 0; ai < 2; ++ai)
#pragma unroll
                for (int m = 0; m < 4; ++m) { float* rp = tile + (size_t)(r0 + ai * HALF + m * 16) * 256 + c0;
#pragma unroll
                    for (int bj = 0; bj < 2; ++bj) { *(f32x4*)(rp + bj * HALF) = acc[ai][bj][m][0]; *(f32x4*)(rp + bj * HALF + 4) = acc[ai][bj][m][1]; } }
            asm volatile("s_waitcnt vmcnt(0)" ::: "memory"); __builtin_amdgcn_s_barrier();
            if (threadIdx.x == 0) { __builtin_amdgcn_fence(__ATOMIC_RELEASE, "agent"); asm volatile("s_waitcnt vmcnt(0)" ::: "memory"); __hip_atomic_store(flags + u.orow * 64, epoch, __ATOMIC_RELAXED, __HIP_MEMORY_SCOPE_AGENT); }
        } else {
            if (threadIdx.x == 0) { unsigned sp = 0; while (__hip_atomic_load(flags + u.orow * 64, __ATOMIC_RELAXED, __HIP_MEMORY_SCOPE_AGENT) < epoch) { __builtin_amdgcn_s_sleep(2); if (++sp > (1u << 20)) break; }
                __builtin_amdgcn_fence(__ATOMIC_ACQUIRE, "agent"); asm volatile("s_waitcnt vmcnt(0)" ::: "memory"); }
            __builtin_amdgcn_s_barrier(); asm volatile("" ::: "memory");
#pragma unroll
            for (int ai = 0; ai < 2; ++ai)
#pragma unroll
                for (int m = 0; m < 4; ++m) { const int r = r0 + ai * HALF + m * 16, k = pm8 * 256 + r; const float* rp = tile + (size_t)r * 256 + c0;
                    bf16_t* y0 = CC + (size_t)(b * T + k) * D + 768 + c0; bf16_t* y1 = CC + (size_t)(b * T + (T - k)) * D + 768 + c0;
#pragma unroll
                    for (int bj = 0; bj < 2; ++bj) { const f32x4 p0 = __builtin_nontemporal_load((const f32x4*)(rp + bj * HALF)), p1 = __builtin_nontemporal_load((const f32x4*)(rp + bj * HALF + 4));
                        *(u32x4*)(y0 + bj * HALF) = pack8(p0 + acc[ai][bj][m][0], p1 + acc[ai][bj][m][1]);
                        if (k > 0) *(u32x4*)(y1 + bj * HALF) = pack8(p0 - acc[ai][bj][m][0], p1 - acc[ai][bj][m][1]); } }
        }
    }
};

struct SchedPlain {
    int nN, total, G, c; const char* A; const char* B; size_t tA, tB; bool grp8;
    __device__ __forceinline__ bool next(int i, Unit& u) const { const int L = i * G + c; if (L >= total) return false; int pm = L / nN, pn = L - pm * nN;
        if (grp8) { const int gsz = 8 * nN, gi = L / gsz, r = L - gi * gsz; pm = gi * 8 + (r & 7); pn = r >> 3; }
        u.a = A + (size_t)pm * tA; u.b = B + (size_t)pn * tB; u.orow = pm * BM; u.ocol = pn * BM; u.idx = nullptr; return true; }
};
struct SchedF1 {
    int total, G, c; const char* A; const char* B;
    __device__ __forceinline__ bool next(int i, Unit& u) const { const int L = i * G + c; if (L >= total) return false; const int pn = L >> 1, pm = L & 1;
        u.a = A + (size_t)pm * (256 * 256 * 2); u.b = B + (size_t)pn * (256 * (size_t)INW * 2); u.orow = pm * BM; u.ocol = pn * BM; u.idx = nullptr; return true; }
};
struct SchedF2L {
    int G, c; const char* AT; const char* GT;
    __device__ __forceinline__ bool next(int i, Unit& u) const { const int L = i * G + c; if (L >= 256) return false;
        int b = L >> 4, pm = L & 15; if (G == 256) { const int x = L >> 5, w = L & 31; pm = (x & 3) * 4 + (w & 3); b = (x >> 2) * 8 + (w >> 2); }
        u.a = AT + (size_t)pm * (256 * 8192 * 2); u.b = GT + (size_t)b * (256 * 8192 * 2); u.orow = b * T + pm * BM; u.ocol = 768; u.idx = nullptr; return true; }
};
struct SchedF2H {
    int G, c; const char* AT; const char* GT;
    __device__ __forceinline__ bool next(int i, Unit& u) const { const int L = i * G + c; if (L >= 256) return false;
        const int x = L >> 5, w = L & 31, part = w & 1, pm8 = (x & 1) * 4 + ((w >> 1) & 3), b = (x >> 1) * 4 + (w >> 3);
        u.a = AT + (size_t)pm8 * (256 * 8192 * 2) + (size_t)part * (4096 * 2); u.b = GT + (size_t)b * (256 * 8192 * 2) + (size_t)part * (4096 * 2); u.orow = b * 8 + pm8; u.ocol = part; u.idx = nullptr; return true; }
};
struct SchedF2C {
    int G, c; const char* AC; const char* GTC;
    __device__ __forceinline__ bool next(int i, Unit& u) const { const int L = i * G + c; if (L >= 16) return false;
        u.a = AC; u.b = GTC + (size_t)L * (256 * 512 * 2); u.orow = ML + L * TC; u.ocol = 768; u.idx = nullptr; return true; }
};
struct SchedGU {
    int nrt, G, c; const char* XS; const char* W; const int* IDX;
    __device__ __forceinline__ bool next(int i, Unit& u) const { const int L = i * G + c; if (L >= 16 * 16 * nrt) return false;
        const int e = L / (16 * nrt), r = L - e * 16 * nrt;
        const int gi = r >> 6, rr = r & 63, gsz = (nrt - 4 * gi) < 4 ? (nrt - 4 * gi) : 4, half = rr / (gsz * 8), w = rr - half * gsz * 8, rt = gi * 4 + w % gsz, ct = half * 8 + w / gsz;
        const int rowbase = (rt < 32) ? (e * 17 + (rt >> 1)) * 512 + (rt & 1) * 256 : (e * 17 + 16) * 512 + (rt - 32) * 256;
        u.a = XS; u.idx = IDX + rowbase; u.b = W + (size_t)e * (2 * FE * D) + (size_t)ct * (128 * D); u.orow = rowbase; u.ocol = ct * 128; return true; }
};
struct SchedDN {
    int nrt, G, c; const char* HM; const char* W;
    __device__ __forceinline__ bool next(int i, Unit& u) const { const int L = i * G + c; if (L >= 16 * 4 * nrt) return false;
        const int e = L / (4 * nrt), r = L - e * 4 * nrt, rt = r >> 2, ct = r & 3;
        const int rowbase = (rt < 32) ? (e * 17 + (rt >> 1)) * 512 + (rt & 1) * 256 : (e * 17 + 16) * 512 + (rt - 32) * 256;
        u.a = HM + (size_t)rowbase * FE; u.b = W + (size_t)e * (D * FE) + (size_t)ct * (256 * FE); u.orow = rowbase; u.ocol = ct * 256; u.idx = nullptr; return true; }
};
}
namespace att {
constexpr int NW = 8, QBLK = 32, KVBLK = 64, LDZ = INW;
constexpr float SCALE = 0.125f, THR = 8.f;
#ifndef ATT_SDEPTH
#define ATT_SDEPTH 2
#endif
constexpr int SDEPTH = ATT_SDEPTH;
constexpr int SHM_V = KVBLK * 128 * 2, SHM_K = KVBLK * 64 * 2;
#ifndef ATT_RING3
#define ATT_RING3 1
#endif
constexpr int NBUF = ATT_RING3 ? 3 : 2;
constexpr int OFF_V = 0, OFF_K = NBUF * SHM_V, OFF_WS = OFF_K + NBUF * SHM_K, ATT_LDS = OFF_WS + NW * 64 * 4;
#define KSWZ(row, colB) ((row) * 128 + ((colB) ^ ((((row) >> 1) & 7) << 4)))
#define SBAR() __builtin_amdgcn_sched_barrier(0)
__device__ __forceinline__ int crow(int r, int hi) { return (r & 3) + 8 * (r >> 2) + 4 * hi; }
__device__ __forceinline__ void partialSM(f32x16& p0, f32x16& p1, float& m_reg, float& mn, float& alpha) {
  constexpr float C = SCALE * 1.4426950408889634f;
  float pmax = p0[0];
#pragma unroll
  for (int r = 1; r < 16; ++r) pmax = fmaxf(pmax, p0[r]);
#pragma unroll
  for (int r = 0; r < 16; ++r) pmax = fmaxf(pmax, p1[r]);
  { unsigned r0, r1; swap32(__float_as_uint(pmax), r0, r1); pmax = fmaxf(__uint_as_float(r0), __uint_as_float(r1)); }
  if (__builtin_expect(__all(pmax - m_reg <= THR / SCALE), 1)) { mn = m_reg; alpha = 1.f; }
  else { mn = fmaxf(m_reg, pmax); alpha = __builtin_amdgcn_exp2f((m_reg - mn) * C); m_reg = mn; }
  float mnC = -mn * C;
#pragma unroll
  for (int r = 0; r < 16; ++r) p0[r] = fmaf(p0[r], C, mnC);
#pragma unroll
  for (int r = 0; r < 16; ++r) p1[r] = fmaf(p1[r], C, mnC);
#ifndef ABL_NOEXP
#pragma unroll
  for (int r = 0; r < 16; ++r) p0[r] = __builtin_amdgcn_exp2f(p0[r]);
#endif
}
__device__ __forceinline__ void finishSM(f32x16& p0, f32x16& p1, float alpha, float& l_reg, bf16x8& pa0, bf16x8& pa1, bf16x8& pa2, bf16x8& pa3) {
#ifndef ABL_NOEXP
#pragma unroll
  for (int r = 0; r < 16; ++r) p1[r] = __builtin_amdgcn_exp2f(p1[r]);
#endif
  float ps = 0;
#pragma unroll
  for (int r = 0; r < 16; ++r) ps += p0[r];
#pragma unroll
  for (int r = 0; r < 16; ++r) ps += p1[r];
  { unsigned r0, r1; swap32(__float_as_uint(ps), r0, r1); ps = __uint_as_float(r0) + __uint_as_float(r1); }
  l_reg = l_reg * alpha + ps;
#define PK4(P, BASE, OUT) do { unsigned a0 = cvt_pk_bf16(P[BASE + 0], P[BASE + 1]), a1 = cvt_pk_bf16(P[BASE + 2], P[BASE + 3]);   \
    unsigned b0 = cvt_pk_bf16(P[BASE + 4], P[BASE + 5]), b1 = cvt_pk_bf16(P[BASE + 6], P[BASE + 7]);                              \
    auto r0 = __builtin_amdgcn_permlane32_swap(a0, b0, false, false); auto r1 = __builtin_amdgcn_permlane32_swap(a1, b1, false, false); \
    u32x4 w = {r0[0], r1[0], r0[1], r1[1]}; OUT = __builtin_bit_cast(bf16x8, w); } while (0)
  PK4(p0, 0, pa0); PK4(p0, 8, pa1); PK4(p1, 0, pa2); PK4(p1, 8, pa3);
#undef PK4
}
__device__ __forceinline__ void qkt(f32x16& p0, f32x16& p1, const LAS char* Ks, const bf16x8* qr, int r32, int hi) {
#pragma unroll
  for (int r = 0; r < 16; ++r) { p0[r] = 0.f; p1[r] = 0.f; }
#pragma unroll
  for (int d0 = 0; d0 < 4; ++d0) { const int cb = (d0 * 16 + hi * 8) * 2;
    bf16x8 b0 = *(const LAS bf16x8*)(Ks + KSWZ(r32, cb));
    bf16x8 b1 = *(const LAS bf16x8*)(Ks + KSWZ(32 + r32, cb));
    p0 = __builtin_amdgcn_mfma_f32_32x32x16_bf16(b0, qr[d0], p0, 0, 0, 0);
    p1 = __builtin_amdgcn_mfma_f32_32x32x16_bf16(b1, qr[d0], p1, 0, 0, 0); }
}
__device__ __forceinline__ int v_st(int k, int c) { const int kk = (k & ~0xC) | ((k & 4) << 1) | ((k & 8) >> 1); return ((kk >> 3) * 4 + (c >> 5)) * 512 + ((kk & 7) * 32 + (c & 31)) * 2; }
__device__ __forceinline__ int v_rd_base(int lane) { return ((lane & 3) << 3) | (((lane >> 2) & 3) << 6) | (((lane >> 4) & 1) << 5) | (((lane >> 5) & 1) << 8); }
constexpr int v_rd_off(int d0, int ks, int half) { return d0 * 512 + ks * 4096 + half * 2048; }
template <int OFF> __device__ __forceinline__ s16x4 tr_read(int vb) {
  s16x4 r; asm volatile("ds_read_b64_tr_b16 %0, %1 offset:%2" : "=&v"(r) : "v"(vb), "i"(OFF) : "memory"); return r;
}
template <int D0> __device__ __forceinline__ void pv_one(f32x16& od, int vb, bf16x8 pa0, bf16x8 pa1, bf16x8 pa2, bf16x8 pa3) {
  const s16x4 l0 = tr_read<v_rd_off(D0, 0, 0)>(vb), h0 = tr_read<v_rd_off(D0, 0, 1)>(vb), l1 = tr_read<v_rd_off(D0, 1, 0)>(vb), h1 = tr_read<v_rd_off(D0, 1, 1)>(vb);
  const s16x4 l2 = tr_read<v_rd_off(D0, 2, 0)>(vb), h2 = tr_read<v_rd_off(D0, 2, 1)>(vb), l3 = tr_read<v_rd_off(D0, 3, 0)>(vb), h3 = tr_read<v_rd_off(D0, 3, 1)>(vb);
  asm volatile("s_waitcnt lgkmcnt(0)" ::: "memory"); SBAR();
#define PK(L, H) (bf16x8){L[0], L[1], L[2], L[3], H[0], H[1], H[2], H[3]}
  od = __builtin_amdgcn_mfma_f32_32x32x16_bf16(pa0, PK(l0, h0), od, 0, 0, 0);
  od = __builtin_amdgcn_mfma_f32_32x32x16_bf16(pa1, PK(l1, h1), od, 0, 0, 0);
  od = __builtin_amdgcn_mfma_f32_32x32x16_bf16(pa2, PK(l2, h2), od, 0, 0, 0);
  od = __builtin_amdgcn_mfma_f32_32x32x16_bf16(pa3, PK(l3, h3), od, 0, 0, 0);
#undef PK
}
__device__ __forceinline__ void pv_d0(f32x16* o, int vb, bf16x8 pa0, bf16x8 pa1, bf16x8 pa2, bf16x8 pa3) {
  pv_one<0>(o[0], vb, pa0, pa1, pa2, pa3); pv_one<1>(o[1], vb, pa0, pa1, pa2, pa3); pv_one<2>(o[2], vb, pa0, pa1, pa2, pa3); pv_one<3>(o[3], vb, pa0, pa1, pa2, pa3);
}

__device__ __forceinline__ void diff_attn_unit(const bf16_t* __restrict__ Z, bf16_t* __restrict__ CC, float* o1s, const float* __restrict__ gvec, float lam, float gsc,
                                               int qrow0, int h, int seg0, int n0, int seg1, int NT, LAS char* lds, int tid) {
  asm volatile("" : "+v"(tid));
  const int wid = tid >> 6, lane = tid & 63, r32 = lane & 31, hi = lane >> 5;
  LAS char* V_lds = lds + OFF_V; LAS char* K_lds = lds + OFF_K;
  LAS float* ws = (LAS float*)(lds + OFF_WS) + wid * 64; LAS float* li_l = ws; LAS float* al_l = ws + 32;
  const int sr = tid >> 4, sc = (tid & 15) * 8, vst0 = v_st(sr, sc), vst1 = v_st(32 + sr, sc);
  const int kr = tid >> 3, kc = (tid & 7) * 8, kst = KSWZ(kr, kc * 2);
  const int vb0 = (int)(uintptr_t)V_lds + v_rd_base(lane);
  const bf16_t* Vcol = Z + 1024 + h * 128 + sc;
  for (int mp = 0; mp < 2; ++mp) {
    __syncthreads();
    const bf16_t* Kcol = Z + 512 + h * 128 + mp * 64 + kc;
    float m_reg = -1e30f, l_reg = 0; f32x16 o[4]; bf16x8 qr[4];
#pragma unroll
    for (int d = 0; d < 4; ++d)
#pragma unroll
      for (int r = 0; r < 16; ++r) o[d][r] = 0.f;
    const bf16_t* Qw = Z + (size_t)(qrow0 + wid * QBLK + r32) * LDZ + h * 128 + mp * 64 + hi * 8;
#pragma unroll
    for (int d0 = 0; d0 < 4; ++d0) qr[d0] = *(const bf16x8*)(Qw + d0 * 16);
    struct { bf16x8 vs0, vs1, ks; } sr_[SDEPTH];
#define TROW(j) ((j) < n0 ? seg0 + (j) * KVBLK : seg1 + ((j) - n0) * KVBLK)
#define SLOAD(i, j) do { const int _k0 = TROW(j); sr_[i].vs0 = *(const bf16x8*)(Vcol + (size_t)(_k0 + sr) * LDZ); sr_[i].vs1 = *(const bf16x8*)(Vcol + (size_t)(_k0 + 32 + sr) * LDZ); \
    sr_[i].ks = *(const bf16x8*)(Kcol + (size_t)(_k0 + kr) * LDZ); } while (0)
#define SWRITE(b, i) do { *(LAS bf16x8*)(V_lds + (b) * SHM_V + vst0) = sr_[i].vs0; *(LAS bf16x8*)(V_lds + (b) * SHM_V + vst1) = sr_[i].vs1; \
    *(LAS bf16x8*)(K_lds + (b) * SHM_K + kst) = sr_[i].ks; } while (0)
#define SWAIT() do { if constexpr (SDEPTH == 2) asm volatile("s_waitcnt vmcnt(3)" ::: "memory"); else asm volatile("s_waitcnt vmcnt(0)" ::: "memory"); } while (0)
#define RESC(a) do { if (__any((a) < 1.f)) { if (hi == 0) al_l[r32] = (a); asm volatile("s_waitcnt lgkmcnt(0)" ::: "memory"); \
    _Pragma("unroll") for (int d = 0; d < 4; ++d) _Pragma("unroll") for (int r = 0; r < 16; ++r) o[d][r] *= al_l[crow(r, hi)]; } } while (0)
    f32x16 pA0, pA1, pB0, pB1; float mnA, mnB, alA, alB; bf16x8 pa0, pa1, pa2, pa3;
    constexpr int SE = 0, SO = SDEPTH - 1;
    SLOAD(SE, 0); asm volatile("s_waitcnt vmcnt(0)" ::: "memory"); SWRITE(0, SE); __syncthreads();
    qkt(pA0, pA1, K_lds, qr, r32, hi); partialSM(pA0, pA1, m_reg, mnA, alA);
    SLOAD(SO, 1); if constexpr (SDEPTH == 2) { if (2 < NT) SLOAD(SE, 2); }
    SWAIT(); SWRITE(1, SO); __syncthreads();
#if ATT_RING3
    int b0 = 0, b1 = 1, b2 = 2;
    for (int j = 1; j + 1 < NT; j += 2) {
      SBAR(); qkt(pB0, pB1, K_lds + b1 * SHM_K, qr, r32, hi);
      finishSM(pA0, pA1, alA, l_reg, pa0, pa1, pa2, pa3); SBAR();
      SLOAD(SO, j + SDEPTH); SBAR();
      pv_d0(o, vb0 + b0 * SHM_V, pa0, pa1, pa2, pa3); partialSM(pB0, pB1, m_reg, mnB, alB);
      SWAIT(); SWRITE(b2, SE);
      RESC(alB); __syncthreads();
      SBAR(); qkt(pA0, pA1, K_lds + b2 * SHM_K, qr, r32, hi);
      finishSM(pB0, pB1, alB, l_reg, pa0, pa1, pa2, pa3); SBAR();
      if (SDEPTH == 1 || j + 3 < NT) SLOAD(SE, j + 1 + SDEPTH); SBAR();
      pv_d0(o, vb0 + b1 * SHM_V, pa0, pa1, pa2, pa3); partialSM(pA0, pA1, m_reg, mnA, alA);
      SWAIT(); SWRITE(b0, SO);
      RESC(alA); __syncthreads();
      { const int t0_ = b0; b0 = b2; b2 = b1; b1 = t0_; }
    }
    SBAR(); qkt(pB0, pB1, K_lds + b1 * SHM_K, qr, r32, hi);
    finishSM(pA0, pA1, alA, l_reg, pa0, pa1, pa2, pa3); SBAR();
    pv_d0(o, vb0 + b0 * SHM_V, pa0, pa1, pa2, pa3); partialSM(pB0, pB1, m_reg, mnB, alB);
    RESC(alB);
    finishSM(pB0, pB1, alB, l_reg, pa0, pa1, pa2, pa3); SBAR();
    pv_d0(o, vb0 + b1 * SHM_V, pa0, pa1, pa2, pa3);
#else
    for (int j = 1; j + 1 < NT; j += 2) {
      SBAR(); qkt(pB0, pB1, K_lds + SHM_K, qr, r32, hi);
      finishSM(pA0, pA1, alA, l_reg, pa0, pa1, pa2, pa3); SBAR();
      SLOAD(SO, j + SDEPTH); SBAR();
      pv_d0(o, vb0, pa0, pa1, pa2, pa3); partialSM(pB0, pB1, m_reg, mnB, alB);
      __syncthreads(); SWAIT(); SWRITE(0, SE);
      RESC(alB); __syncthreads();
      SBAR(); qkt(pA0, pA1, K_lds, qr, r32, hi);
      finishSM(pB0, pB1, alB, l_reg, pa0, pa1, pa2, pa3); SBAR();
      if (SDEPTH == 1 || j + 3 < NT) SLOAD(SE, j + 1 + SDEPTH); SBAR();
      pv_d0(o, vb0 + SHM_V, pa0, pa1, pa2, pa3); partialSM(pA0, pA1, m_reg, mnA, alA);
      __syncthreads(); SWAIT(); SWRITE(1, SO);
      RESC(alA); __syncthreads();
    }
    SBAR(); qkt(pB0, pB1, K_lds + SHM_K, qr, r32, hi);
    finishSM(pA0, pA1, alA, l_reg, pa0, pa1, pa2, pa3); SBAR();
    pv_d0(o, vb0, pa0, pa1, pa2, pa3); partialSM(pB0, pB1, m_reg, mnB, alB);
    __syncthreads(); RESC(alB);
    finishSM(pB0, pB1, alB, l_reg, pa0, pa1, pa2, pa3); SBAR();
    pv_d0(o, vb0 + SHM_V, pa0, pa1, pa2, pa3);
#endif
    if (hi == 0) li_l[r32] = l_reg; asm volatile("s_waitcnt lgkmcnt(0)" ::: "memory");
    float rli[16];
#pragma unroll
    for (int r = 0; r < 16; ++r) rli[r] = __builtin_amdgcn_rcpf(li_l[crow(r, hi)]);
    float* op = o1s + tid * 64;
    if (mp == 0) {
#pragma unroll
      for (int d0 = 0; d0 < 4; ++d0)
#pragma unroll
        for (int r4 = 0; r4 < 4; ++r4) *(f32x4*)(op + d0 * 16 + r4 * 4) = (f32x4){o[d0][4 * r4] * rli[4 * r4], o[d0][4 * r4 + 1] * rli[4 * r4 + 1], o[d0][4 * r4 + 2] * rli[4 * r4 + 2], o[d0][4 * r4 + 3] * rli[4 * r4 + 3]};
    } else {
      float ss[16];
#pragma unroll
      for (int r = 0; r < 16; ++r) ss[r] = 0.f;
#pragma unroll
      for (int d0 = 0; d0 < 4; ++d0)
#pragma unroll
        for (int r4 = 0; r4 < 4; ++r4) { const f32x4 o1 = __builtin_nontemporal_load((const f32x4*)(op + d0 * 16 + r4 * 4));
#pragma unroll
          for (int k = 0; k < 4; ++k) { const int r = 4 * r4 + k; const float v = o1[k] - lam * (o[d0][r] * rli[r]); o[d0][r] = v; ss[r] += v * v; } }
#pragma unroll
      for (int r = 0; r < 16; ++r) {
        ss[r] = row32_sum(ss[r]);
        ss[r] = __builtin_amdgcn_rsqf(ss[r] * (1.0f / 128.0f) + RMS_EPS) * gsc; }
      float gg[4];
#pragma unroll
      for (int d0 = 0; d0 < 4; ++d0) gg[d0] = gvec[h * 128 + d0 * 32 + r32];
      bf16_t* Ow = CC + (size_t)(qrow0 + wid * QBLK) * D + h * 128 + r32;
#pragma unroll
      for (int r = 0; r < 16; ++r) { int roff = crow(r, hi) * D; asm volatile("" : "+v"(roff)); bf16_t* rp = Ow + roff;
#pragma unroll
        for (int d0 = 0; d0 < 4; ++d0) rp[d0 * 32] = (bf16_t)f2bf(o[d0][r] * ss[r] * gg[d0]); }
    }
#undef TROW
#undef SLOAD
#undef SWRITE
#undef SWAIT
#undef RESC
  }
}
#undef KSWZ
}
struct Args { const float* in[28]; float* out; unsigned char* ws; int ph_lo, ph_hi, li, pad; };
struct Frame {
    LAS unsigned char* lds;
    int tid, lane, wave, vcu, G;
    unsigned char* ws;
};
enum { I_X = 0, I_C, I_CTX, I_CCTX, I_WMOD, I_BMOD, I_WIN, I_LQ1, I_LK1, I_LQ2, I_LK2, I_ANG, I_CONVW, I_CONVB, I_LWA, I_LBA, I_LWX, I_LBX, I_LLAM, I_WOUT,
       I_LN1G, I_LN1B, I_WR, I_WG, I_WU, I_WD, I_LN2G, I_LN2B };

__device__ __forceinline__ void transpose_item(const float* W, int N, bf16_t* WT, int ldt, LAS float* scr, int kb, int nb, int lane) {
    const int k0 = 64 * kb, n0 = 32 * nb;
#pragma unroll 8
    for (int i = 0; i < 32; ++i) { const int kk = 2 * i + (lane >> 5); scr[kk * 33 + (lane & 31)] = W[(size_t)(k0 + kk) * N + n0 + (lane & 31)]; }
    LDS_WAIT(); asm volatile("" ::: "memory");
    const int c = lane & 7;
#pragma unroll
    for (int j = 0; j < 4; ++j) { const int n = (lane >> 3) + 8 * j; const LAS float* s = scr + (8 * c) * 33 + n;
        u32x4 o; o.x = pk2(s[0 * 33], s[1 * 33]); o.y = pk2(s[2 * 33], s[3 * 33]); o.z = pk2(s[4 * 33], s[5 * 33]); o.w = pk2(s[6 * 33], s[7 * 33]);
        *(u32x4*)(WT + (size_t)(n0 + n) * ldt + k0 + 8 * c) = o; }
    LDS_WAIT(); asm volatile("" ::: "memory");
}

__device__ __forceinline__ void p0a(Frame& F, const Args& args) {
    const int gw = F.vcu * NWAVES + F.wave, NGW = F.G * NWAVES;
    LAS float* scr = (LAS float*)(F.lds + F.wave * 16384);
    { constexpr int IA = 16 * 72, IB = 16 * 32, PER = IA + IB;
      for (int it = gw; it < DEPTH * PER; it += NGW) { const int l = it / PER, r = it - l * PER;
        if (r < IA) transpose_item(args.in[I_WIN] + (size_t)l * D * INW, INW, (bf16_t*)(F.ws + WS_WIN) + (size_t)l * INW * D, D, scr, r / 72, r % 72, F.lane);
        else { const int r2 = r - IA; transpose_item(args.in[I_WOUT] + (size_t)l * D * D, D, (bf16_t*)(F.ws + WS_WOUT) + (size_t)l * D * D, D, scr, r2 / 32, r2 % 32, F.lane); } } }
    __syncthreads();
    { LAS float* sl = (LAS float*)F.lds;
      LAS float* cmb = sl + 17 * 1024;
      bool loaded = false;
      for (int it = F.vcu; it < DEPTH * 24; it += F.G) {
        if (!loaded) { for (int i = F.tid; i < 17 * 1024; i += NTHR) { const float c = (i < 16 * 1024) ? args.in[I_C][i] : args.in[I_CCTX][i - 16 * 1024]; sl[i] = c * fast_sigmoid(c); } loaded = true; }
        __syncthreads();
        const int l = it / 24, nb = it % 24, col = nb * 256 + (F.tid & 255), kh = F.tid >> 8;
        const float* wp = args.in[I_WMOD] + (size_t)l * D * 6144 + (size_t)(kh * 512) * 6144 + col;
        float acc[17];
#pragma unroll
        for (int j = 0; j < 17; ++j) acc[j] = 0.f;
        const float* wq = wp; float w0 = wq[0], w1 = wq[6144], w2 = wq[2 * 6144], w3 = wq[3 * 6144];
#pragma unroll 1
        for (int k = 0; k < 512; k += 4) {
            wq += 4 * 6144; const bool more = (k + 4 < 512);
            const float n0 = more ? wq[0] : 0.f, n1 = more ? wq[6144] : 0.f, n2 = more ? wq[2 * 6144] : 0.f, n3 = more ? wq[3 * 6144] : 0.f;
#pragma unroll
            for (int j = 0; j < 17; ++j) { const f32x4 s = *(const LAS f32x4*)(sl + j * 1024 + kh * 512 + k); acc[j] += s[0] * w0 + s[1] * w1 + s[2] * w2 + s[3] * w3; }
            w0 = n0; w1 = n1; w2 = n2; w3 = n3; }
        if (kh == 1) {
#pragma unroll
            for (int j = 0; j < 17; ++j) cmb[j * 256 + (F.tid & 255)] = acc[j]; }
        __syncthreads();
        if (kh == 0) { const float bm = args.in[I_BMOD][l * 6144 + col]; float* mo = (float*)(F.ws + WS_MOD) + (size_t)l * 17 * 6144 + col;
#pragma unroll
            for (int j = 0; j < 17; ++j) mo[(size_t)j * 6144] = acc[j] + cmb[j * 256 + (F.tid & 255)] + bm; }
        __syncthreads(); } }
    __syncthreads();
    { LAS f32x2* tab = (LAS f32x2*)F.lds;
      for (int r = F.tid; r < 4096; r += NTHR) { float s, c; sincospif((float)r * (1.0f / 2048.0f), &s, &c); tab[r] = (f32x2){c, s}; }
      __syncthreads();
      bf16_t* AT = (bf16_t*)(F.ws + WS_AT);
      for (int k = F.vcu; k < 2048; k += F.G) {
        for (int c8 = F.tid; c8 < 1024; c8 += NTHR) { const int half = c8 >> 9, t0 = (c8 & 511) * 8; unsigned w[4];
#pragma unroll
            for (int q = 0; q < 4; ++q) { const f32x2 e0 = tab[(k * (t0 + 2 * q)) & 4095], e1 = tab[(k * (t0 + 2 * q + 1)) & 4095];
                w[q] = half ? pk2(-e0.y * (1.f / 64.f), -e1.y * (1.f / 64.f)) : pk2(e0.x * (1.f / 64.f), e1.x * (1.f / 64.f)); }
            *(u32x4*)(AT + (size_t)k * 8192 + half * 4096 + t0) = (u32x4){w[0], w[1], w[2], w[3]}; } }
      bf16_t* AC = (bf16_t*)(F.ws + WS_SMALL + SM_AC);
      for (int i = gw * 64 + F.lane; i < 256 * 512; i += NGW * 64) { const int k = i >> 9, c = i & 511, half = c >> 8, t = c & 255; const f32x2 e = tab[((k * t) & 255) * 16];
        AC[i] = (bf16_t)f2bf(half ? -e.y * (1.f / 16.f) : e.x * (1.f / 16.f)); }
      bf16_t* DC = (bf16_t*)(F.ws + WS_SMALL + SM_DC);
      for (int i = gw * 64 + F.lane; i < 512 * 256; i += NGW * 64) { const int r = i >> 8, col = i & 255, p = r >> 8, g = (r >> 6) & 3, cp = r & 63, g2 = col >> 6, c = col & 63;
        const f32x2 e = tab[((c * cp) & 63) * 64]; DC[i] = (bf16_t)((g == g2) ? f2bf((p ? e.y : e.x) * 0.125f) : 0u); }
    }
    { bf16_t* LW = (bf16_t*)(F.ws + WS_SMALL + SM_LRUW);
      for (int i = gw * 64 + F.lane; i < 4 * 2 * 2 * 4 * 4096; i += NGW * 64) { const int k = i & 63, n = (i >> 6) & 63, blk = (i >> 12) & 3, gate = (i >> 14) & 1, ld = i >> 15;
        const float* src = (gate ? args.in[I_LWX] : args.in[I_LWA]) + ((size_t)(ld * 4 + blk) * 64 + k) * 64 + n; LW[i] = (bf16_t)f2bf(*src); } }
    if (F.vcu == 0 && F.wave == 0) { float* lamv = (float*)(F.ws + WS_SMALL + SM_LAM);
      for (int l = 0; l < DEPTH; ++l) { const float a = wave_sum(args.in[I_LQ1][l * 64 + F.lane] * args.in[I_LK1][l * 64 + F.lane]), b = wave_sum(args.in[I_LQ2][l * 64 + F.lane] * args.in[I_LK2][l * 64 + F.lane]);
        const float li = 0.8f - 0.6f * expf(-0.3f * (float)l); if (F.lane == 0) lamv[l] = expf(a) - expf(b) + li; } }
    __syncthreads();
}

__device__ __forceinline__ void ln_mod_store(const f32x4 (&v)[4], const float* md_sh, const float* md_sc, bf16_t* hrow, int lane) {
    float s = 0.f;
#pragma unroll
    for (int q = 0; q < 4; ++q) s += (v[q][0] + v[q][1]) + (v[q][2] + v[q][3]);
    const float mean = wave_sum(s) * (1.f / D); float s2 = 0.f; f32x4 d[4];
#pragma unroll
    for (int q = 0; q < 4; ++q) { d[q] = v[q] - mean; s2 += (d[q][0] * d[q][0] + d[q][1] * d[q][1]) + (d[q][2] * d[q][2] + d[q][3] * d[q][3]); }
    const float rstd = __builtin_amdgcn_rsqf(wave_sum(s2) * (1.f / D) + LN_EPS);
#pragma unroll
    for (int q = 0; q < 4; ++q) { const int col = 4 * lane + 256 * q; const f32x4 sh = *(const f32x4*)(md_sh + col), sc = *(const f32x4*)(md_sc + col);
        const f32x4 h = d[q] * rstd * (sc + 1.0f) + sh; u32x2 w; w.x = cvt_pk_bf16(h[0], h[1]); w.y = cvt_pk_bf16(h[2], h[3]); *(u32x2*)(hrow + col) = w; }
}
__device__ __forceinline__ void p0b(Frame& F, const Args& args) {
    const int gw = F.vcu * NWAVES + F.wave, NGW = F.G * NWAVES;
    bf16_t* H = (bf16_t*)(F.ws + WS_H); const float* mod = (const float*)(F.ws + WS_MOD);
#define SRCROW(mm) ((mm) < ML ? args.in[I_X] + (size_t)(mm) * D : args.in[I_CTX] + (size_t)((mm) - ML) * D)
    f32x4 vn[4];
    if (gw < M) {
#pragma unroll
        for (int q = 0; q < 4; ++q) vn[q] = *(const f32x4*)(SRCROW(gw) + 4 * F.lane + 256 * q); }
    for (int m = gw; m < M; m += NGW) { const int j = m < ML ? (m >> 12) : 16;
        f32x4 v[4], shp[4], scp[4]; const float* md = mod + (size_t)j * 6144;
#pragma unroll
        for (int q = 0; q < 4; ++q) { v[q] = vn[q]; shp[q] = *(const f32x4*)(md + 4 * F.lane + 256 * q); scp[q] = *(const f32x4*)(md + D + 4 * F.lane + 256 * q); }
        asm volatile("" ::: "memory");
        if (m + NGW < M) {
#pragma unroll
            for (int q = 0; q < 4; ++q) vn[q] = *(const f32x4*)(SRCROW(m + NGW) + 4 * F.lane + 256 * q); }
        asm volatile("" ::: "memory");
        float s = 0.f;
#pragma unroll
        for (int q = 0; q < 4; ++q) s += (v[q][0] + v[q][1]) + (v[q][2] + v[q][3]);
        const float mean = wave_sum(s) * (1.f / D); float s2 = 0.f;
#pragma unroll
        for (int q = 0; q < 4; ++q) { v[q] = v[q] - mean; s2 += (v[q][0] * v[q][0] + v[q][1] * v[q][1]) + (v[q][2] * v[q][2] + v[q][3] * v[q][3]); }
        const float rstd = __builtin_amdgcn_rsqf(wave_sum(s2) * (1.f / D) + LN_EPS);
#pragma unroll
        for (int q = 0; q < 4; ++q) { const f32x4 h = v[q] * rstd * (scp[q] + 1.0f) + shp[q]; u32x2 w; w.x = cvt_pk_bf16(h[0], h[1]); w.y = cvt_pk_bf16(h[2], h[3]); *(u32x2*)(H + (size_t)m * D + 4 * F.lane + 256 * q) = w; } }
#undef SRCROW
}

__device__ __forceinline__ void pw_item(const float* W, int N, unsigned char* WT, int ldt, LAS float* scr, int kb, int nb, int tid, float scale) {
    const int wave = tid >> 6, lane = tid & 63, k0 = 128 * kb, n0 = 256 * nb;
    const float* src = W + (size_t)(k0 + wave * 16) * N + n0 + lane * 4;
#pragma unroll
    for (int i = 0; i < 16; ++i) *(LAS f32x4*)(scr + (wave * 16 + i) * 260 + lane * 4) = *(const f32x4*)(src + (size_t)i * N);
    __syncthreads();
    const int n = tid & 255, kh = tid >> 8; const LAS float* s = scr + (64 * kh) * 260 + n; unsigned char* dst = WT + (size_t)(n0 + n) * ldt + k0 + 64 * kh;
#pragma unroll
    for (int h = 0; h < 4; ++h) { unsigned w[4];
#pragma unroll
        for (int g = 0; g < 4; ++g) { const LAS float* p = s + (16 * h + 4 * g) * 260; w[g] = cvt4_fp8(p[0] * scale, p[260] * scale, p[520] * scale, p[780] * scale); }
        *(u32x4*)(dst + 16 * h) = (u32x4){w[0], w[1], w[2], w[3]}; }
    __syncthreads();
}
__device__ __forceinline__ void pw_experts(Frame& F, const Args& args, int l) {
    LAS float* scr = (LAS float*)F.lds;
    unsigned char* WGU = F.ws + WS_WEXP; unsigned char* WDN = F.ws + WS_WDN;
    for (int it = F.vcu; it < NE * 192; it += F.G) { const int e = it / 192, r = it - e * 192, which = r >> 6, q = r & 63;
        if (which < 2) pw_item(args.in[which ? I_WU : I_WG] + ((size_t)l * NE + e) * D * FE, FE, WGU + ((size_t)e * 2 + which) * FE * D, D, scr, q >> 3, q & 7, F.tid, SWG8);
        else pw_item(args.in[I_WD] + ((size_t)l * NE + e) * FE * D, D, WDN + (size_t)e * D * FE, FE, scr, q >> 2, q & 3, F.tid, SWD8); }
}

__device__ __forceinline__ void pe_phase(Frame& F, const Args& args, int l, int nrows) {
    const int gw = F.vcu * NWAVES + F.wave, NGW = F.G * NWAVES;
    LAS f32x4* WR4 = (LAS f32x4*)F.lds;
    { const float* wr = args.in[I_WR] + (size_t)l * D * NE;
      for (int i = F.tid; i < 16 * 4 * 64; i += NTHR) { const int ln = i & 63, e4 = (i >> 6) & 3, qi = i >> 8, q = qi >> 2, ii = qi & 3; WR4[i] = *(const f32x4*)(wr + (size_t)(4 * ln + ii + 256 * q) * NE + 4 * e4); } }
    __syncthreads();
    float* X = (float*)(F.ws + WS_X); const bf16_t* MIX = (const bf16_t*)(F.ws + WS_ZR); unsigned char* H8 = F.ws + WS_H; float* SC = (float*)(F.ws + WS_SC);
    const float* mod = (const float*)(F.ws + WS_MOD) + (size_t)l * 17 * 6144;
    const float* g1p = args.in[I_LN1G] + l * D; const float* b1p = args.in[I_LN1B] + l * D;
    f32x4 xn[4]; u32x2 mn[4];
    const float* Xin0 = (l == 0) ? args.in[I_X] : X; const float* Xin1 = (l == 0) ? args.in[I_CTX] - (size_t)ML * D : X;
#define XROW(mm) (((mm) < ML ? Xin0 : Xin1) + (size_t)(mm) * D)
    if (gw < nrows) {
#pragma unroll
        for (int q = 0; q < 4; ++q) { const int col = 4 * F.lane + 256 * q; xn[q] = *(const f32x4*)(XROW(gw) + col); mn[q] = *(const u32x2*)(MIX + (size_t)gw * D + col); } }
    f32x4 g1r[4], b1r[4];
#pragma unroll
    for (int q = 0; q < 4; ++q) { g1r[q] = *(const f32x4*)(g1p + 4 * F.lane + 256 * q); b1r[q] = *(const f32x4*)(b1p + 4 * F.lane + 256 * q); }
    for (int m = gw; m < nrows; m += NGW) { const int j = m < ML ? (m >> 12) : 16; const float* md = mod + (size_t)j * 6144;
        f32x4 v[4], gm[4], sh2[4], sc2[4]; float s = 0.f;
#pragma unroll
        for (int q = 0; q < 4; ++q) { const int col = 4 * F.lane + 256 * q; gm[q] = *(const f32x4*)(md + 2 * D + col); }
#pragma unroll
        for (int q = 0; q < 4; ++q) { const int col = 4 * F.lane + 256 * q; sh2[q] = *(const f32x4*)(md + 3 * D + col); sc2[q] = *(const f32x4*)(md + 4 * D + col); }
#pragma unroll
        for (int q = 0; q < 4; ++q) { const f32x4 mx4 = (f32x4){bflo(mn[q].x), bfhi(mn[q].x), bflo(mn[q].y), bfhi(mn[q].y)};
            v[q] = xn[q] * DN_ALPHA + gm[q] * mx4; s += (v[q][0] + v[q][1]) + (v[q][2] + v[q][3]); }
        asm volatile("" ::: "memory");
        if (m + NGW < nrows) {
#pragma unroll
            for (int q = 0; q < 4; ++q) { const int col = 4 * F.lane + 256 * q; xn[q] = *(const f32x4*)(XROW(m + NGW) + col); mn[q] = *(const u32x2*)(MIX + (size_t)(m + NGW) * D + col); } }
        asm volatile("" ::: "memory");
        const float mean = wave_sum(s) * (1.f / D); float s2 = 0.f;
#pragma unroll
        for (int q = 0; q < 4; ++q) { v[q] = v[q] - mean; s2 += (v[q][0] * v[q][0] + v[q][1] * v[q][1]) + (v[q][2] * v[q][2] + v[q][3] * v[q][3]); }
        const float rstd = __builtin_amdgcn_rsqf(wave_sum(s2) * (1.f / D) + LN_EPS); s = 0.f;
#pragma unroll
        for (int q = 0; q < 4; ++q) { const int col = 4 * F.lane + 256 * q; v[q] = v[q] * rstd * g1r[q] + b1r[q]; *(f32x4*)(X + (size_t)m * D + col) = v[q];
            s += (v[q][0] + v[q][1]) + (v[q][2] + v[q][3]); }
        const float mean2 = wave_sum(s) * (1.f / D); s2 = 0.f;
#pragma unroll
        for (int q = 0; q < 4; ++q) { v[q] = v[q] - mean2; s2 += (v[q][0] * v[q][0] + v[q][1] * v[q][1]) + (v[q][2] * v[q][2] + v[q][3] * v[q][3]); }
        const float rstd2 = __builtin_amdgcn_rsqf(wave_sum(s2) * (1.f / D) + LN_EPS);
        float lg[16];
#pragma unroll
        for (int e = 0; e < 16; ++e) lg[e] = 0.f;
#pragma unroll
        for (int q = 0; q < 4; ++q) { const int col = 4 * F.lane + 256 * q;
            const f32x4 h = v[q] * rstd2 * (sc2[q] + 1.0f) + sh2[q]; *(unsigned*)(H8 + (size_t)m * D + col) = cvt4_fp8(clamp448(h[0] * SX8), clamp448(h[1] * SX8), clamp448(h[2] * SX8), clamp448(h[3] * SX8));
#pragma unroll
            for (int ii = 0; ii < 4; ++ii)
#pragma unroll
                for (int e4 = 0; e4 < 4; ++e4) { const f32x4 w4 = WR4[((q * 4 + ii) * 4 + e4) * 64 + F.lane];
#pragma unroll
                    for (int k = 0; k < 4; ++k) lg[e4 * 4 + k] += h[ii] * w4[k]; } }
        float r1[8], r2[4];
#pragma unroll
        for (int k = 0; k < 8; ++k) { const float ta = lg[k] + xor32f(lg[k], F.lane < 32), tb = lg[k + 8] + xor32f(lg[k + 8], F.lane < 32); r1[k] = (F.lane & 32) ? tb : ta; }
#pragma unroll
        for (int k = 0; k < 4; ++k) { const float ta = r1[k] + swz16f(r1[k]), tb = r1[k + 4] + swz16f(r1[k + 4]); r2[k] = (F.lane & 16) ? tb : ta; }
        float mx = -1e30f;
#pragma unroll
        for (int k = 0; k < 4; ++k) { float t = r2[k]; t += dppf<0xB1>(t); t += dppf<0x4E>(t); t += dppf<0x141>(t); t += dppf<0x140>(t); r2[k] = t; mx = fmaxf(mx, t); }
        mx = fmaxf(mx, swz16f(mx)); mx = fmaxf(mx, xor32f(mx, F.lane < 32));
        float se = 0.f;
#pragma unroll
        for (int k = 0; k < 4; ++k) { r2[k] = __expf(r2[k] - mx); se += r2[k]; }
        se += swz16f(se); se += xor32f(se, F.lane < 32);
        const float inv = 1.0f / se;
        if ((F.lane & 15) == 0) *(f32x4*)(SC + (size_t)m * NE + 4 * (F.lane >> 4)) = (f32x4){r2[0] * inv, r2[1] * inv, r2[2] * inv, r2[3] * inv}; }
#undef XROW
    __syncthreads();
}

__device__ __forceinline__ int block_sum_i(LAS int* red, int v, int wave, int lane) {
    v = wave_sum_i(v);
    if (lane == 0) red[wave] = v;
    __syncthreads();
    int s = 0;
#pragma unroll
    for (int w = 0; w < 8; ++w) s += red[w];
    return s;
}
__device__ __forceinline__ int lower_lanes(unsigned long long m) { return (int)__builtin_amdgcn_mbcnt_hi((unsigned)(m >> 32), __builtin_amdgcn_mbcnt_lo((unsigned)m, 0u)); }
__device__ __forceinline__ void topk_pair(Frame& F, const float* SC, int* TM, int m0, int n, int e, int cap, int yrow0, LAS int* sel, LAS int* red) {
    unsigned key[8];
#pragma unroll
    for (int k = 0; k < 8; ++k) { const int t = k * NTHR + F.tid; key[k] = (t < n) ? __builtin_bit_cast(unsigned, SC[(size_t)(m0 + t) * NE + e]) : 0u; }
    unsigned v = 0u; int it = 0;
    for (int shift = 28; shift >= -2; shift -= 3, ++it) { const int sh = shift < 0 ? 0 : shift; const unsigned jmax = shift < 0 ? 1u : 7u;
        int c[8];
#pragma unroll
        for (int j = 0; j < 8; ++j) c[j] = 0;
#pragma unroll
        for (int k = 0; k < 8; ++k) { const unsigned t = key[k] >= v ? min((key[k] - v) >> sh, jmax) : 0u;
#pragma unroll
            for (int j = 1; j < 8; ++j) c[j] += (t >= (unsigned)j) ? 1 : 0; }
        int pk[4];
#pragma unroll
        for (int q = 0; q < 4; ++q) pk[q] = wave_sum_i(c[2 * q] | (c[2 * q + 1] << 16));
        LAS int* rb = red + (it & 1) * 32;
        if (F.lane == 0) {
#pragma unroll
            for (int q = 0; q < 4; ++q) rb[F.wave * 4 + q] = pk[q]; }
        __syncthreads();
        int tot[4] = {0, 0, 0, 0};
#pragma unroll
        for (int w = 0; w < 8; ++w)
#pragma unroll
            for (int q = 0; q < 4; ++q) tot[q] += rb[w * 4 + q];
        unsigned best = 0u;
#pragma unroll
        for (int j = 1; j < 8; ++j) { const int cj = (j & 1) ? (tot[j >> 1] >> 16) : (tot[j >> 1] & 0xffff); if (cj >= cap && (unsigned)j <= jmax) best = (unsigned)j; }
        v |= best << sh; }
    LAS int* cgt = red + 64; LAS int* ceq = red + 64 + 64;
    __syncthreads();
    int lg[8], le[8];
#pragma unroll
    for (int k = 0; k < 8; ++k) { const unsigned long long mg = __builtin_amdgcn_ballot_w64(key[k] > v), me = __builtin_amdgcn_ballot_w64(key[k] == v);
        lg[k] = lower_lanes(mg); le[k] = lower_lanes(me);
        if (F.lane == 0) { cgt[k * 8 + F.wave] = __builtin_popcountll(mg); ceq[k * 8 + F.wave] = __builtin_popcountll(me); } }
    __syncthreads();
    int tot_gt = 0;
    for (int i = 0; i < 64; ++i) tot_gt += cgt[i];
    const int need_eq = cap - tot_gt;
    int gb = 0, eb = 0, idx = 0;
#pragma unroll
    for (int k = 0; k < 8; ++k) {
        for (; idx < k * 8 + F.wave; ++idx) { gb += cgt[idx]; eb += ceq[idx]; }
        const int t = k * NTHR + F.tid;
        if (t < n) { const bool gt = key[k] > v, eq = key[k] == v; const int myg = gb + lg[k], mye = eb + le[k];
            const bool selx = gt || (eq && mye < need_eq); const int slot = myg + (mye < need_eq ? mye : need_eq);
            if (selx) sel[slot] = m0 + t;
            TM[(size_t)(m0 + t) * NE + e] = selx ? (yrow0 + slot) : -1; } }
    __syncthreads();
}
__device__ __forceinline__ void pk_phase(Frame& F, bool with_ctx) {
    LAS int* sel = (LAS int*)F.lds; LAS int* red = sel + 512;
    const float* SC = (const float*)(F.ws + WS_SC); int* TM = (int*)(F.ws + WS_TM);
    int* IDXp = (int*)(F.ws + WS_IDX);
    for (int pr = F.vcu; pr < (with_ctx ? 512 : 256); pr += F.G) {
        const bool lat = pr < 256; const int q = lat ? pr : pr - 256, b = q >> 4, e = q & 15;
        const int cap = lat ? CAPL : CAPC, yrow0 = lat ? (e * 17 + b) * 512 : (e * 17 + 16) * 512 + b * CAPC;
        topk_pair(F, SC, TM, lat ? b * T : ML + b * TC, lat ? T : TC, e, cap, yrow0, sel, red);
        for (int s = F.tid; s < cap; s += NTHR) IDXp[yrow0 + s] = sel[s];
        __syncthreads(); }
}

__device__ __forceinline__ void pj_phase(Frame& F, const Args& args, int l, int nrows) {
    const int gw = F.vcu * NWAVES + F.wave, NGW = F.G * NWAVES; const bool last = (l == DEPTH - 1);
    float* X = (float*)(F.ws + WS_X); bf16_t* H = (bf16_t*)(F.ws + WS_H); const float* SC = (const float*)(F.ws + WS_SC); const int* TM = (const int*)(F.ws + WS_TM);
    const unsigned char* Y = F.ws + WS_ZR;
    const float* mod = (const float*)(F.ws + WS_MOD) + (size_t)l * 17 * 6144; const float* modn = mod + 17 * 6144;
    const float* g2p = args.in[I_LN2G] + l * D; const float* b2p = args.in[I_LN2B] + l * D;
    int tmn = -1; float scn = 0.f; f32x4 xnx[4];
    if (gw < nrows) { if (F.lane < 16) { tmn = TM[(size_t)gw * NE + F.lane]; scn = SC[(size_t)gw * NE + F.lane]; }
#pragma unroll
        for (int q = 0; q < 4; ++q) xnx[q] = *(const f32x4*)(X + (size_t)gw * D + 4 * F.lane + 256 * q); }
    f32x4 g2r[4], b2r[4];
#pragma unroll
    for (int q = 0; q < 4; ++q) { g2r[q] = *(const f32x4*)(g2p + 4 * F.lane + 256 * q); b2r[q] = *(const f32x4*)(b2p + 4 * F.lane + 256 * q); }
    for (int m = gw; m < nrows; m += NGW) { const int j = m < ML ? (m >> 12) : 16; const float* md = mod + (size_t)j * 6144; const float* mdn = modn + (size_t)j * 6144;
        const int tmv = tmn; const float scv = scn;
        f32x4 xr[4], g2m[4], shn[4], scq[4];
#pragma unroll
        for (int q = 0; q < 4; ++q) { xr[q] = xnx[q]; g2m[q] = *(const f32x4*)(md + 5 * D + 4 * F.lane + 256 * q); }
        if (!last) {
#pragma unroll
            for (int q = 0; q < 4; ++q) { shn[q] = *(const f32x4*)(mdn + 4 * F.lane + 256 * q); scq[q] = *(const f32x4*)(mdn + D + 4 * F.lane + 256 * q); } }
        unsigned long long mask = __builtin_amdgcn_ballot_w64(tmv >= 0);
        f32x4 a[4];
#pragma unroll
        for (int q = 0; q < 4; ++q) a[q] = (f32x4){0.f, 0.f, 0.f, 0.f};
        bool first = true;
        do {
            int yr[4]; float gg[4];
#pragma unroll
            for (int k = 0; k < 4; ++k) { if (mask) { const int e = __builtin_ctzll(mask); mask &= mask - 1; yr[k] = __builtin_amdgcn_readlane(tmv, e); gg[k] = __builtin_bit_cast(float, __builtin_amdgcn_readlane(__builtin_bit_cast(int, scv), e)); } else { yr[k] = 0; gg[k] = 0.f; } }
            unsigned w[4][4];
#pragma unroll
            for (int k = 0; k < 4; ++k)
#pragma unroll
                for (int q = 0; q < 4; ++q) w[k][q] = *(const unsigned*)(Y + (size_t)yr[k] * D + 4 * F.lane + 256 * q);
            asm volatile("" ::: "memory");
            if (first && m + NGW < nrows) { if (F.lane < 16) { tmn = TM[(size_t)(m + NGW) * NE + F.lane]; scn = SC[(size_t)(m + NGW) * NE + F.lane]; }
#pragma unroll
                for (int q = 0; q < 4; ++q) xnx[q] = *(const f32x4*)(X + (size_t)(m + NGW) * D + 4 * F.lane + 256 * q); }
            first = false;
            asm volatile("" ::: "memory");
#pragma unroll
            for (int k = 0; k < 4; ++k)
#pragma unroll
                for (int q = 0; q < 4; ++q) { const float gs = gg[k] * (1.0f / SY8); a[q][0] += gs * __builtin_amdgcn_cvt_f32_fp8((int)w[k][q], 0); a[q][1] += gs * __builtin_amdgcn_cvt_f32_fp8((int)w[k][q], 1); a[q][2] += gs * __builtin_amdgcn_cvt_f32_fp8((int)w[k][q], 2); a[q][3] += gs * __builtin_amdgcn_cvt_f32_fp8((int)w[k][q], 3); }
        } while (mask);
        f32x4 v[4]; float s = 0.f;
#pragma unroll
        for (int q = 0; q < 4; ++q) { v[q] = xr[q] * DN_ALPHA + g2m[q] * a[q]; s += (v[q][0] + v[q][1]) + (v[q][2] + v[q][3]); }
        const float mean = wave_sum(s) * (1.f / D); float s2 = 0.f;
#pragma unroll
        for (int q = 0; q < 4; ++q) { v[q] = v[q] - mean; s2 += (v[q][0] * v[q][0] + v[q][1] * v[q][1]) + (v[q][2] * v[q][2] + v[q][3] * v[q][3]); }
        const float rstd = __builtin_amdgcn_rsqf(wave_sum(s2) * (1.f / D) + LN_EPS);
        float* dst = last ? args.out + (size_t)m * D : X + (size_t)m * D; s = 0.f;
#pragma unroll
        for (int q = 0; q < 4; ++q) { const int col = 4 * F.lane + 256 * q; v[q] = v[q] * rstd * g2r[q] + b2r[q]; *(f32x4*)(dst + col) = v[q]; s += (v[q][0] + v[q][1]) + (v[q][2] + v[q][3]); }
        if (!last) { const float mean2 = wave_sum(s) * (1.f / D); s2 = 0.f;
#pragma unroll
            for (int q = 0; q < 4; ++q) { v[q] = v[q] - mean2; s2 += (v[q][0] * v[q][0] + v[q][1] * v[q][1]) + (v[q][2] * v[q][2] + v[q][3] * v[q][3]); }
            const float rstd2 = __builtin_amdgcn_rsqf(wave_sum(s2) * (1.f / D) + LN_EPS);
#pragma unroll
            for (int q = 0; q < 4; ++q) { const int col = 4 * F.lane + 256 * q; const f32x4 h = v[q] * rstd2 * (scq[q] + 1.0f) + shn[q]; u32x2 w; w.x = cvt_pk_bf16(h[0], h[1]); w.y = cvt_pk_bf16(h[2], h[3]); *(u32x2*)(H + (size_t)m * D + col) = w; } } }
}
constexpr int LRU_U = 0, LRU_SA = 33280, LRU_SI = LRU_SA + 32768, LRU_HS = LRU_SI + 32768;
static_assert(LRU_HS + 32768 + 5 * 256 * 4 <= PH_LDS, "lru lds");
constexpr int NCHUNK = 2048 + 128;
constexpr size_t WS_AX = WS_HM + 64 * MiB;
template <bool FINAL>
__device__ __forceinline__ void lru_phase(Frame& F, const Args& args, int l, int nunits) {
    const bf16_t* Z = (const bf16_t*)(F.ws + WS_ZR); bf16_t* CC = (bf16_t*)(F.ws + WS_CC);
    f32x2* SUMM = (f32x2*)(F.ws + WS_SUM); const float* CAR = (const float*)(F.ws + WS_CAR); unsigned* AX = (unsigned*)(F.ws + WS_AX);
    LAS float* U32 = (LAS float*)(F.lds + LRU_U); LAS float* SA = (LAS float*)(F.lds + LRU_SA); LAS float* SI = (LAS float*)(F.lds + LRU_SI); LAS float* HS = (LAS float*)(F.lds + LRU_HS);
    const int fr = F.lane & 15, fq = F.lane >> 4, dw = F.wave >> 2, blk = F.wave & 3;
    bf16x8 bw[2][4][2];
    { const bf16_t* LW = (const bf16_t*)(F.ws + WS_SMALL + SM_LRUW);
#pragma unroll
      for (int gate = 0; gate < 2; ++gate)
#pragma unroll
        for (int nt = 0; nt < 4; ++nt)
#pragma unroll
          for (int s = 0; s < 2; ++s) bw[gate][nt][s] = *(const bf16x8*)(LW + ((size_t)((((l * 2 + dw) * 2 + gate) * 4 + blk) * 64 + 16 * nt + fr)) * 64 + 32 * s + 8 * fq); }
    float gba[4], gbx[4], gsp[4];
#pragma unroll
    for (int nt = 0; nt < 4; ++nt) { const int ch = blk * 64 + 16 * nt + fr, o = (l * 2 + dw) * 256 + ch; gba[nt] = args.in[I_LBA][o]; gbx[nt] = args.in[I_LBX][o]; gsp[nt] = log1pf(expf(-args.in[I_LLAM][o])); }
    const float* cw = args.in[I_CONVW] + l * 4 * 256; const float* cb = args.in[I_CONVB] + l * 256;
    const int dt = F.tid >> 8, cht = F.tid & 255;
    const int ctt = F.tid >> 5, cch0 = (F.tid & 31) * 8;
    LAS float* CW = (LAS float*)(F.lds + LRU_HS + 32768);
    for (int i = F.tid; i < 5 * 256; i += NTHR) CW[i] = (i < 1024) ? cw[i] : cb[i - 1024];
    __syncthreads();
    u32x4 zr[2][4];
#define LRU_DECODE(u_, m0_, sl_, t0_) do { if ((u_) < 2048) { m0_ = ((u_) >> 7) * T; sl_ = T; t0_ = ((u_) & 127) * 32; } else { const int u2_ = (u_) - 2048; m0_ = ML + (u2_ >> 3) * TC; sl_ = TC; t0_ = (u2_ & 7) * 32; } } while (0)
#define LRU_ZLOAD(u_) do { int m0_, sl_, t0_; LRU_DECODE(u_, m0_, sl_, t0_); _Pragma("unroll") for (int hh = 0; hh < 2; ++hh) _Pragma("unroll") for (int j = 0; j < 4; ++j) { const int ts = t0_ + ctt + 16 * hh + j - 2; \
        zr[hh][j] = (ts >= 0 && ts < sl_) ? *(const u32x4*)(Z + (size_t)(m0_ + ts) * INW + 1536 + cch0) : (u32x4){0u, 0u, 0u, 0u}; } } while (0)
    if (F.vcu < nunits) LRU_ZLOAD(F.vcu);
    for (int uidx = F.vcu; uidx < nunits; uidx += F.G) {
        int m0, seqlen, t0; LRU_DECODE(uidx, m0, seqlen, t0);
        {
#pragma unroll
          for (int hh = 0; hh < 2; ++hh) { const int tk = ctt + 16 * hh; float u[8];
#pragma unroll
            for (int i = 0; i < 8; ++i) u[i] = CW[1024 + cch0 + i];
#pragma unroll
            for (int j = 0; j < 4; ++j) { const u32x4 z = zr[hh][j];
                    const f32x4 wa = *(const LAS f32x4*)(CW + j * 256 + cch0), wb = *(const LAS f32x4*)(CW + j * 256 + cch0 + 4);
                    u[0] += bflo(z.x) * wa[0]; u[1] += bfhi(z.x) * wa[1]; u[2] += bflo(z.y) * wa[2]; u[3] += bfhi(z.y) * wa[3];
                    u[4] += bflo(z.z) * wb[0]; u[5] += bfhi(z.z) * wb[1]; u[6] += bflo(z.w) * wb[2]; u[7] += bfhi(z.w) * wb[3]; }
            *(LAS f32x4*)(U32 + tk * 260 + cch0) = (f32x4){u[0], u[1], u[2], u[3]}; *(LAS f32x4*)(U32 + tk * 260 + cch0 + 4) = (f32x4){u[4], u[5], u[6], u[7]}; } }
        if (uidx + F.G < nunits) LRU_ZLOAD(uidx + F.G);
        __syncthreads();
        float h = FINAL ? CAR[(size_t)uidx * 512 + F.tid] : 0.f, P = 1.f;
#pragma unroll
        for (int j = 0; j < 2; ++j) {
            { const int sc = dw ? 1 - j : j;
              bf16x8 af[2];
#pragma unroll
              for (int s = 0; s < 2; ++s) { const LAS float* up = U32 + (16 * sc + fr) * 260 + blk * 64 + 32 * s + 8 * fq; const f32x4 x0 = *(const LAS f32x4*)up, x1 = *(const LAS f32x4*)(up + 4);
                  u32x4 w; w.x = cvt_pk_bf16(x0[0], x0[1]); w.y = cvt_pk_bf16(x0[2], x0[3]); w.z = cvt_pk_bf16(x1[0], x1[1]); w.w = cvt_pk_bf16(x1[2], x1[3]); af[s] = __builtin_bit_cast(bf16x8, w); }
#pragma unroll
              for (int nt = 0; nt < 4; ++nt) { f32x4 pa = (f32x4){0.f, 0.f, 0.f, 0.f}, px = pa;
#pragma unroll
                for (int s = 0; s < 2; ++s) { pa = __builtin_amdgcn_mfma_f32_16x16x32_bf16(af[s], bw[0][nt][s], pa, 0, 0, 0); px = __builtin_amdgcn_mfma_f32_16x16x32_bf16(af[s], bw[1][nt][s], px, 0, 0, 0); }
                const int ch = blk * 64 + 16 * nt + fr;
#pragma unroll
                for (int i = 0; i < 4; ++i) { const int tk = 4 * fq + i; const float e1 = 1.0f + __expf(-(pa[i] + gba[nt])), e2 = 1.0f + __expf(-(px[i] + gbx[nt])), t12 = __builtin_amdgcn_rcpf(e1 * e2), r = t12 * e2, ig = t12 * e1;
                    const float la = -8.0f * r * gsp[nt], a = __expf(la), mult = __builtin_amdgcn_sqrtf(fmaxf(1.0f - a * a, 0.f)), u = U32[(16 * sc + tk) * 260 + ch];
                    SA[tk * 512 + dw * 256 + ch] = a; SI[tk * 512 + dw * 256 + ch] = mult * ig * u; } } }
            __syncthreads();
            { const int sct = dt ? 1 - j : j;
#pragma unroll
              for (int k = 0; k < 16; ++k) { const int tk = dt ? 15 - k : k; const float a = SA[tk * 512 + F.tid], x = SI[tk * 512 + F.tid]; h = a * h + x; P *= a;
                  if (!FINAL) AX[(size_t)(m0 + t0 + 16 * sct + tk) * 512 + F.tid] = pk2(1.0f - a, x);
                  if (FINAL) { LAS float* hp = HS + (16 * sct + tk) * 256 + cht; *hp = (j == 0) ? h : *hp + h; } } }
            __syncthreads();
        }
        if (!FINAL) SUMM[(size_t)uidx * 512 + F.tid] = (f32x2){P, h};
        else { const int tok = F.tid >> 4, ch0 = (F.tid & 15) * 16; const size_t m = (size_t)(m0 + t0 + tok);
#pragma unroll
            for (int hh = 0; hh < 2; ++hh) { const u32x4 g = *(const u32x4*)(Z + m * INW + 1792 + ch0 + 8 * hh); const unsigned gw_[4] = {g.x, g.y, g.z, g.w}; float y[8];
#pragma unroll
                for (int i = 0; i < 8; ++i) { const float gv = (i & 1) ? bfhi(gw_[i >> 1]) : bflo(gw_[i >> 1]); const float ge = gv * fast_sigmoid(1.5957691216057308f * (gv + 0.044715f * gv * gv * gv));
                    y[i] = HS[tok * 256 + ch0 + 8 * hh + i] * ge; }
                u32x4 w; w.x = cvt_pk_bf16(y[0], y[1]); w.y = cvt_pk_bf16(y[2], y[3]); w.z = cvt_pk_bf16(y[4], y[5]); w.w = cvt_pk_bf16(y[6], y[7]);
                *(u32x4*)(CC + m * D + 512 + ch0 + 8 * hh) = w; }
            __syncthreads(); }
    }
}
#undef LRU_DECODE
#undef LRU_ZLOAD

__device__ __forceinline__ void lru_final(Frame& F, int nunits) {
    const bf16_t* Z = (const bf16_t*)(F.ws + WS_ZR); bf16_t* CC = (bf16_t*)(F.ws + WS_CC);
    const float* CAR = (const float*)(F.ws + WS_CAR); const unsigned* AX = (const unsigned*)(F.ws + WS_AX);
    LAS float* HF = (LAS float*)F.lds; LAS float* HB = HF + 32 * 256;
    const int dt = F.tid >> 8, cht = F.tid & 255;
    unsigned ax[32]; float hin = 0.f;
#define LF_DECODE(u_, m0_, t0_) do { if ((u_) < 2048) { m0_ = ((u_) >> 7) * T; t0_ = ((u_) & 127) * 32; } else { const int u2_ = (u_) - 2048; m0_ = ML + (u2_ >> 3) * TC; t0_ = (u2_ & 7) * 32; } } while (0)
#define LF_LOAD(u_) do { int m0_, t0_; LF_DECODE(u_, m0_, t0_); _Pragma("unroll") for (int k = 0; k < 32; ++k) ax[k] = AX[(size_t)(m0_ + t0_ + (dt ? 31 - k : k)) * 512 + F.tid]; hin = CAR[(size_t)(u_) * 512 + F.tid]; } while (0)
    if (F.vcu < nunits) LF_LOAD(F.vcu);
    for (int uidx = F.vcu; uidx < nunits; uidx += F.G) {
        int m0, t0; LF_DECODE(uidx, m0, t0);
        const int tok = F.tid >> 4, ch0 = (F.tid & 15) * 16; const size_t m = (size_t)(m0 + t0 + tok);
        const u32x4 g0 = *(const u32x4*)(Z + m * INW + 1792 + ch0), g1 = *(const u32x4*)(Z + m * INW + 1792 + ch0 + 8);
        float h = hin; LAS float* hp = (dt ? HB : HF) + cht;
#pragma unroll
        for (int k = 0; k < 32; ++k) { const int tk = dt ? 31 - k : k; const unsigned w = ax[k]; h = (1.0f - bflo(w)) * h + bfhi(w); hp[tk * 256] = h; }
        if (uidx + F.G < nunits) LF_LOAD(uidx + F.G);
        __syncthreads();
        { const unsigned gw_[8] = {g0.x, g0.y, g0.z, g0.w, g1.x, g1.y, g1.z, g1.w};
#pragma unroll
          for (int hh = 0; hh < 2; ++hh) { float y[8];
#pragma unroll
            for (int i = 0; i < 8; ++i) { const unsigned wv = gw_[4 * hh + (i >> 1)]; const float gv = (i & 1) ? bfhi(wv) : bflo(wv); const float ge = gv * fast_sigmoid(1.5957691216057308f * (gv + 0.044715f * gv * gv * gv));
                y[i] = (HF[tok * 256 + ch0 + 8 * hh + i] + HB[tok * 256 + ch0 + 8 * hh + i]) * ge; }
            u32x4 w; w.x = cvt_pk_bf16(y[0], y[1]); w.y = cvt_pk_bf16(y[2], y[3]); w.z = cvt_pk_bf16(y[4], y[5]); w.w = cvt_pk_bf16(y[6], y[7]);
            *(u32x4*)(CC + m * D + 512 + ch0 + 8 * hh) = w; } }
        __syncthreads();
    }
#undef LF_DECODE
#undef LF_LOAD
}
__device__ __forceinline__ void lru_carry(Frame& F) {
    const int gid = (F.vcu - (F.G - NB)) * NTHR + F.tid; if (gid < 0 || gid >= NB * 512) return;
    const f32x2* SUMM = (const f32x2*)(F.ws + WS_SUM); float* CAR = (float*)(F.ws + WS_CAR);
    const int b = gid >> 9, dch = gid & 511, d = dch >> 8; float h = 0.f;
#pragma unroll 1
    for (int s0 = 0; s0 < 136; s0 += 8) { f32x2 sm[8]; int ux[8];
#pragma unroll
        for (int k = 0; k < 8; ++k) { const int s = s0 + k; ux[k] = (s < 8) ? 2048 + b * 8 + (d ? 7 - s : s) : b * 128 + (d ? 127 - (s - 8) : (s - 8)); sm[k] = SUMM[(size_t)ux[k] * 512 + dch]; }
#pragma unroll
        for (int k = 0; k < 8; ++k) { CAR[(size_t)ux[k] * 512 + dch] = h; h = sm[k].x * h + sm[k].y; } }
}

constexpr int CW_F2 = 232000;
constexpr int CW_BAR = 1024, NPH_L = 10, NPHASE = 2 + DEPTH * NPH_L;
__global__ void __launch_bounds__(NTHR, 2) fwd_kernel(Args args) {
    extern __shared__ __attribute__((aligned(16))) unsigned char lds_raw[];
    Frame F;
    F.lds = (LAS unsigned char*)lds_raw;
    int wave_s = __builtin_amdgcn_readfirstlane((int)threadIdx.x >> 6);
    F.tid = threadIdx.x; F.lane = F.tid & 63; F.wave = wave_s;
    F.G = gridDim.x; { const int bx = blockIdx.x; F.vcu = (F.G % 8 == 0) ? (bx % 8) * (F.G / 8) + bx / 8 : bx; }
    F.ws = args.ws;
    volatile LAS unsigned* MISC = (volatile LAS unsigned*)(F.lds + MISC_OFF);
    if (F.tid < 128) MISC[F.tid] = 0u;
    { LAS f32x2* rope = (LAS f32x2*)(F.lds + ROPE_OFF);
      for (int i = F.tid; i < 1024; i += NTHR) { const int pos = i >> 4, j = i & 15; const float inv = exp2f(-(float)j * (13.287712379549449f / 16.0f)); float s, c; sincosf((float)pos * inv, &s, &c); rope[i] = (f32x2){c, s}; } }
    __syncthreads();
    XcdBarrier bar = xcd_barrier_post((unsigned*)(F.ws + WS_CTL) + CW_BAR + args.li * XCD_BAR_WORDS, MISC + 8);
    const int lo = args.ph_lo, hi = args.ph_hi;
#ifndef PHMASK
#define PHMASK 0xFFFFFFFFu
#endif
#define IN(k) (lo <= (k) && (k) < hi)
#define ON(b) ((PHMASK >> (b)) & 1u)
#define SEAM(k) do { if (IN(k) && IN((k) + 1)) { XcdBarrier b2_ = bar; unsigned x_ = b2_.x; asm volatile("" : "+s"(x_)); b2_.x = x_; unsigned* p_ = b2_.bar; asm volatile("" : "+s"(p_)); b2_.bar = p_; xcd_barrier(b2_); } RELAUNDER(); } while (0)
#define RELAUNDER() do { asm volatile("" : "+s"(wave_s)); int l_ = lane_id(); asm volatile("" : "+v"(l_)); F.lane = l_; F.wave = wave_s; F.tid = wave_s * 64 + l_; int v_ = F.vcu; asm volatile("" : "+s"(v_)); F.vcu = v_; size_t z_ = 0; asm volatile("" : "+s"(z_)); F.ws = args.ws + z_;     } while (0)
    LAS unsigned char* lds = F.lds;
    if (IN(0)) p0a(F, args);
    SEAM(0);
    if (IN(1)) p0b(F, args);
    SEAM(1);
    for (int l = 0; l < DEPTH; ++l) {
        RELAUNDER();
        const int pb = 2 + l * NPH_L; const bool last = (l == DEPTH - 1); const int nrows = last ? ML : M;
        const char* wsb = (const char*)F.ws;
        if (IN(pb + 0)) {
            pg8::GemmP g{D, D, D, (size_t)128 * D * 2, (size_t)128 * D * 2};
            pg8::SchedPlain S{9, (M / 256) * 9, F.G, F.vcu, wsb + WS_H, wsb + WS_WIN + (size_t)l * INW * D * 2, (size_t)256 * D * 2, (size_t)256 * D * 2, true};
            pg8::EpiInProj E{(bf16_t*)(F.ws + WS_ZR), (const LAS f32x2*)(F.lds + ROPE_OFF)};
            pg8::gemm_phase<pg8::EpiInProj, pg8::SchedPlain, true>(lds, g, S, E, F.tid);
        }
        SEAM(pb + 0);
        if (IN(pb + 1)) pw_experts(F, args, l);
        if (IN(pb + 1)) lru_phase<false>(F, args, l, NCHUNK);
        if (IN(pb + 1)) {
            pg8::GemmP g{256, 256, INW, (size_t)128 * 256 * 2, (size_t)128 * INW * 2};
            pg8::SchedF1 S{2 * (nrows / 256), F.G, F.vcu, wsb + WS_SMALL + SM_DC, wsb + WS_ZR + 2048 * 2};
            pg8::EpiF1 E{(bf16_t*)(F.ws + WS_GT), (bf16_t*)(F.ws + WS_GTC)};
            pg8::gemm_phase<pg8::EpiF1, pg8::SchedF1, true>(lds, g, S, E, F.tid);
        }
        if (IN(pb + 1) && !last) {
            const float lam = ((const float*)(F.ws + WS_SMALL + SM_LAM))[l], gsc = 1.0f - (0.8f - 0.6f * expf(-0.3f * (float)l));
            int bx_ = blockIdx.x; asm volatile("" : "+s"(bx_)); float* o1s = (float*)(F.ws + WS_O1) + (size_t)bx_ * 32768;
            for (int u2 = F.G - 1 - F.vcu; u2 < 64; u2 += F.G) { const int b = u2 >> 2, h = u2 & 3, qrow0 = ML + b * TC;
                att::diff_attn_unit((const bf16_t*)(F.ws + WS_ZR), (bf16_t*)(F.ws + WS_CC), o1s, args.in[I_ANG] + l * 512, lam, gsc, qrow0, h, qrow0, 4, qrow0, 4, (LAS char*)lds, F.tid); }
            __syncthreads();
        }
        SEAM(pb + 1);
        if (IN(pb + 2)) lru_carry(F);
        if (IN(pb + 2)) {
            const float lam = ((const float*)(F.ws + WS_SMALL + SM_LAM))[l], gsc = 1.0f - (0.8f - 0.6f * expf(-0.3f * (float)l));
            int bx_ = blockIdx.x; asm volatile("" : "+s"(bx_)); float* o1s = (float*)(F.ws + WS_O1) + (size_t)bx_ * 32768;
            for (int u = F.vcu; u < 1024; u += F.G) {
                const int b = u >> 6, h = (u >> 4) & 3, qrow0 = b * T + (u & 15) * 256, seg0 = b * T, n0 = 64, seg1 = ML + b * TC, NT = 68;
                att::diff_attn_unit((const bf16_t*)(F.ws + WS_ZR), (bf16_t*)(F.ws + WS_CC), o1s, args.in[I_ANG] + l * 512, lam, gsc, qrow0, h, seg0, n0, seg1, NT, (LAS char*)lds, F.tid);
            }
            __syncthreads();
        }
        SEAM(pb + 2);
        if (IN(pb + 3)) lru_final(F, last ? 2048 : NCHUNK);
        if (IN(pb + 3)) {
            { pg8::GemmP g{4096, 8192, 8192, (size_t)128 * 8192 * 2, (size_t)128 * 8192 * 2};
              pg8::SchedF2H S{F.G, F.vcu, wsb + WS_AT, wsb + WS_GT};
              pg8::EpiF2H E{(float*)(F.ws + WS_HM), (bf16_t*)(F.ws + WS_CC), (unsigned*)(F.ws + WS_CTL) + CW_F2, (unsigned)(l + 1)};
              pg8::gemm_phase<pg8::EpiF2H, pg8::SchedF2H, true>(lds, g, S, E, F.tid); }
            {
              const bf16_t* GT = (const bf16_t*)(F.ws + WS_GT); bf16_t* CC = (bf16_t*)(F.ws + WS_CC);
              for (int pr = F.vcu * NWAVES + F.wave; pr < NB * 256; pr += F.G * NWAVES) { const int b = pr >> 8, cp = pr & 255; const bf16_t* g = GT + ((size_t)(b * 256 + cp) * 2) * 4096 + F.lane * 64; float s = 0.f;
#pragma unroll
                  for (int q = 0; q < 8; ++q) { const u32x4 w = *(const u32x4*)(g + 8 * q); s += (bflo(w.x) - bfhi(w.x)) + (bflo(w.y) - bfhi(w.y)) + (bflo(w.z) - bfhi(w.z)) + (bflo(w.w) - bfhi(w.w)); }
                  s = wave_sum(s) * (1.0f / 64.0f); if (F.lane == 0) CC[(size_t)(b * T + T / 2) * D + 768 + cp] = (bf16_t)f2bf(s); } }
            if (!last) { pg8::GemmP g{512, 512, 512, (size_t)128 * 512 * 2, (size_t)128 * 512 * 2};
              pg8::SchedF2C S{F.G, F.vcu, wsb + WS_SMALL + SM_AC, wsb + WS_GTC};
              pg8::EpiBf16 E{(bf16_t*)(F.ws + WS_CC), D, 1.0f};
              pg8::gemm_phase<pg8::EpiBf16, pg8::SchedF2C, true>(lds, g, S, E, F.tid); }
        }
        SEAM(pb + 3);
        if (IN(pb + 4)) {
            pg8::GemmP g{D, D, D, (size_t)128 * D * 2, (size_t)128 * D * 2};
            pg8::SchedPlain S{4, (nrows / 256) * 4, F.G, F.vcu, wsb + WS_CC, wsb + WS_WOUT + (size_t)l * D * D * 2, (size_t)256 * D * 2, (size_t)256 * D * 2, false};
            pg8::EpiBf16 E{(bf16_t*)(F.ws + WS_ZR), D, 1.0f};
            pg8::gemm_phase<pg8::EpiBf16, pg8::SchedPlain, true>(lds, g, S, E, F.tid);
        }
        SEAM(pb + 4);
        if (IN(pb + 5)) pe_phase(F, args, l, nrows);
        SEAM(pb + 5);
        if (IN(pb + 6)) pk_phase(F, !last);
        SEAM(pb + 6);
        if (IN(pb + 7)) {
            pg8::GemmP g{D / 2, D / 2, D / 2, (size_t)128 * D, (size_t)FE * D};
            pg8::SchedGU S{last ? 32 : 34, F.G, F.vcu, wsb + WS_H, wsb + WS_WEXP, (const int*)(wsb + WS_IDX)};
            pg8::EpiGateUp E{F.ws + WS_HM};
            pg8::gemm_phase<pg8::EpiGateUp, pg8::SchedGU, true, true, true>(lds, g, S, E, F.tid);
        }
        SEAM(pb + 7);
        if (IN(pb + 8)) {
            pg8::GemmP g{FE / 2, FE / 2, FE / 2, (size_t)128 * FE, (size_t)128 * FE};
            pg8::SchedDN S{last ? 32 : 34, F.G, F.vcu, wsb + WS_HM, wsb + WS_WDN};
            pg8::EpiFp8 E{F.ws + WS_ZR, D, SY8 / (SH8 * SWD8)};
            pg8::gemm_phase<pg8::EpiFp8, pg8::SchedDN, true, true>(lds, g, S, E, F.tid);
        }
        SEAM(pb + 8);
        if (IN(pb + 9)) pj_phase(F, args, l, nrows);
        SEAM(pb + 9);
    }
#undef IN
#undef SEAM
}

#ifndef MK_PER_PHASE
#define MK_PER_PHASE 0
#endif
extern "C" void kernel_launch(void* const* d_in, const int* in_sizes, int n_in, void* d_out, int out_size, void* d_ws, size_t ws_size, hipStream_t stream) {
    static int grid = 0;
    if (grid == 0) {
        if (n_in != 28 || in_sizes[0] != ML * D || out_size != ML * D || ws_size < WS_END) { fprintf(stderr, "kernel_launch: unexpected shapes / workspace (n_in %d, ws %zu < %zu)\n", n_in, ws_size, (size_t)WS_END); grid = -1; return; }
        int dev = 0, cus = 0, per_cu = 0;
        if (hipGetDevice(&dev) != hipSuccess || hipDeviceGetAttribute(&cus, hipDeviceAttributeMultiprocessorCount, dev) != hipSuccess) { grid = -1; return; }
        if (hipFuncSetAttribute((const void*)fwd_kernel, hipFuncAttributeMaxDynamicSharedMemorySize, LDS_BYTES) != hipSuccess) { fprintf(stderr, "kernel_launch: hipFuncSetAttribute failed\n"); grid = -1; return; }
        if (hipOccupancyMaxActiveBlocksPerMultiprocessor(&per_cu, (const void*)fwd_kernel, NTHR, LDS_BYTES) != hipSuccess || per_cu < 1) { fprintf(stderr, "kernel_launch: occupancy query says %d\n", per_cu); }
        (void)hipGetLastError();
        grid = cus < 256 ? cus : 256;
    }
    if (grid < 0) return;
    if (hipMemsetAsync((char*)d_ws + WS_CTL, 0, CTL_ZERO_BYTES, stream) != hipSuccess) return;
    Args a{};
    for (int i = 0; i < 28; ++i) a.in[i] = (const float*)d_in[i];
    a.out = (float*)d_out; a.ws = (unsigned char*)d_ws;
#if MK_PER_PHASE
#ifdef DIAG
    hipMemsetAsync((char*)d_ws + WS_DIAG, 0, 256, stream);
#ifndef DIAG_L
#define DIAG_L 0
#endif
#ifndef DIAG_VAL
#define DIAG_VAL -1
#endif
#endif
    for (int p = 0; p < NPHASE; ++p) { a.ph_lo = p; a.ph_hi = p + 1; a.li = p; hipLaunchKernelGGL(fwd_kernel, dim3(grid), dim3(NTHR), LDS_BYTES, stream, a);
#ifdef DIAG
        const int l = (p - 2) / NPH_L, k = (p - 2) % NPH_L; int ids[2] = {-1, -1};
        if (p == 1) ids[0] = 0;
        if (p >= 2 && l == DIAG_L) { if (k == 0) ids[0] = 1; if (k == 2) ids[0] = 2; if (k == 3) { ids[0] = 3; ids[1] = 4; } if (k == 4) ids[0] = 5; if (k == 5) ids[0] = 6; if (k == 6) ids[0] = 7; if (k == 7) ids[0] = 8; if (k == 8) ids[0] = 9; }
        if (p >= 2 && l == 3 && k == 9) ids[0] = 10;
        for (int q = 0; q < 2; ++q) if (ids[q] >= 0) hipLaunchKernelGGL(chk_kernel, dim3(48), dim3(256), 0, stream, a, ids[q], ids[q] == 0 ? 0 : (ids[q] == 10 ? 3 : DIAG_L));
#endif
    }
#ifdef DIAG
    hipLaunchKernelGGL(fin_kernel, dim3(1), dim3(1), 0, stream, a, 16, DIAG_VAL);
#endif
#else
    a.ph_lo = 0; a.ph_hi = NPHASE; a.li = 0; hipLaunchKernelGGL(fwd_kernel, dim3(grid), dim3(NTHR), LDS_BYTES, stream, a);
#endif
}
```

```cpp
#include <hip/hip_runtime.h>
#include <cstdio>
#include <cstdint>

#define GAS __attribute__((address_space(1)))
#define LAS __attribute__((address_space(3)))
typedef unsigned short bf16_t;
typedef short bf16x8 __attribute__((ext_vector_type(8)));
typedef short s16x4 __attribute__((ext_vector_type(4)));
typedef float f32x4 __attribute__((ext_vector_type(4)));
typedef float f32x2 __attribute__((ext_vector_type(2)));
typedef float f32x16 __attribute__((ext_vector_type(16)));
typedef unsigned u32x4 __attribute__((ext_vector_type(4)));
typedef unsigned u32x2 __attribute__((ext_vector_type(2)));
typedef GAS unsigned gu32;
#define RLX_AGENT __ATOMIC_RELAXED, __HIP_MEMORY_SCOPE_AGENT
#define LDS_WAIT() asm volatile("s_waitcnt lgkmcnt(0)" ::: "memory")
#define VM_WAIT() asm volatile("s_waitcnt vmcnt(0)" ::: "memory")

constexpr int D = 1024, NB = 16, T = 4096, TC = 256, DEPTH = 4;
constexpr int ML = NB * T, MC = NB * TC, M = ML + MC;
constexpr int INW = 2304, NE = 16, FE = 2048;
constexpr int CAPL = 512, CAPC = 32;
constexpr int NPAIR = NE * 17;
constexpr float LN_EPS = 1e-5f, RMS_EPS = 1e-6f;
constexpr float DN_ALPHA = 1.6817928305074290f;
constexpr int NWAVES = 8, NTHR = 512;

constexpr size_t MiB = 1u << 20;
constexpr size_t WS_CTL = 0, CTL_ZERO_BYTES = 1 * MiB;
constexpr size_t WS_MOD = 1 * MiB;
constexpr size_t WS_SMALL = 3 * MiB;
constexpr size_t SM_LAM = 0, SM_LRUW = 4096, SM_DC = SM_LRUW + 4 * 2 * 2 * 4 * 4096 * 2, SM_AC = SM_DC + 512 * 256 * 2, SM_END = SM_AC + 256 * 512 * 2;
static_assert(SM_END <= 3 * MiB, "small region");
constexpr size_t WS_WIN = 6 * MiB;
constexpr size_t WS_WOUT = 24 * MiB;
constexpr size_t WS_AT = 32 * MiB;
constexpr size_t WS_WEXP = 96 * MiB;
constexpr size_t WS_WDN = WS_WEXP + 128 * MiB;
constexpr size_t WS_X = 288 * MiB;
constexpr size_t WS_H = 560 * MiB;
constexpr size_t WS_CC = 696 * MiB;
constexpr size_t WS_ZR = 832 * MiB;
constexpr size_t WS_O1 = 1138 * MiB;
constexpr size_t WS_GT = 1170 * MiB;
constexpr size_t WS_GTC = 1234 * MiB;
constexpr size_t WS_SC = 1238 * MiB;
constexpr size_t WS_TM = 1243 * MiB;
constexpr size_t WS_IDX = 1248 * MiB;
constexpr size_t WS_SUM = 1249 * MiB;
constexpr size_t WS_CAR = 1258 * MiB;
constexpr size_t WS_HM = 1270 * MiB;
constexpr size_t WS_END = 1814 * MiB;
static_assert(WS_HM + (size_t)NPAIR * 512 * FE * 2 <= WS_END, "ws map");
static_assert(WS_ZR + (size_t)M * INW * 2 <= WS_O1 && WS_ZR + (size_t)NPAIR * 512 * D * 2 <= WS_O1, "ws map zr");

constexpr int PH_LDS = 147456;
constexpr int ROPE_OFF = PH_LDS;
constexpr int MISC_OFF = ROPE_OFF + 8192;
constexpr int LDS_BYTES = MISC_OFF + 512;

__device__ __forceinline__ unsigned f2bf(float f) { unsigned u = __builtin_bit_cast(unsigned, f); return (u + 0x7fffu + ((u >> 16) & 1u)) >> 16; }
__device__ __forceinline__ unsigned pk2(float lo, float hi) { return f2bf(lo) | (f2bf(hi) << 16); }
__device__ __forceinline__ float bf2f(unsigned short h) { return __builtin_bit_cast(float, (unsigned)h << 16); }
__device__ __forceinline__ float bflo(unsigned w) { return __builtin_bit_cast(float, w << 16); }
__device__ __forceinline__ float bfhi(unsigned w) { return __builtin_bit_cast(float, w & 0xffff0000u); }
__device__ __forceinline__ unsigned cvt_pk_bf16(float lo, float hi) { unsigned r; asm volatile("v_cvt_pk_bf16_f32 %0, %1, %2" : "=v"(r) : "v"(lo), "v"(hi)); return r; }
typedef int v8i __attribute__((ext_vector_type(8)));
__device__ __forceinline__ float clamp448(float x) { return __builtin_amdgcn_fmed3f(x, -448.f, 448.f); }
__device__ __forceinline__ unsigned cvt4_fp8(float a, float b, float c, float d) { int w = 0; w = __builtin_amdgcn_cvt_pk_fp8_f32(a, b, w, false); w = __builtin_amdgcn_cvt_pk_fp8_f32(c, d, w, true); return (unsigned)w; }
__device__ __forceinline__ float fp8_dec(unsigned char b) { return __builtin_amdgcn_cvt_f32_fp8((int)b, 0); }
constexpr float SX8 = 16.f, SWG8 = 128.f, SH8 = 8.f, SWD8 = 512.f, SY8 = 64.f;
__device__ __forceinline__ float fast_sigmoid(float x) { return __builtin_amdgcn_rcpf(1.0f + __expf(-x)); }
__device__ __forceinline__ int lane_id() { int r; asm volatile("v_mbcnt_lo_u32_b32 %0, -1, 0\n\tv_mbcnt_hi_u32_b32 %0, -1, %0" : "=v"(r)); return r; }
template <int CTRL> __device__ __forceinline__ float dppf(float v) { return __builtin_bit_cast(float, __builtin_amdgcn_update_dpp(0, __builtin_bit_cast(int, v), CTRL, 0xF, 0xF, true)); }
template <int CTRL> __device__ __forceinline__ int dppi(int v) { return __builtin_amdgcn_update_dpp(0, v, CTRL, 0xF, 0xF, true); }
__device__ __forceinline__ float swz16f(float v) { return __builtin_bit_cast(float, __builtin_amdgcn_ds_swizzle(__builtin_bit_cast(int, v), 0x401F)); }
__device__ __forceinline__ float row32_sum(float v) {
    v += dppf<0xB1>(v); v += dppf<0x4E>(v); v += dppf<0x141>(v); v += dppf<0x140>(v); v += swz16f(v); return v; }
__device__ __forceinline__ void swap32(unsigned x, unsigned& r0, unsigned& r1) { unsigned y = x; asm volatile("" : "+v"(y)); auto r = __builtin_amdgcn_permlane32_swap(x, y, false, false); r0 = r[0]; r1 = r[1]; }
__device__ __forceinline__ float wave_sum(float v) {
    v = row32_sum(v); unsigned r0, r1; swap32(__builtin_bit_cast(unsigned, v), r0, r1);
    return __builtin_bit_cast(float, r0) + __builtin_bit_cast(float, r1);
}
__device__ __forceinline__ int wave_sum_i(int v) {
    v += dppi<0xB1>(v); v += dppi<0x4E>(v); v += dppi<0x141>(v); v += dppi<0x140>(v); v += __builtin_amdgcn_ds_swizzle(v, 0x401F);
    unsigned r0, r1; swap32((unsigned)v, r0, r1); return (int)r0 + (int)r1;
}
__device__ __forceinline__ float xor32f(float v, bool lo_half) { unsigned r0, r1; swap32(__builtin_bit_cast(unsigned, v), r0, r1); return __builtin_bit_cast(float, lo_half ? r1 : r0); }

#define XB_TMO      128
#define XB_XCNT(j)  (256  + 64 * (j))
#define XB_XSUB(j)  (1280 + 64 * (j))
#define XB_XGEN(j)  (2304 + 64 * (j))
#define XB_TOP      3328
#define XB_TOPGEN   3392
#define XCD_BAR_WORDS 3456
#define XB_SPIN_CAP (1u << 18)
__device__ __forceinline__ unsigned xb_ld(unsigned* p)              { return __hip_atomic_load(p, __ATOMIC_RELAXED, __HIP_MEMORY_SCOPE_AGENT); }
__device__ __forceinline__ unsigned xb_add(unsigned* p, unsigned v) { return __hip_atomic_fetch_add(p, v, __ATOMIC_RELAXED, __HIP_MEMORY_SCOPE_AGENT); }
__device__ __forceinline__ unsigned xb_xcc_id() { return (unsigned)__builtin_amdgcn_s_getreg((3 << 11) | 20) & 0xFu; }
#define XB_SPIN(cond, bar) do { unsigned _sp = 0; while (cond) { __builtin_amdgcn_s_sleep(1); \
    if ((++_sp & 255u) == 0u) { if (xb_ld(&(bar)[XB_TMO])) break; if (_sp > XB_SPIN_CAP) { atomicAdd(&(bar)[XB_TMO], 1u); break; } } } } while (0)
struct XcdBarrier { unsigned* bar; unsigned x; volatile LAS unsigned* st; };
__device__ __forceinline__ XcdBarrier xcd_barrier_post(unsigned* bar, volatile LAS unsigned* st) {
    XcdBarrier b; b.bar = bar; b.x = xb_xcc_id(); b.st = st;
    if (threadIdx.x == 0) (void)xb_add(&bar[XB_XCNT(b.x)], 1u);
    return b;
}
__device__ __forceinline__ void xcd_barrier_complete(unsigned* bar, unsigned x, unsigned& nloc, unsigned& nx) {
    const unsigned G = gridDim.x * gridDim.y * gridDim.z;
    unsigned sum, cnt, mine, sp = 0u;
    for (;;) {
        sum = 0u; cnt = 0u; mine = 0u;
#pragma unroll
        for (unsigned j = 0; j < 16; ++j) { const unsigned c = xb_ld(&bar[XB_XCNT(j)]); sum += c; cnt += (c > 0u) ? 1u : 0u; mine = (j == x) ? c : mine; }
        if (sum == G) break;
        __builtin_amdgcn_s_sleep(1);
        if ((++sp & 255u) == 0u) { if (xb_ld(&bar[XB_TMO])) break; if (sp > XB_SPIN_CAP) { atomicAdd(&bar[XB_TMO], 1u); break; } }
    }
    nloc = mine > 0u ? mine : 1u; nx = cnt > 0u ? cnt : 1u;
}
__device__ __forceinline__ void xcd_barrier(const XcdBarrier& b) {
    asm volatile("s_waitcnt vmcnt(0)" ::: "memory");
    __syncthreads();
    if (threadIdx.x == 0) {
        unsigned* bar = b.bar;
        __builtin_amdgcn_s_waitcnt(0);
        unsigned nloc = b.st[0], nx = b.st[1];
        if (nloc == 0u) { xcd_barrier_complete(bar, b.x, nloc, nx); b.st[0] = nloc; b.st[1] = nx; }
        const unsigned old = xb_add(&bar[XB_XSUB(b.x)], 1u);
        const unsigned gen = old / nloc;
        if (old + 1u == (gen + 1u) * nloc) {
            __builtin_amdgcn_fence(__ATOMIC_RELEASE, "agent");
            asm volatile("s_waitcnt vmcnt(0)" ::: "memory");
            const unsigned og = xb_add(&bar[XB_TOP], 1u);
            const unsigned tg = og / nx;
            if (og + 1u == (tg + 1u) * nx) xb_add(&bar[XB_TOPGEN], 1u);
            else XB_SPIN(xb_ld(&bar[XB_TOPGEN]) == tg, bar);
            __builtin_amdgcn_fence(__ATOMIC_ACQUIRE, "agent");
            xb_add(&bar[XB_XGEN(b.x)], 1u);
            asm volatile("s_waitcnt vmcnt(0)" ::: "memory");
        } else {
            XB_SPIN(xb_ld(&bar[XB_XGEN(b.x)]) == gen, bar);
            __builtin_amdgcn_fence(__ATOMIC_ACQUIRE, "agent");
            asm volatile("s_waitcnt vmcnt(0)" ::: "memory");
        }
    }
    __syncthreads();
}
namespace pg8 {
constexpr int BM = 256, BK = 64, HALF = 128, HTB = HALF * BK * 2, STAGE_BYTES = 8 * HTB;
__host__ __device__ __forceinline__ int lds_byte(int r, int c) { const int st = (r >> 4) * 2 + (c >> 5), rr = r & 15, cc = c & 31, ob = rr * 64 + cc * 2; return st * 1024 + (ob ^ (((ob >> 9) & 1) << 5)); }
__host__ __device__ __forceinline__ void stage_rc(int b, int& R, int& C) { const int st = b / 1024, sb = b % 1024, swz = sb ^ (((sb >> 9) & 1) << 5); R = (st >> 1) * 16 + swz / 64; C = (st & 1) * 32 + (swz % 64) / 2; }
__host__ __device__ __forceinline__ int perm32(int rho) { const int n = rho >> 4, i = rho & 15; return 8 * (i >> 2) + 4 * n + (i & 3); }

struct Unit { const char* a; const char* b; int orow, ocol; const int* idx; };
struct GemmP { int K; unsigned lda, ldb; size_t hstepA, hstepB; };

template <class Epi, class Sched, bool ALIGN_EPI, bool FP8 = false, bool GATHER = false>
__device__ __forceinline__ void gemm_phase(LAS unsigned char* lds, const GemmP g, const Sched& S, const Epi& E, int tid) {
    const int wid = __builtin_amdgcn_readfirstlane(tid >> 6), lane = tid & 63, wr = wid >> 2, wc = wid & 3, fr = lane & 15, fq = lane >> 4;
    const int K = g.K, nt = K / BK;
    unsigned voffA[2], voffB[2];
#pragma unroll
    for (int i = 0; i < 2; ++i) { int R, C; stage_rc(tid * 16 + i * 8192, R, C); const int Rb = Epi::PERM ? ((R & ~31) + perm32(R & 31)) : R;
        voffA[i] = (unsigned)(R * g.lda + C) * 2u; voffB[i] = (unsigned)(Rb * g.ldb + C) * 2u; }
    const size_t kstep = (size_t)(BK * 2);
    const size_t hA = GATHER ? (size_t)0 : g.hstepA, hB = g.hstepB;
    unsigned a0c[2], a1c[2], a0n[2], a1n[2]; int gR[2], gC[2];
#pragma unroll
    for (int i = 0; i < 2; ++i) { stage_rc(tid * 16 + i * 8192, gR[i], gC[i]); a0c[i] = a1c[i] = a0n[i] = a1n[i] = voffA[i]; }
#define PG8_IDX(u_, v0_, v1_) do { if constexpr (GATHER) { _Pragma("unroll") for (int _i = 0; _i < 2; ++_i) { v0_[_i] = (unsigned)(u_).idx[gR[_i]] * (g.lda * 2u) + (unsigned)gC[_i] * 2u; v1_[_i] = (unsigned)(u_).idx[128 + gR[_i]] * (g.lda * 2u) + (unsigned)gC[_i] * 2u; } } } while (0)
    const unsigned ldsw = (unsigned)wid * 1024u;
    const int aoff = FP8 ? lds_byte(wr * 64 + fr, (fq & 1) * 16) + (fq >> 1) * 1024 : lds_byte(wr * 64 + fr, fq * 8), boff = FP8 ? lds_byte(wc * 32 + fr, (fq & 1) * 16) + (fq >> 1) * 1024 : lds_byte(wc * 32 + fr, fq * 8);
#define PG8_SA(b, h) (((b) * 2 + (h)) * HTB)
#define PG8_SB(b, h) ((4 + (b) * 2 + (h)) * HTB)
#define PG8_STAGE(bufoff, gbase, voff) do { _Pragma("unroll") for (int _i = 0; _i < 2; ++_i) \
        __builtin_amdgcn_global_load_lds((const unsigned*)((const char*)(gbase) + (voff)[_i]), (LAS unsigned*)(lds + (bufoff) + ldsw + _i * 8192), 16, 0, 0); } while (0)
#define PG8_LD8(p_) ({ const u32x4 lo_ = *(const LAS u32x4*)(p_), hi_ = *(const LAS u32x4*)((p_) + 16); (v8i){(int)lo_.x, (int)lo_.y, (int)lo_.z, (int)lo_.w, (int)hi_.x, (int)hi_.y, (int)hi_.z, (int)hi_.w}; })
#define PG8_LDA(dst, b, h) do { if constexpr (FP8) { _Pragma("unroll") for (int m = 0; m < 4; ++m) dst##8[m] = PG8_LD8(lds + PG8_SA(b, h) + aoff + m * 2048); } \
        else { _Pragma("unroll") for (int m = 0; m < 4; ++m) _Pragma("unroll") for (int k = 0; k < 2; ++k) dst[m][k] = *(const LAS bf16x8*)(lds + PG8_SA(b, h) + aoff + m * 2048 + k * 1024); } } while (0)
#define PG8_LDB(dst, b, h) do { if constexpr (FP8) { _Pragma("unroll") for (int n = 0; n < 2; ++n) dst##8[n] = PG8_LD8(lds + PG8_SB(b, h) + boff + n * 2048); } \
        else { _Pragma("unroll") for (int n = 0; n < 2; ++n) _Pragma("unroll") for (int k = 0; k < 2; ++k) dst[n][k] = *(const LAS bf16x8*)(lds + PG8_SB(b, h) + boff + n * 2048 + k * 1024); } } while (0)
#define PG8_MMA(ai, bj, At, Bt) do { __builtin_amdgcn_s_setprio(1); if constexpr (FP8) { _Pragma("unroll") for (int m = 0; m < 4; ++m) _Pragma("unroll") for (int n = 0; n < 2; ++n) \
        asm volatile("v_mfma_f32_16x16x128_f8f6f4 %0, %1, %2, %0" : "+v"(acc[ai][bj][m][n]) : "v"(Bt##8[n]), "v"(At##8[m])); }   \
        else { _Pragma("unroll") for (int m = 0; m < 4; ++m) _Pragma("unroll") for (int n = 0; n < 2; ++n) _Pragma("unroll") for (int k = 0; k < 2; ++k) \
        acc[ai][bj][m][n] = __builtin_amdgcn_mfma_f32_16x16x32_bf16(Bt[n][k], At[m][k], acc[ai][bj][m][n], 0, 0, 0); } __builtin_amdgcn_s_setprio(0); } while (0)
#define PG8_WAIT_V(n) asm volatile("s_waitcnt vmcnt(" #n ")" ::: "memory")
#define PG8_WAIT_L(n) asm volatile("s_waitcnt lgkmcnt(" #n ")" ::: "memory")
#define PG8_BAR __builtin_amdgcn_s_barrier()
#define PG8_SCHED __builtin_amdgcn_sched_barrier(0)
    Unit cur, nxt; int ui = 0;
    if (!S.next(0, cur)) return;
    f32x4 acc[2][2][4][2];
#pragma unroll
    for (int a = 0; a < 2; ++a)
#pragma unroll
        for (int b = 0; b < 2; ++b)
#pragma unroll
            for (int m = 0; m < 4; ++m)
#pragma unroll
                for (int n = 0; n < 2; ++n) acc[a][b][m][n] = (f32x4){0.f, 0.f, 0.f, 0.f};
    bf16x8 At[4][2], B0[2][2], B1[2][2]; v8i At8[4], B08[2], B18[2];
    const char* cA = cur.a; const char* cB = cur.b;
    PG8_IDX(cur, a0c, a1c);
    PG8_STAGE(PG8_SB(0, 0), cB, voffB); PG8_STAGE(PG8_SB(0, 1), cB + hB, voffB); PG8_STAGE(PG8_SA(0, 0), cA, a0c); PG8_STAGE(PG8_SA(0, 1), cA + hA, a1c);
    if (wr == 1) PG8_BAR;
    PG8_WAIT_V(2); PG8_BAR;
    PG8_STAGE(PG8_SB(1, 0), cB + kstep, voffB); PG8_STAGE(PG8_SA(1, 0), cA + kstep, a0c); PG8_STAGE(PG8_SB(1, 1), cB + hB + kstep, voffB);
    PG8_WAIT_V(6); PG8_BAR;
    for (;;) {
        const bool has_next = S.next(ui + 1, nxt);
        const char* nA = has_next ? nxt.a : cA; const char* nB = has_next ? nxt.b : cB;
        if constexpr (GATHER) { if (has_next)
            __builtin_amdgcn_global_load_lds((const unsigned*)(nxt.idx + 4 * lane), (LAS unsigned*)(lds + STAGE_BYTES + wid * 1024), 16, 0, 0); }
#pragma unroll 1
        for (int t = 0; t < nt; t += 2) {
            const bool last = (t == nt - 2);
            const char* a1 = cA + (size_t)(t + 1) * kstep;
            const char* a2 = last ? nA : cA + (size_t)(t + 2) * kstep; const char* b2 = last ? nB : cB + (size_t)(t + 2) * kstep;
            const char* a3 = a2 + kstep; const char* b3 = b2 + kstep;
            PG8_LDB(B0, 0, 0); PG8_LDB(B1, 0, 1); PG8_SCHED; PG8_LDA(At, 0, 0); PG8_STAGE(PG8_SA(1, 1), a1 + hA, a1c);
            if constexpr (GATHER) { if (last && has_next) {
                { const LAS unsigned* ix = (const LAS unsigned*)(lds + STAGE_BYTES + wid * 1024); a0n[0] = ix[gR[0]]; a0n[1] = ix[gR[1]]; a1n[0] = ix[128 + gR[0]]; a1n[1] = ix[128 + gR[1]]; }
                a0c[0] = a0n[0] * (g.lda * 2u) + (unsigned)gC[0] * 2u; a0c[1] = a0n[1] * (g.lda * 2u) + (unsigned)gC[1] * 2u; a1c[0] = a1n[0] * (g.lda * 2u) + (unsigned)gC[0] * 2u; a1c[1] = a1n[1] * (g.lda * 2u) + (unsigned)gC[1] * 2u; } }
            PG8_WAIT_V(8); PG8_WAIT_L(0); PG8_BAR; PG8_MMA(0, 0, At, B0); PG8_MMA(0, 1, At, B1); PG8_BAR; PG8_SCHED;
            PG8_LDA(At, 0, 1); PG8_STAGE(PG8_SB(0, 0), b2, voffB); PG8_STAGE(PG8_SB(0, 1), b2 + hB, voffB); PG8_STAGE(PG8_SA(0, 0), a2, a0c);
            PG8_WAIT_V(8); PG8_WAIT_L(0); PG8_BAR; PG8_MMA(1, 0, At, B0); PG8_MMA(1, 1, At, B1); PG8_BAR; PG8_SCHED;
            PG8_LDB(B0, 1, 0); PG8_LDB(B1, 1, 1); PG8_SCHED; PG8_LDA(At, 1, 0); PG8_STAGE(PG8_SA(0, 1), a2 + hA, a1c);
            PG8_WAIT_V(8); PG8_WAIT_L(0); PG8_BAR; PG8_MMA(0, 0, At, B0); PG8_MMA(0, 1, At, B1); PG8_BAR; PG8_SCHED;
            PG8_LDA(At, 1, 1); PG8_STAGE(PG8_SB(1, 0), b3, voffB); PG8_STAGE(PG8_SB(1, 1), b3 + hB, voffB); PG8_STAGE(PG8_SA(1, 0), a3, a0c);
            PG8_WAIT_V(8); PG8_WAIT_L(0); PG8_BAR; PG8_MMA(1, 0, At, B0); PG8_MMA(1, 1, At, B1); PG8_BAR; PG8_SCHED;
        }
        if constexpr (ALIGN_EPI) { if (wr == 0) PG8_BAR; }
        if constexpr (FP8) asm volatile("s_nop 15\n\ts_nop 15" ::: "memory");
        { int fr_ = fr, fq_ = fq; asm volatile("" : "+v"(fr_), "+v"(fq_)); E(acc, cur, wr, wc, fr_, fq_); }
        if (!has_next) break;
#pragma unroll
        for (int a = 0; a < 2; ++a)
#pragma unroll
            for (int b = 0; b < 2; ++b)
#pragma unroll
                for (int m = 0; m < 4; ++m)
#pragma unroll
                    for (int n = 0; n < 2; ++n) acc[a][b][m][n] = (f32x4){0.f, 0.f, 0.f, 0.f};
        cur = nxt; cA = nA; cB = nB; ++ui;
        if constexpr (ALIGN_EPI) { if (wr == 1) PG8_BAR; }
    }
    PG8_WAIT_V(0);
    if constexpr (!ALIGN_EPI) { if (wr == 0) PG8_BAR; }
    PG8_BAR;
#undef PG8_SA
#undef PG8_SB
#undef PG8_STAGE
#undef PG8_LDA
#undef PG8_IDX
#undef PG8_LD8
#undef PG8_LDB
#undef PG8_MMA
#undef PG8_WAIT_V
#undef PG8_WAIT_L
#undef PG8_BAR
#undef PG8_SCHED
}

typedef const f32x4 (&AccRef)[2][2][4][2];
__device__ __forceinline__ u32x4 pack8(const f32x4 v0, const f32x4 v1) { u32x4 w; w.x = cvt_pk_bf16(v0[0], v0[1]); w.y = cvt_pk_bf16(v0[2], v0[3]); w.z = cvt_pk_bf16(v1[0], v1[1]); w.w = cvt_pk_bf16(v1[2], v1[3]); return w; }

struct EpiBf16 {
    static constexpr bool PERM = true;
    bf16_t* O; int ldc; float scale;
    __device__ __forceinline__ void operator()(AccRef acc, const Unit& u, int wr, int wc, int fr, int fq) const {
        const int row0 = u.orow + wr * 64 + fr, col0 = u.ocol + wc * 32 + 8 * fq;
#pragma unroll
        for (int ai = 0; ai < 2; ++ai)
#pragma unroll
            for (int m = 0; m < 4; ++m) { bf16_t* rowp = O + (size_t)(row0 + ai * HALF + m * 16) * ldc + col0;
#pragma unroll
                for (int bj = 0; bj < 2; ++bj) *(u32x4*)(rowp + bj * HALF) = pack8(acc[ai][bj][m][0] * scale, acc[ai][bj][m][1] * scale); }
    }
};
struct EpiFp8 {
    static constexpr bool PERM = true;
    unsigned char* O; int ldc; float scale;
    __device__ __forceinline__ void operator()(AccRef acc, const Unit& u, int wr, int wc, int fr, int fq) const {
        const int row0 = u.orow + wr * 64 + fr, col0 = u.ocol + wc * 32 + 8 * fq;
#pragma unroll
        for (int ai = 0; ai < 2; ++ai)
#pragma unroll
            for (int m = 0; m < 4; ++m) { unsigned char* rowp = O + (size_t)(row0 + ai * HALF + m * 16) * ldc + col0;
#pragma unroll
                for (int bj = 0; bj < 2; ++bj) { const f32x4 v0 = acc[ai][bj][m][0] * scale, v1 = acc[ai][bj][m][1] * scale; u32x2 w;
                    w.x = cvt4_fp8(clamp448(v0[0]), clamp448(v0[1]), clamp448(v0[2]), clamp448(v0[3])); w.y = cvt4_fp8(clamp448(v1[0]), clamp448(v1[1]), clamp448(v1[2]), clamp448(v1[3]));
                    *(u32x2*)(rowp + bj * HALF) = w; } }
    }
};
struct EpiInProj {
    static constexpr bool PERM = true;
    bf16_t* O; const LAS f32x2* rope;
    __device__ __forceinline__ void operator()(AccRef acc, const Unit& u, int wr, int wc, int fr, int fq) const {
        const int row0 = u.orow + wr * 64 + fr, col0 = u.ocol + wc * 32 + 8 * fq;
        const bool do_rope = (u.ocol < 1024) && (u.orow < ML);
        const float sgn = (fq < 2) ? -1.f : 1.f;
#pragma unroll
        for (int ai = 0; ai < 2; ++ai)
#pragma unroll
            for (int m = 0; m < 4; ++m) { const int row = row0 + ai * HALF + m * 16; bf16_t* rowp = O + (size_t)row * INW + col0;
                f32x2 cs[8];
                if (do_rope) { const int t = row & (T - 1); const int pos = (wc & 1) ? (t & 63) : (t >> 6);
                    const LAS f32x4* rp = (const LAS f32x4*)(rope + pos * 16 + 8 * (fq & 1));
#pragma unroll
                    for (int k = 0; k < 4; ++k) { const f32x4 q = rp[k]; cs[2 * k] = (f32x2){q[0], q[1]}; cs[2 * k + 1] = (f32x2){q[2], q[3]}; } }
#pragma unroll
                for (int bj = 0; bj < 2; ++bj) { f32x4 v0 = acc[ai][bj][m][0], v1 = acc[ai][bj][m][1];
                    if (do_rope) {
#pragma unroll
                        for (int k = 0; k < 4; ++k) { const float p0 = xor32f(v0[k], fq < 2), p1 = xor32f(v1[k], fq < 2);
                            v0[k] = v0[k] * cs[k].x + sgn * p0 * cs[k].y; v1[k] = v1[k] * cs[4 + k].x + sgn * p1 * cs[4 + k].y; } }
                    *(u32x4*)(rowp + bj * HALF) = pack8(v0, v1); } }
    }
};
struct EpiF32 {
    static constexpr bool PERM = false;
    float* C; int ldc;
    __device__ __forceinline__ void operator()(AccRef acc, const Unit& u, int wr, int wc, int fr, int fq) const {
        const int row0 = u.orow + wr * 64 + fr, col0 = u.ocol + wc * 32 + 4 * fq;
#pragma unroll
        for (int ai = 0; ai < 2; ++ai)
#pragma unroll
            for (int m = 0; m < 4; ++m) { float* rowp = C + (size_t)(row0 + ai * HALF + m * 16) * ldc + col0;
#pragma unroll
                for (int bj = 0; bj < 2; ++bj)
#pragma unroll
                    for (int n = 0; n < 2; ++n) *(f32x4*)(rowp + bj * HALF + n * 16) = acc[ai][bj][m][n]; }
    }
};
struct EpiGateUp {
    static constexpr bool PERM = true;
    unsigned char* O;
    __device__ __forceinline__ void operator()(AccRef acc, const Unit& u, int wr, int wc, int fr, int fq) const {
        const int row0 = u.orow + wr * 64 + fr, col0 = u.ocol + wc * 32 + 8 * fq; constexpr float sg = 1.0f / (SX8 * SWG8);
#pragma unroll
        for (int ai = 0; ai < 2; ++ai)
#pragma unroll
            for (int m = 0; m < 4; ++m) { unsigned char* rowp = O + (size_t)(row0 + ai * HALF + m * 16) * FE + col0;
                float h[8];
#pragma unroll
                for (int k = 0; k < 4; ++k) { const float g0 = acc[ai][0][m][0][k] * sg, g1 = acc[ai][0][m][1][k] * sg;
                    h[k] = clamp448(g0 * fast_sigmoid(g0) * acc[ai][1][m][0][k] * (sg * SH8)); h[4 + k] = clamp448(g1 * fast_sigmoid(g1) * acc[ai][1][m][1][k] * (sg * SH8)); }
                u32x2 w; w.x = cvt4_fp8(h[0], h[1], h[2], h[3]); w.y = cvt4_fp8(h[4], h[5], h[6], h[7]); *(u32x2*)rowp = w; }
    }
};
struct EpiF1 {
    static constexpr bool PERM = true;
    bf16_t* GT; bf16_t* GTC;
    __device__ __forceinline__ void operator()(AccRef acc, const Unit& u, int wr, int wc, int fr, int fq) const {
        const int p = u.orow >> 8, pn = u.ocol >> 8, c0 = wr * 64 + fr, t0 = wc * 32 + 8 * fq;
        bf16_t* base; int cs;
        if (pn < 256) { base = GT + ((size_t)(pn >> 4) << 21) + (size_t)p * 4096 + (pn & 15) * 256; cs = 8192; }
        else { base = GTC + (size_t)(pn - 256) * 131072 + p * 256; cs = 512; }
        bf16_t* lp = base + (size_t)c0 * cs + t0;
#pragma unroll
        for (int ai = 0; ai < 2; ++ai)
#pragma unroll
            for (int m = 0; m < 4; ++m) { bf16_t* rp = lp + (size_t)(ai * HALF + m * 16) * cs;
#pragma unroll
                for (int bj = 0; bj < 2; ++bj) *(u32x4*)(rp + bj * HALF) = pack8(acc[ai][bj][m][0], acc[ai][bj][m][1]); }
    }
};

struct EpiF2H {
    static constexpr bool PERM = true;
    float* PQ; bf16_t* CC; unsigned* flags; unsigned epoch;
    __device__ __forceinline__ void operator()(AccRef acc, const Unit& u, int wr, int wc, int fr, int fq) const {
        const int part = u.ocol, b = u.orow >> 3, pm8 = u.orow & 7;
        float* tile = PQ + (size_t)u.orow * 65536; const int r0 = wr * 64 + fr, c0 = wc * 32 + 8 * fq;
        if (part == 0) {
#pragma unroll
            for (int ai = 0; ai < 2; ++ai)
#pragma unroll
                for (int m = 0; m < 4; ++m) { float* rp = tile + (size_t)(r0 + ai * HALF + m * 16) * 256 + c0;
#pragma unroll
                    for (int bj = 0; bj < 2; ++bj) { *(f32x4*)(rp + bj * HALF) = acc[ai][bj][m][0]; *(f32x4*)(rp + bj * HALF + 4) = acc[ai][bj][m][1]; } }
            asm volatile("s_waitcnt vmcnt(0)" ::: "memory"); __builtin_amdgcn_s_barrier();
            if (threadIdx.x == 0) { __builtin_amdgcn_fence(__ATOMIC_RELEASE, "agent"); asm volatile("s_waitcnt vmcnt(0)" ::: "memory"); __hip_atomic_store(flags + u.orow * 64, epoch, __ATOMIC_RELAXED, __HIP_MEMORY_SCOPE_AGENT); }
        } else {
            if (threadIdx.x == 0) { unsigned sp = 0; while (__hip_atomic_load(flags + u.orow * 64, __ATOMIC_RELAXED, __HIP_MEMORY_SCOPE_AGENT) < epoch) { __builtin_amdgcn_s_sleep(2); if (++sp > (1u << 20)) break; }
                __builtin_amdgcn_fence(__ATOMIC_ACQUIRE, "agent"); asm volatile("s_waitcnt vmcnt(0)" ::: "memory"); }
            __builtin_amdgcn_s_barrier(); asm volatile("" ::: "memory");
#pragma unroll
            for (int ai = 0; ai < 2; ++ai)
#pragma unroll
                for (int m = 0; m < 4; ++m) { const int r = r0 + ai * HALF + m * 16, k = pm8 * 256 + r; const float* rp = tile + (size_t)r * 256 + c0;
                    bf16_t* y0 = CC + (size_t)(b * T + k) * D + 768 + c0; bf16_t* y1 = CC + (size_t)(b * T + (T - k)) * D + 768 + c0;
#pragma unroll
                    for (int bj = 0; bj < 2; ++bj) { const f32x4 p0 = __builtin_nontemporal_load((const f32x4*)(rp + bj * HALF)), p1 = __builtin_nontemporal_load((const f32x4*)(rp + bj * HALF + 4));
                        *(u32x4*)(y0 + bj * HALF) = pack8(p0 + acc[ai][bj][m][0], p1 + acc[ai][bj][m][1]);
                        if (k > 0) *(u32x4*)(y1 + bj * HALF) = pack8(p0 - acc[ai][bj][m][0], p1 - acc[ai][bj][m][1]); } }
        }
    }
};

struct SchedPlain {
    int nN, total, G, c; const char* A; const char* B; size_t tA, tB; bool grp8;
    __device__ __forceinline__ bool next(int i, Unit& u) const { const int L = i * G + c; if (L >= total) return false; int pm = L / nN, pn = L - pm * nN;
        if (grp8) { const int gsz = 8 * nN, gi = L / gsz, r = L - gi * gsz; pm = gi * 8 + (r & 7); pn = r >> 3; }
        u.a = A + (size_t)pm * tA; u.b = B + (size_t)pn * tB; u.orow = pm * BM; u.ocol = pn * BM; u.idx = nullptr; return true; }
};
struct SchedF1 {
    int total, G, c; const char* A; const char* B;
    __device__ __forceinline__ bool next(int i, Unit& u) const { const int L = i * G + c; if (L >= total) return false; const int pn = L >> 1, pm = L & 1;
        u.a = A + (size_t)pm * (256 * 256 * 2); u.b = B + (size_t)pn * (256 * (size_t)INW * 2); u.orow = pm * BM; u.ocol = pn * BM; u.idx = nullptr; return true; }
};
struct SchedF2L {
    int G, c; const char* AT; const char* GT;
    __device__ __forceinline__ bool next(int i, Unit& u) const { const int L = i * G + c; if (L >= 256) return false;
        int b = L >> 4, pm = L & 15; if (G == 256) { const int x = L >> 5, w = L & 31; pm = (x & 3) * 4 + (w & 3); b = (x >> 2) * 8 + (w >> 2); }
        u.a = AT + (size_t)pm * (256 * 8192 * 2); u.b = GT + (size_t)b * (256 * 8192 * 2); u.orow = b * T + pm * BM; u.ocol = 768; u.idx = nullptr; return true; }
};
struct SchedF2H {
    int G, c; const char* AT; const char* GT;
    __device__ __forceinline__ bool next(int i, Unit& u) const { const int L = i * G + c; if (L >= 256) return false;
        const int x = L >> 5, w = L & 31, part = w & 1, pm8 = (x & 1) * 4 + ((w >> 1) & 3), b = (x >> 1) * 4 + (w >> 3);
        u.a = AT + (size_t)pm8 * (256 * 8192 * 2) + (size_t)part * (4096 * 2); u.b = GT + (size_t)b * (256 * 8192 * 2) + (size_t)part * (4096 * 2); u.orow = b * 8 + pm8; u.ocol = part; u.idx = nullptr; return true; }
};
struct SchedF2C {
    int G, c; const char* AC; const char* GTC;
    __device__ __forceinline__ bool next(int i, Unit& u) const { const int L = i * G + c; if (L >= 16) return false;
        u.a = AC; u.b = GTC + (size_t)L * (256 * 512 * 2); u.orow = ML + L * TC; u.ocol = 768; u.idx = nullptr; return true; }
};
struct SchedGU {
    int nrt, G, c; const char* XS; const char* W; const int* IDX;
    __device__ __forceinline__ bool next(int i, Unit& u) const { const int L = i * G + c; if (L >= 16 * 16 * nrt) return false;
        const int e = L / (16 * nrt), r = L - e * 16 * nrt;
        const int gi = r >> 6, rr = r & 63, gsz = (nrt - 4 * gi) < 4 ? (nrt - 4 * gi) : 4, half = rr / (gsz * 8), w = rr - half * gsz * 8, rt = gi * 4 + w % gsz, ct = half * 8 + w / gsz;
        const int rowbase = (rt < 32) ? (e * 17 + (rt >> 1)) * 512 + (rt & 1) * 256 : (e * 17 + 16) * 512 + (rt - 32) * 256;
        u.a = XS; u.idx = IDX + rowbase; u.b = W + (size_t)e * (2 * FE * D) + (size_t)ct * (128 * D); u.orow = rowbase; u.ocol = ct * 128; return true; }
};
struct SchedDN {
    int nrt, G, c; const char* HM; const char* W;
    __device__ __forceinline__ bool next(int i, Unit& u) const { const int L = i * G + c; if (L >= 16 * 4 * nrt) return false;
        const int e = L / (4 * nrt), r = L - e * 4 * nrt, rt = r >> 2, ct = r & 3;
        const int rowbase = (rt < 32) ? (e * 17 + (rt >> 1)) * 512 + (rt & 1) * 256 : (e * 17 + 16) * 512 + (rt - 32) * 256;
        u.a = HM + (size_t)rowbase * FE; u.b = W + (size_t)e * (D * FE) + (size_t)ct * (256 * FE); u.orow = rowbase; u.ocol = ct * 256; u.idx = nullptr; return true; }
};
}
namespace att {
constexpr int NW = 8, QBLK = 32, KVBLK = 64, LDZ = INW;
constexpr float SCALE = 0.125f, THR = 8.f;
#ifndef ATT_SDEPTH
#define ATT_SDEPTH 2
#endif
constexpr int SDEPTH = ATT_SDEPTH;
constexpr int SHM_V = KVBLK * 128 * 2, SHM_K = KVBLK * 64 * 2;
#ifndef ATT_RING3
#define ATT_RING3 1
#endif
constexpr int NBUF = ATT_RING3 ? 3 : 2;
constexpr int OFF_V = 0, OFF_K = NBUF * SHM_V, OFF_WS = OFF_K + NBUF * SHM_K, ATT_LDS = OFF_WS + NW * 64 * 4;
#define KSWZ(row, colB) ((row) * 128 + ((colB) ^ ((((row) >> 1) & 7) << 4)))
#define SBAR() __builtin_amdgcn_sched_barrier(0)
__device__ __forceinline__ int crow(int r, int hi) { return (r & 3) + 8 * (r >> 2) + 4 * hi; }
__device__ __forceinline__ void partialSM(f32x16& p0, f32x16& p1, float& m_reg, float& mn, float& alpha) {
  constexpr float C = SCALE * 1.4426950408889634f;
  float pmax = p0[0];
#pragma unroll
  for (int r = 1; r < 16; ++r) pmax = fmaxf(pmax, p0[r]);
#pragma unroll
  for (int r = 0; r < 16; ++r) pmax = fmaxf(pmax, p1[r]);
  { unsigned r0, r1; swap32(__float_as_uint(pmax), r0, r1); pmax = fmaxf(__uint_as_float(r0), __uint_as_float(r1)); }
  if (__builtin_expect(__all(pmax - m_reg <= THR / SCALE), 1)) { mn = m_reg; alpha = 1.f; }
  else { mn = fmaxf(m_reg, pmax); alpha = __builtin_amdgcn_exp2f((m_reg - mn) * C); m_reg = mn; }
  float mnC = -mn * C;
#pragma unroll
  for (int r = 0; r < 16; ++r) p0[r] = fmaf(p0[r], C, mnC);
#pragma unroll
  for (int r = 0; r < 16; ++r) p1[r] = fmaf(p1[r], C, mnC);
#ifndef ABL_NOEXP
#pragma unroll
  for (int r = 0; r < 16; ++r) p0[r] = __builtin_amdgcn_exp2f(p0[r]);
#endif
}
__device__ __forceinline__ void finishSM(f32x16& p0, f32x16& p1, float alpha, float& l_reg, bf16x8& pa0, bf16x8& pa1, bf16x8& pa2, bf16x8& pa3) {
#ifndef ABL_NOEXP
#pragma unroll
  for (int r = 0; r < 16; ++r) p1[r] = __builtin_amdgcn_exp2f(p1[r]);
#endif
  float ps = 0;
#pragma unroll
  for (int r = 0; r < 16; ++r) ps += p0[r];
#pragma unroll
  for (int r = 0; r < 16; ++r) ps += p1[r];
  { unsigned r0, r1; swap32(__float_as_uint(ps), r0, r1); ps = __uint_as_float(r0) + __uint_as_float(r1); }
  l_reg = l_reg * alpha + ps;
#define PK4(P, BASE, OUT) do { unsigned a0 = cvt_pk_bf16(P[BASE + 0], P[BASE + 1]), a1 = cvt_pk_bf16(P[BASE + 2], P[BASE + 3]);   \
    unsigned b0 = cvt_pk_bf16(P[BASE + 4], P[BASE + 5]), b1 = cvt_pk_bf16(P[BASE + 6], P[BASE + 7]);                              \
    auto r0 = __builtin_amdgcn_permlane32_swap(a0, b0, false, false); auto r1 = __builtin_amdgcn_permlane32_swap(a1, b1, false, false); \
    u32x4 w = {r0[0], r1[0], r0[1], r1[1]}; OUT = __builtin_bit_cast(bf16x8, w); } while (0)
  PK4(p0, 0, pa0); PK4(p0, 8, pa1); PK4(p1, 0, pa2); PK4(p1, 8, pa3);
#undef PK4
}
__device__ __forceinline__ void qkt(f32x16& p0, f32x16& p1, const LAS char* Ks, const bf16x8* qr, int r32, int hi) {
#pragma unroll
  for (int r = 0; r < 16; ++r) { p0[r] = 0.f; p1[r] = 0.f; }
#pragma unroll
  for (int d0 = 0; d0 < 4; ++d0) { const int cb = (d0 * 16 + hi * 8) * 2;
    bf16x8 b0 = *(const LAS bf16x8*)(Ks + KSWZ(r32, cb));
    bf16x8 b1 = *(const LAS bf16x8*)(Ks + KSWZ(32 + r32, cb));
    p0 = __builtin_amdgcn_mfma_f32_32x32x16_bf16(b0, qr[d0], p0, 0, 0, 0);
    p1 = __builtin_amdgcn_mfma_f32_32x32x16_bf16(b1, qr[d0], p1, 0, 0, 0); }
}
__device__ __forceinline__ int v_st(int k, int c) { const int kk = (k & ~0xC) | ((k & 4) << 1) | ((k & 8) >> 1); return ((kk >> 3) * 4 + (c >> 5)) * 512 + ((kk & 7) * 32 + (c & 31)) * 2; }
__device__ __forceinline__ int v_rd_base(int lane) { return ((lane & 3) << 3) | (((lane >> 2) & 3) << 6) | (((lane >> 4) & 1) << 5) | (((lane >> 5) & 1) << 8); }
constexpr int v_rd_off(int d0, int ks, int half) { return d0 * 512 + ks * 4096 + half * 2048; }
template <int OFF> __device__ __forceinline__ s16x4 tr_read(int vb) {
  s16x4 r; asm volatile("ds_read_b64_tr_b16 %0, %1 offset:%2" : "=&v"(r) : "v"(vb), "i"(OFF) : "memory"); return r;
}
template <int D0> __device__ __forceinline__ void pv_one(f32x16& od, int vb, bf16x8 pa0, bf16x8 pa1, bf16x8 pa2, bf16x8 pa3) {
  const s16x4 l0 = tr_read<v_rd_off(D0, 0, 0)>(vb), h0 = tr_read<v_rd_off(D0, 0, 1)>(vb), l1 = tr_read<v_rd_off(D0, 1, 0)>(vb), h1 = tr_read<v_rd_off(D0, 1, 1)>(vb);
  const s16x4 l2 = tr_read<v_rd_off(D0, 2, 0)>(vb), h2 = tr_read<v_rd_off(D0, 2, 1)>(vb), l3 = tr_read<v_rd_off(D0, 3, 0)>(vb), h3 = tr_read<v_rd_off(D0, 3, 1)>(vb);
  asm volatile("s_waitcnt lgkmcnt(0)" ::: "memory"); SBAR();
#define PK(L, H) (bf16x8){L[0], L[1], L[2], L[3], H[0], H[1], H[2], H[3]}
  od = __builtin_amdgcn_mfma_f32_32x32x16_bf16(pa0, PK(l0, h0), od, 0, 0, 0);
  od = __builtin_amdgcn_mfma_f32_32x32x16_bf16(pa1, PK(l1, h1), od, 0, 0, 0);
  od = __builtin_amdgcn_mfma_f32_32x32x16_bf16(pa2, PK(l2, h2), od, 0, 0, 0);
  od = __builtin_amdgcn_mfma_f32_32x32x16_bf16(pa3, PK(l3, h3), od, 0, 0, 0);
#undef PK
}
__device__ __forceinline__ void pv_d0(f32x16* o, int vb, bf16x8 pa0, bf16x8 pa1, bf16x8 pa2, bf16x8 pa3) {
  pv_one<0>(o[0], vb, pa0, pa1, pa2, pa3); pv_one<1>(o[1], vb, pa0, pa1, pa2, pa3); pv_one<2>(o[2], vb, pa0, pa1, pa2, pa3); pv_one<3>(o[3], vb, pa0, pa1, pa2, pa3);
}

__device__ __forceinline__ void diff_attn_unit(const bf16_t* __restrict__ Z, bf16_t* __restrict__ CC, float* o1s, const float* __restrict__ gvec, float lam, float gsc,
                                               int qrow0, int h, int seg0, int n0, int seg1, int NT, LAS char* lds, int tid) {
  asm volatile("" : "+v"(tid));
  const int wid = tid >> 6, lane = tid & 63, r32 = lane & 31, hi = lane >> 5;
  LAS char* V_lds = lds + OFF_V; LAS char* K_lds = lds + OFF_K;
  LAS float* ws = (LAS float*)(lds + OFF_WS) + wid * 64; LAS float* li_l = ws; LAS float* al_l = ws + 32;
  const int sr = tid >> 4, sc = (tid & 15) * 8, vst0 = v_st(sr, sc), vst1 = v_st(32 + sr, sc);
  const int kr = tid >> 3, kc = (tid & 7) * 8, kst = KSWZ(kr, kc * 2);
  const int vb0 = (int)(uintptr_t)V_lds + v_rd_base(lane);
  const bf16_t* Vcol = Z + 1024 + h * 128 + sc;
  for (int mp = 0; mp < 2; ++mp) {
    __syncthreads();
    const bf16_t* Kcol = Z + 512 + h * 128 + mp * 64 + kc;
    float m_reg = -1e30f, l_reg = 0; f32x16 o[4]; bf16x8 qr[4];
#pragma unroll
    for (int d = 0; d < 4; ++d)
#pragma unroll
      for (int r = 0; r < 16; ++r) o[d][r] = 0.f;
    const bf16_t* Qw = Z + (size_t)(qrow0 + wid * QBLK + r32) * LDZ + h * 128 + mp * 64 + hi * 8;
#pragma unroll
    for (int d0 = 0; d0 < 4; ++d0) qr[d0] = *(const bf16x8*)(Qw + d0 * 16);
    struct { bf16x8 vs0, vs1, ks; } sr_[SDEPTH];
#define TROW(j) ((j) < n0 ? seg0 + (j) * KVBLK : seg1 + ((j) - n0) * KVBLK)
#define SLOAD(i, j) do { const int _k0 = TROW(j); sr_[i].vs0 = *(const bf16x8*)(Vcol + (size_t)(_k0 + sr) * LDZ); sr_[i].vs1 = *(const bf16x8*)(Vcol + (size_t)(_k0 + 32 + sr) * LDZ); \
    sr_[i].ks = *(const bf16x8*)(Kcol + (size_t)(_k0 + kr) * LDZ); } while (0)
#define SWRITE(b, i) do { *(LAS bf16x8*)(V_lds + (b) * SHM_V + vst0) = sr_[i].vs0; *(LAS bf16x8*)(V_lds + (b) * SHM_V + vst1) = sr_[i].vs1; \
    *(LAS bf16x8*)(K_lds + (b) * SHM_K + kst) = sr_[i].ks; } while (0)
#define SWAIT() do { if constexpr (SDEPTH == 2) asm volatile("s_waitcnt vmcnt(3)" ::: "memory"); else asm volatile("s_waitcnt vmcnt(0)" ::: "memory"); } while (0)
#define RESC(a) do { if (__any((a) < 1.f)) { if (hi == 0) al_l[r32] = (a); asm volatile("s_waitcnt lgkmcnt(0)" ::: "memory"); \
    _Pragma("unroll") for (int d = 0; d < 4; ++d) _Pragma("unroll") for (int r = 0; r < 16; ++r) o[d][r] *= al_l[crow(r, hi)]; } } while (0)
    f32x16 pA0, pA1, pB0, pB1; float mnA, mnB, alA, alB; bf16x8 pa0, pa1, pa2, pa3;
    constexpr int SE = 0, SO = SDEPTH - 1;
    SLOAD(SE, 0); asm volatile("s_waitcnt vmcnt(0)" ::: "memory"); SWRITE(0, SE); __syncthreads();
    qkt(pA0, pA1, K_lds, qr, r32, hi); partialSM(pA0, pA1, m_reg, mnA, alA);
    SLOAD(SO, 1); if constexpr (SDEPTH == 2) { if (2 < NT) SLOAD(SE, 2); }
    SWAIT(); SWRITE(1, SO); __syncthreads();
#if ATT_RING3
    int b0 = 0, b1 = 1, b2 = 2;
    for (int j = 1; j + 1 < NT; j += 2) {
      SBAR(); qkt(pB0, pB1, K_lds + b1 * SHM_K, qr, r32, hi);
      finishSM(pA0, pA1, alA, l_reg, pa0, pa1, pa2, pa3); SBAR();
      SLOAD(SO, j + SDEPTH); SBAR();
      pv_d0(o, vb0 + b0 * SHM_V, pa0, pa1, pa2, pa3); partialSM(pB0, pB1, m_reg, mnB, alB);
      SWAIT(); SWRITE(b2, SE);
      RESC(alB); __syncthreads();
      SBAR(); qkt(pA0, pA1, K_lds + b2 * SHM_K, qr, r32, hi);
      finishSM(pB0, pB1, alB, l_reg, pa0, pa1, pa2, pa3); SBAR();
      if (SDEPTH == 1 || j + 3 < NT) SLOAD(SE, j + 1 + SDEPTH); SBAR();
      pv_d0(o, vb0 + b1 * SHM_V, pa0, pa1, pa2, pa3); partialSM(pA0, pA1, m_reg, mnA, alA);
      SWAIT(); SWRITE(b0, SO);
      RESC(alA); __syncthreads();
      { const int t0_ = b0; b0 = b2; b2 = b1; b1 = t0_; }
    }
    SBAR(); qkt(pB0, pB1, K_lds + b1 * SHM_K, qr, r32, hi);
    finishSM(pA0, pA1, alA, l_reg, pa0, pa1, pa2, pa3); SBAR();
    pv_d0(o, vb0 + b0 * SHM_V, pa0, pa1, pa2, pa3); partialSM(pB0, pB1, m_reg, mnB, alB);
    RESC(alB);
    finishSM(pB0, pB1, alB, l_reg, pa0, pa1, pa2, pa3); SBAR();
    pv_d0(o, vb0 + b1 * SHM_V, pa0, pa1, pa2, pa3);
#else
    for (int j = 1; j + 1 < NT; j += 2) {
      SBAR(); qkt(pB0, pB1, K_lds + SHM_K, qr, r32, hi);
      finishSM(pA0, pA1, alA, l_reg, pa0, pa1, pa2, pa3); SBAR();
      SLOAD(SO, j + SDEPTH); SBAR();
      pv_d0(o, vb0, pa0, pa1, pa2, pa3); partialSM(pB0, pB1, m_reg, mnB, alB);
      __syncthreads(); SWAIT(); SWRITE(0, SE);
      RESC(alB); __syncthreads();
      SBAR(); qkt(pA0, pA1, K_lds, qr, r32, hi);
      finishSM(pB0, pB1, alB, l_reg, pa0, pa1, pa2, pa3); SBAR();
      if (SDEPTH == 1 || j + 3 < NT) SLOAD(SE, j + 1 + SDEPTH); SBAR();
      pv_d0(o, vb0 + SHM_V, pa0, pa1, pa2, pa3); partialSM(pA0, pA1, m_reg, mnA, alA);
      __syncthreads(); SWAIT(); SWRITE(1, SO);
      RESC(alA); __syncthreads();
    }
    SBAR(); qkt(pB0, pB1, K_lds + SHM_K, qr, r32, hi);
    finishSM(pA0, pA1, alA, l_reg, pa0, pa1, pa2, pa3); SBAR();
    pv_d0(o, vb0, pa0, pa1, pa2, pa3); partialSM(pB0, pB1, m_reg, mnB, alB);
    __syncthreads(); RESC(alB);
    finishSM(pB0, pB1, alB, l_reg, pa0, pa1, pa2, pa3); SBAR();
    pv_d0(o, vb0 + SHM_V, pa0, pa1, pa2, pa3);
#endif
    if (hi == 0) li_l[r32] = l_reg; asm volatile("s_waitcnt lgkmcnt(0)" ::: "memory");
    float rli[16];
#pragma unroll
    for (int r = 0; r < 16; ++r) rli[r] = __builtin_amdgcn_rcpf(li_l[crow(r, hi)]);
    float* op = o1s + tid * 64;
    if (mp == 0) {
#pragma unroll
      for (int d0 = 0; d0 < 4; ++d0)
#pragma unroll
        for (int r4 = 0; r4 < 4; ++r4) *(f32x4*)(op + d0 * 16 + r4 * 4) = (f32x4){o[d0][4 * r4] * rli[4 * r4], o[d0][4 * r4 + 1] * rli[4 * r4 + 1], o[d0][4 * r4 + 2] * rli[4 * r4 + 2], o[d0][4 * r4 + 3] * rli[4 * r4 + 3]};
    } else {
      float ss[16];
#pragma unroll
      for (int r = 0; r < 16; ++r) ss[r] = 0.f;
#pragma unroll
      for (int d0 = 0; d0 < 4; ++d0)
#pragma unroll
        for (int r4 = 0; r4 < 4; ++r4) { const f32x4 o1 = __builtin_nontemporal_load((const f32x4*)(op + d0 * 16 + r4 * 4));
#pragma unroll
          for (int k = 0; k < 4; ++k) { const int r = 4 * r4 + k; const float v = o1[k] - lam * (o[d0][r] * rli[r]); o[d0][r] = v; ss[r] += v * v; } }
#pragma unroll
      for (int r = 0; r < 16; ++r) {
        ss[r] = row32_sum(ss[r]);
        ss[r] = __builtin_amdgcn_rsqf(ss[r] * (1.0f / 128.0f) + RMS_EPS) * gsc; }
      float gg[4];
#pragma unroll
      for (int d0 = 0; d0 < 4; ++d0) gg[d0] = gvec[h * 128 + d0 * 32 + r32];
      bf16_t* Ow = CC + (size_t)(qrow0 + wid * QBLK) * D + h * 128 + r32;
#pragma unroll
      for (int r = 0; r < 16; ++r) { int roff = crow(r, hi) * D; asm volatile("" : "+v"(roff)); bf16_t* rp = Ow + roff;
#pragma unroll
        for (int d0 = 0; d0 < 4; ++d0) rp[d0 * 32] = (bf16_t)f2bf(o[d0][r] * ss[r] * gg[d0]); }
    }
#undef TROW
#undef SLOAD
#undef SWRITE
#undef SWAIT
#undef RESC
  }
}
#undef KSWZ
}
struct Args { const float* in[28]; float* out; unsigned char* ws; int ph_lo, ph_hi, li, pad; };
struct Frame {
    LAS unsigned char* lds;
    int tid, lane, wave, vcu, G;
    unsigned char* ws;
};
enum { I_X = 0, I_C, I_CTX, I_CCTX, I_WMOD, I_BMOD, I_WIN, I_LQ1, I_LK1, I_LQ2, I_LK2, I_ANG, I_CONVW, I_CONVB, I_LWA, I_LBA, I_LWX, I_LBX, I_LLAM, I_WOUT,
       I_LN1G, I_LN1B, I_WR, I_WG, I_WU, I_WD, I_LN2G, I_LN2B };

__device__ __forceinline__ void transpose_item(const float* W, int N, bf16_t* WT, int ldt, LAS float* scr, int kb, int nb, int lane) {
    const int k0 = 64 * kb, n0 = 32 * nb;
#pragma unroll 8
    for (int i = 0; i < 32; ++i) { const int kk = 2 * i + (lane >> 5); scr[kk * 33 + (lane & 31)] = W[(size_t)(k0 + kk) * N + n0 + (lane & 31)]; }
    LDS_WAIT(); asm volatile("" ::: "memory");
    const int c = lane & 7;
#pragma unroll
    for (int j = 0; j < 4; ++j) { const int n = (lane >> 3) + 8 * j; const LAS float* s = scr + (8 * c) * 33 + n;
        u32x4 o; o.x = pk2(s[0 * 33], s[1 * 33]); o.y = pk2(s[2 * 33], s[3 * 33]); o.z = pk2(s[4 * 33], s[5 * 33]); o.w = pk2(s[6 * 33], s[7 * 33]);
        *(u32x4*)(WT + (size_t)(n0 + n) * ldt + k0 + 8 * c) = o; }
    LDS_WAIT(); asm volatile("" ::: "memory");
}

__device__ __forceinline__ void p0a(Frame& F, const Args& args) {
    const int gw = F.vcu * NWAVES + F.wave, NGW = F.G * NWAVES;
    LAS float* scr = (LAS float*)(F.lds + F.wave * 16384);
    { constexpr int IA = 16 * 72, IB = 16 * 32, PER = IA + IB;
      for (int it = gw; it < DEPTH * PER; it += NGW) { const int l = it / PER, r = it - l * PER;
        if (r < IA) transpose_item(args.in[I_WIN] + (size_t)l * D * INW, INW, (bf16_t*)(F.ws + WS_WIN) + (size_t)l * INW * D, D, scr, r / 72, r % 72, F.lane);
        else { const int r2 = r - IA; transpose_item(args.in[I_WOUT] + (size_t)l * D * D, D, (bf16_t*)(F.ws + WS_WOUT) + (size_t)l * D * D, D, scr, r2 / 32, r2 % 32, F.lane); } } }
    __syncthreads();
    { LAS float* sl = (LAS float*)F.lds;
      LAS float* cmb = sl + 17 * 1024;
      bool loaded = false;
      for (int it = F.vcu; it < DEPTH * 24; it += F.G) {
        if (!loaded) { for (int i = F.tid; i < 17 * 1024; i += NTHR) { const float c = (i < 16 * 1024) ? args.in[I_C][i] : args.in[I_CCTX][i - 16 * 1024]; sl[i] = c * fast_sigmoid(c); } loaded = true; }
        __syncthreads();
        const int l = it / 24, nb = it % 24, col = nb * 256 + (F.tid & 255), kh = F.tid >> 8;
        const float* wp = args.in[I_WMOD] + (size_t)l * D * 6144 + (size_t)(kh * 512) * 6144 + col;
        float acc[17];
#pragma unroll
        for (int j = 0; j < 17; ++j) acc[j] = 0.f;
        const float* wq = wp; float w0 = wq[0], w1 = wq[6144], w2 = wq[2 * 6144], w3 = wq[3 * 6144];
#pragma unroll 1
        for (int k = 0; k < 512; k += 4) {
            wq += 4 * 6144; const bool more = (k + 4 < 512);
            const float n0 = more ? wq[0] : 0.f, n1 = more ? wq[6144] : 0.f, n2 = more ? wq[2 * 6144] : 0.f, n3 = more ? wq[3 * 6144] : 0.f;
#pragma unroll
            for (int j = 0; j < 17; ++j) { const f32x4 s = *(const LAS f32x4*)(sl + j * 1024 + kh * 512 + k); acc[j] += s[0] * w0 + s[1] * w1 + s[2] * w2 + s[3] * w3; }
            w0 = n0; w1 = n1; w2 = n2; w3 = n3; }
        if (kh == 1) {
#pragma unroll
            for (int j = 0; j < 17; ++j) cmb[j * 256 + (F.tid & 255)] = acc[j]; }
        __syncthreads();
        if (kh == 0) { const float bm = args.in[I_BMOD][l * 6144 + col]; float* mo = (float*)(F.ws + WS_MOD) + (size_t)l * 17 * 6144 + col;
#pragma unroll
            for (int j = 0; j < 17; ++j) mo[(size_t)j * 6144] = acc[j] + cmb[j * 256 + (F.tid & 255)] + bm; }
        __syncthreads(); } }
    __syncthreads();
    { LAS f32x2* tab = (LAS f32x2*)F.lds;
      for (int r = F.tid; r < 4096; r += NTHR) { float s, c; sincospif((float)r * (1.0f / 2048.0f), &s, &c); tab[r] = (f32x2){c, s}; }
      __syncthreads();
      bf16_t* AT = (bf16_t*)(F.ws + WS_AT);
      for (int k = F.vcu; k < 2048; k += F.G) {
        for (int c8 = F.tid; c8 < 1024; c8 += NTHR) { const int half = c8 >> 9, t0 = (c8 & 511) * 8; unsigned w[4];
#pragma unroll
            for (int q = 0; q < 4; ++q) { const f32x2 e0 = tab[(k * (t0 + 2 * q)) & 4095], e1 = tab[(k * (t0 + 2 * q + 1)) & 4095];
                w[q] = half ? pk2(-e0.y * (1.f / 64.f), -e1.y * (1.f / 64.f)) : pk2(e0.x * (1.f / 64.f), e1.x * (1.f / 64.f)); }
            *(u32x4*)(AT + (size_t)k * 8192 + half * 4096 + t0) = (u32x4){w[0], w[1], w[2], w[3]}; } }
      bf16_t* AC = (bf16_t*)(F.ws + WS_SMALL + SM_AC);
      for (int i = gw * 64 + F.lane; i < 256 * 512; i += NGW * 64) { const int k = i >> 9, c = i & 511, half = c >> 8, t = c & 255; const f32x2 e = tab[((k * t) & 255) * 16];
        AC[i] = (bf16_t)f2bf(half ? -e.y * (1.f / 16.f) : e.x * (1.f / 16.f)); }
      bf16_t* DC = (bf16_t*)(F.ws + WS_SMALL + SM_DC);
      for (int i = gw * 64 + F.lane; i < 512 * 256; i += NGW * 64) { const int r = i >> 8, col = i & 255, p = r >> 8, g = (r >> 6) & 3, cp = r & 63, g2 = col >> 6, c = col & 63;
        const f32x2 e = tab[((c * cp) & 63) * 64]; DC[i] = (bf16_t)((g == g2) ? f2bf((p ? e.y : e.x) * 0.125f) : 0u); }
    }
    { bf16_t* LW = (bf16_t*)(F.ws + WS_SMALL + SM_LRUW);
      for (int i = gw * 64 + F.lane; i < 4 * 2 * 2 * 4 * 4096; i += NGW * 64) { const int k = i & 63, n = (i >> 6) & 63, blk = (i >> 12) & 3, gate = (i >> 14) & 1, ld = i >> 15;
        const float* src = (gate ? args.in[I_LWX] : args.in[I_LWA]) + ((size_t)(ld * 4 + blk) * 64 + k) * 64 + n; LW[i] = (bf16_t)f2bf(*src); } }
    if (F.vcu == 0 && F.wave == 0) { float* lamv = (float*)(F.ws + WS_SMALL + SM_LAM);
      for (int l = 0; l < DEPTH; ++l) { const float a = wave_sum(args.in[I_LQ1][l * 64 + F.lane] * args.in[I_LK1][l * 64 + F.lane]), b = wave_sum(args.in[I_LQ2][l * 64 + F.lane] * args.in[I_LK2][l * 64 + F.lane]);
        const float li = 0.8f - 0.6f * expf(-0.3f * (float)l); if (F.lane == 0) lamv[l] = expf(a) - expf(b) + li; } }
    __syncthreads();
}

__device__ __forceinline__ void ln_mod_store(const f32x4 (&v)[4], const float* md_sh, const float* md_sc, bf16_t* hrow, int lane) {
    float s = 0.f;
#pragma unroll
    for (int q = 0; q < 4; ++q) s += (v[q][0] + v[q][1]) + (v[q][2] + v[q][3]);
    const float mean = wave_sum(s) * (1.f / D); float s2 = 0.f; f32x4 d[4];
#pragma unroll
    for (int q = 0; q < 4; ++q) { d[q] = v[q] - mean; s2 += (d[q][0] * d[q][0] + d[q][1] * d[q][1]) + (d[q][2] * d[q][2] + d[q][3] * d[q][3]); }
    const float rstd = __builtin_amdgcn_rsqf(wave_sum(s2) * (1.f / D) + LN_EPS);
#pragma unroll
    for (int q = 0; q < 4; ++q) { const int col = 4 * lane + 256 * q; const f32x4 sh = *(const f32x4*)(md_sh + col), sc = *(const f32x4*)(md_sc + col);
        const f32x4 h = d[q] * rstd * (sc + 1.0f) + sh; u32x2 w; w.x = cvt_pk_bf16(h[0], h[1]); w.y = cvt_pk_bf16(h[2], h[3]); *(u32x2*)(hrow + col) = w; }
}
__device__ __forceinline__ void p0b(Frame& F, const Args& args) {
    const int gw = F.vcu * NWAVES + F.wave, NGW = F.G * NWAVES;
    bf16_t* H = (bf16_t*)(F.ws + WS_H); const float* mod = (const float*)(F.ws + WS_MOD);
#define SRCROW(mm) ((mm) < ML ? args.in[I_X] + (size_t)(mm) * D : args.in[I_CTX] + (size_t)((mm) - ML) * D)
    f32x4 vn[4];
    if (gw < M) {
#pragma unroll
        for (int q = 0; q < 4; ++q) vn[q] = *(const f32x4*)(SRCROW(gw) + 4 * F.lane + 256 * q); }
    for (int m = gw; m < M; m += NGW) { const int j = m < ML ? (m >> 12) : 16;
        f32x4 v[4], shp[4], scp[4]; const float* md = mod + (size_t)j * 6144;
#pragma unroll
        for (int q = 0; q < 4; ++q) { v[q] = vn[q]; shp[q] = *(const f32x4*)(md + 4 * F.lane + 256 * q); scp[q] = *(const f32x4*)(md + D + 4 * F.lane + 256 * q); }
        asm volatile("" ::: "memory");
        if (m + NGW < M) {
#pragma unroll
            for (int q = 0; q < 4; ++q) vn[q] = *(const f32x4*)(SRCROW(m + NGW) + 4 * F.lane + 256 * q); }
        asm volatile("" ::: "memory");
        float s = 0.f;
#pragma unroll
        for (int q = 0; q < 4; ++q) s += (v[q][0] + v[q][1]) + (v[q][2] + v[q][3]);
        const float mean = wave_sum(s) * (1.f / D); float s2 = 0.f;
#pragma unroll
        for (int q = 0; q < 4; ++q) { v[q] = v[q] - mean; s2 += (v[q][0] * v[q][0] + v[q][1] * v[q][1]) + (v[q][2] * v[q][2] + v[q][3] * v[q][3]); }
        const float rstd = __builtin_amdgcn_rsqf(wave_sum(s2) * (1.f / D) + LN_EPS);
#pragma unroll
        for (int q = 0; q < 4; ++q) { const f32x4 h = v[q] * rstd * (scp[q] + 1.0f) + shp[q]; u32x2 w; w.x = cvt_pk_bf16(h[0], h[1]); w.y = cvt_pk_bf16(h[2], h[3]); *(u32x2*)(H + (size_t)m * D + 4 * F.lane + 256 * q) = w; } }
#undef SRCROW
}

__device__ __forceinline__ void pw_item(const float* W, int N, unsigned char* WT, int ldt, LAS float* scr, int kb, int nb, int tid, float scale) {
    const int wave = tid >> 6, lane = tid & 63, k0 = 128 * kb, n0 = 256 * nb;
    const float* src = W + (size_t)(k0 + wave * 16) * N + n0 + lane * 4;
#pragma unroll
    for (int i = 0; i < 16; ++i) *(LAS f32x4*)(scr + (wave * 16 + i) * 260 + lane * 4) = *(const f32x4*)(src + (size_t)i * N);
    __syncthreads();
    const int n = tid & 255, kh = tid >> 8; const LAS float* s = scr + (64 * kh) * 260 + n; unsigned char* dst = WT + (size_t)(n0 + n) * ldt + k0 + 64 * kh;
#pragma unroll
    for (int h = 0; h < 4; ++h) { unsigned w[4];
#pragma unroll
        for (int g = 0; g < 4; ++g) { const LAS float* p = s + (16 * h + 4 * g) * 260; w[g] = cvt4_fp8(p[0] * scale, p[260] * scale, p[520] * scale, p[780] * scale); }
        *(u32x4*)(dst + 16 * h) = (u32x4){w[0], w[1], w[2], w[3]}; }
    __syncthreads();
}
__device__ __forceinline__ void pw_experts(Frame& F, const Args& args, int l) {
    LAS float* scr = (LAS float*)F.lds;
    unsigned char* WGU = F.ws + WS_WEXP; unsigned char* WDN = F.ws + WS_WDN;
    for (int it = F.vcu; it < NE * 192; it += F.G) { const int e = it / 192, r = it - e * 192, which = r >> 6, q = r & 63;
        if (which < 2) pw_item(args.in[which ? I_WU : I_WG] + ((size_t)l * NE + e) * D * FE, FE, WGU + ((size_t)e * 2 + which) * FE * D, D, scr, q >> 3, q & 7, F.tid, SWG8);
        else pw_item(args.in[I_WD] + ((size_t)l * NE + e) * FE * D, D, WDN + (size_t)e * D * FE, FE, scr, q >> 2, q & 3, F.tid, SWD8); }
}

__device__ __forceinline__ void pe_phase(Frame& F, const Args& args, int l, int nrows) {
    const int gw = F.vcu * NWAVES + F.wave, NGW = F.G * NWAVES;
    LAS f32x4* WR4 = (LAS f32x4*)F.lds;
    { const float* wr = args.in[I_WR] + (size_t)l * D * NE;
      for (int i = F.tid; i < 16 * 4 * 64; i += NTHR) { const int ln = i & 63, e4 = (i >> 6) & 3, qi = i >> 8, q = qi >> 2, ii = qi & 3; WR4[i] = *(const f32x4*)(wr + (size_t)(4 * ln + ii + 256 * q) * NE + 4 * e4); } }
    __syncthreads();
    float* X = (float*)(F.ws + WS_X); const bf16_t* MIX = (const bf16_t*)(F.ws + WS_ZR); unsigned char* H8 = F.ws + WS_H; float* SC = (float*)(F.ws + WS_SC);
    const float* mod = (const float*)(F.ws + WS_MOD) + (size_t)l * 17 * 6144;
    const float* g1p = args.in[I_LN1G] + l * D; const float* b1p = args.in[I_LN1B] + l * D;
    f32x4 xn[4]; u32x2 mn[4];
    const float* Xin0 = (l == 0) ? args.in[I_X] : X; const float* Xin1 = (l == 0) ? args.in[I_CTX] - (size_t)ML * D : X;
#define XROW(mm) (((mm) < ML ? Xin0 : Xin1) + (size_t)(mm) * D)
    if (gw < nrows) {
#pragma unroll
        for (int q = 0; q < 4; ++q) { const int col = 4 * F.lane + 256 * q; xn[q] = *(const f32x4*)(XROW(gw) + col); mn[q] = *(const u32x2*)(MIX + (size_t)gw * D + col); } }
    f32x4 g1r[4], b1r[4];
#pragma unroll
    for (int q = 0; q < 4; ++q) { g1r[q] = *(const f32x4*)(g1p + 4 * F.lane + 256 * q); b1r[q] = *(const f32x4*)(b1p + 4 * F.lane + 256 * q); }
    for (int m = gw; m < nrows; m += NGW) { const int j = m < ML ? (m >> 12) : 16; const float* md = mod + (size_t)j * 6144;
        f32x4 v[4], gm[4], sh2[4], sc2[4]; float s = 0.f;
#pragma unroll
        for (int q = 0; q < 4; ++q) { const int col = 4 * F.lane + 256 * q; gm[q] = *(const f32x4*)(md + 2 * D + col); }
#pragma unroll
        for (int q = 0; q < 4; ++q) { const int col = 4 * F.lane + 256 * q; sh2[q] = *(const f32x4*)(md + 3 * D + col); sc2[q] = *(const f32x4*)(md + 4 * D + col); }
#pragma unroll
        for (int q = 0; q < 4; ++q) { const f32x4 mx4 = (f32x4){bflo(mn[q].x), bfhi(mn[q].x), bflo(mn[q].y), bfhi(mn[q].y)};
            v[q] = xn[q] * DN_ALPHA + gm[q] * mx4; s += (v[q][0] + v[q][1]) + (v[q][2] + v[q][3]); }
        asm volatile("" ::: "memory");
        if (m + NGW < nrows) {
#pragma unroll
            for (int q = 0; q < 4; ++q) { const int col = 4 * F.lane + 256 * q; xn[q] = *(const f32x4*)(XROW(m + NGW) + col); mn[q] = *(const u32x2*)(MIX + (size_t)(m + NGW) * D + col); } }
        asm volatile("" ::: "memory");
        const float mean = wave_sum(s) * (1.f / D); float s2 = 0.f;
#pragma unroll
        for (int q = 0; q < 4; ++q) { v[q] = v[q] - mean; s2 += (v[q][0] * v[q][0] + v[q][1] * v[q][1]) + (v[q][2] * v[q][2] + v[q][3] * v[q][3]); }
        const float rstd = __builtin_amdgcn_rsqf(wave_sum(s2) * (1.f / D) + LN_EPS); s = 0.f;
#pragma unroll
        for (int q = 0; q < 4; ++q) { const int col = 4 * F.lane + 256 * q; v[q] = v[q] * rstd * g1r[q] + b1r[q]; *(f32x4*)(X + (size_t)m * D + col) = v[q];
            s += (v[q][0] + v[q][1]) + (v[q][2] + v[q][3]); }
        const float mean2 = wave_sum(s) * (1.f / D); s2 = 0.f;
#pragma unroll
        for (int q = 0; q < 4; ++q) { v[q] = v[q] - mean2; s2 += (v[q][0] * v[q][0] + v[q][1] * v[q][1]) + (v[q][2] * v[q][2] + v[q][3] * v[q][3]); }
        const float rstd2 = __builtin_amdgcn_rsqf(wave_sum(s2) * (1.f / D) + LN_EPS);
        float lg[16];
#pragma unroll
        for (int e = 0; e < 16; ++e) lg[e] = 0.f;
#pragma unroll
        for (int q = 0; q < 4; ++q) { const int col = 4 * F.lane + 256 * q;
            const f32x4 h = v[q] * rstd2 * (sc2[q] + 1.0f) + sh2[q]; *(unsigned*)(H8 + (size_t)m * D + col) = cvt4_fp8(clamp448(h[0] * SX8), clamp448(h[1] * SX8), clamp448(h[2] * SX8), clamp448(h[3] * SX8));
#pragma unroll
            for (int ii = 0; ii < 4; ++ii)
#pragma unroll
                for (int e4 = 0; e4 < 4; ++e4) { const f32x4 w4 = WR4[((q * 4 + ii) * 4 + e4) * 64 + F.lane];
#pragma unroll
                    for (int k = 0; k < 4; ++k) lg[e4 * 4 + k] += h[ii] * w4[k]; } }
        float r1[8], r2[4];
#pragma unroll
        for (int k = 0; k < 8; ++k) { const float ta = lg[k] + xor32f(lg[k], F.lane < 32), tb = lg[k + 8] + xor32f(lg[k + 8], F.lane < 32); r1[k] = (F.lane & 32) ? tb : ta; }
#pragma unroll
        for (int k = 0; k < 4; ++k) { const float ta = r1[k] + swz16f(r1[k]), tb = r1[k + 4] + swz16f(r1[k + 4]); r2[k] = (F.lane & 16) ? tb : ta; }
        float mx = -1e30f;
#pragma unroll
        for (int k = 0; k < 4; ++k) { float t = r2[k]; t += dppf<0xB1>(t); t += dppf<0x4E>(t); t += dppf<0x141>(t); t += dppf<0x140>(t); r2[k] = t; mx = fmaxf(mx, t); }
        mx = fmaxf(mx, swz16f(mx)); mx = fmaxf(mx, xor32f(mx, F.lane < 32));
        float se = 0.f;
#pragma unroll
        for (int k = 0; k < 4; ++k) { r2[k] = __expf(r2[k] - mx); se += r2[k]; }
        se += swz16f(se); se += xor32f(se, F.lane < 32);
        const float inv = 1.0f / se;
        if ((F.lane & 15) == 0) *(f32x4*)(SC + (size_t)m * NE + 4 * (F.lane >> 4)) = (f32x4){r2[0] * inv, r2[1] * inv, r2[2] * inv, r2[3] * inv}; }
#undef XROW
    __syncthreads();
}

__device__ __forceinline__ int block_sum_i(LAS int* red, int v, int wave, int lane) {
    v = wave_sum_i(v);
    if (lane == 0) red[wave] = v;
    __syncthreads();
    int s = 0;
#pragma unroll
    for (int w = 0; w < 8; ++w) s += red[w];
    return s;
}
__device__ __forceinline__ int lower_lanes(unsigned long long m) { return (int)__builtin_amdgcn_mbcnt_hi((unsigned)(m >> 32), __builtin_amdgcn_mbcnt_lo((unsigned)m, 0u)); }
__device__ __forceinline__ void topk_pair(Frame& F, const float* SC, int* TM, int m0, int n, int e, int cap, int yrow0, LAS int* sel, LAS int* red) {
    unsigned key[8];
#pragma unroll
    for (int k = 0; k < 8; ++k) { const int t = k * NTHR + F.tid; key[k] = (t < n) ? __builtin_bit_cast(unsigned, SC[(size_t)(m0 + t) * NE + e]) : 0u; }
    unsigned v = 0u; int it = 0;
    for (int shift = 28; shift >= -2; shift -= 3, ++it) { const int sh = shift < 0 ? 0 : shift; const unsigned jmax = shift < 0 ? 1u : 7u;
        int c[8];
#pragma unroll
        for (int j = 0; j < 8; ++j) c[j] = 0;
#pragma unroll
        for (int k = 0; k < 8; ++k) { const unsigned t = key[k] >= v ? min((key[k] - v) >> sh, jmax) : 0u;
#pragma unroll
            for (int j = 1; j < 8; ++j) c[j] += (t >= (unsigned)j) ? 1 : 0; }
        int pk[4];
#pragma unroll
        for (int q = 0; q < 4; ++q) pk[q] = wave_sum_i(c[2 * q] | (c[2 * q + 1] << 16));
        LAS int* rb = red + (it & 1) * 32;
        if (F.lane == 0) {
#pragma unroll
            for (int q = 0; q < 4; ++q) rb[F.wave * 4 + q] = pk[q]; }
        __syncthreads();
        int tot[4] = {0, 0, 0, 0};
#pragma unroll
        for (int w = 0; w < 8; ++w)
#pragma unroll
            for (int q = 0; q < 4; ++q) tot[q] += rb[w * 4 + q];
        unsigned best = 0u;
#pragma unroll
        for (int j = 1; j < 8; ++j) { const int cj = (j & 1) ? (tot[j >> 1] >> 16) : (tot[j >> 1] & 0xffff); if (cj >= cap && (unsigned)j <= jmax) best = (unsigned)j; }
        v |= best << sh; }
    LAS int* cgt = red + 64; LAS int* ceq = red + 64 + 64;
    __syncthreads();
    int lg[8], le[8];
#pragma unroll
    for (int k = 0; k < 8; ++k) { const unsigned long long mg = __builtin_amdgcn_ballot_w64(key[k] > v), me = __builtin_amdgcn_ballot_w64(key[k] == v);
        lg[k] = lower_lanes(mg); le[k] = lower_lanes(me);
        if (F.lane == 0) { cgt[k * 8 + F.wave] = __builtin_popcountll(mg); ceq[k * 8 + F.wave] = __builtin_popcountll(me); } }
    __syncthreads();
    int tot_gt = 0;
    for (int i = 0; i < 64; ++i) tot_gt += cgt[i];
    const int need_eq = cap - tot_gt;
    int gb = 0, eb = 0, idx = 0;
#pragma unroll
    for (int k = 0; k < 8; ++k) {
        for (; idx < k * 8 + F.wave; ++idx) { gb += cgt[idx]; eb += ceq[idx]; }
        const int t = k * NTHR + F.tid;
        if (t < n) { const bool gt = key[k] > v, eq = key[k] == v; const int myg = gb + lg[k], mye = eb + le[k];
            const bool selx = gt || (eq && mye < need_eq); const int slot = myg + (mye < need_eq ? mye : need_eq);
            if (selx) sel[slot] = m0 + t;
            TM[(size_t)(m0 + t) * NE + e] = selx ? (yrow0 + slot) : -1; } }
    __syncthreads();
}
__device__ __forceinline__ void pk_phase(Frame& F, bool with_ctx) {
    LAS int* sel = (LAS int*)F.lds; LAS int* red = sel + 512;
    const float* SC = (const float*)(F.ws + WS_SC); int* TM = (int*)(F.ws + WS_TM);
    int* IDXp = (int*)(F.ws + WS_IDX);
    for (int pr = F.vcu; pr < (with_ctx ? 512 : 256); pr += F.G) {
        const bool lat = pr < 256; const int q = lat ? pr : pr - 256, b = q >> 4, e = q & 15;
        const int cap = lat ? CAPL : CAPC, yrow0 = lat ? (e * 17 + b) * 512 : (e * 17 + 16) * 512 + b * CAPC;
        topk_pair(F, SC, TM, lat ? b * T : ML + b * TC, lat ? T : TC, e, cap, yrow0, sel, red);
        for (int s = F.tid; s < cap; s += NTHR) IDXp[yrow0 + s] = sel[s];
        __syncthreads(); }
}

__device__ __forceinline__ void pj_phase(Frame& F, const Args& args, int l, int nrows) {
    const int gw = F.vcu * NWAVES + F.wave, NGW = F.G * NWAVES; const bool last = (l == DEPTH - 1);
    float* X = (float*)(F.ws + WS_X); bf16_t* H = (bf16_t*)(F.ws + WS_H); const float* SC = (const float*)(F.ws + WS_SC); const int* TM = (const int*)(F.ws + WS_TM);
    const unsigned char* Y = F.ws + WS_ZR;
    const float* mod = (const float*)(F.ws + WS_MOD) + (size_t)l * 17 * 6144; const float* modn = mod + 17 * 6144;
    const float* g2p = args.in[I_LN2G] + l * D; const float* b2p = args.in[I_LN2B] + l * D;
    int tmn = -1; float scn = 0.f; f32x4 xnx[4];
    if (gw < nrows) { if (F.lane < 16) { tmn = TM[(size_t)gw * NE + F.lane]; scn = SC[(size_t)gw * NE + F.lane]; }
#pragma unroll
        for (int q = 0; q < 4; ++q) xnx[q] = *(const f32x4*)(X + (size_t)gw * D + 4 * F.lane + 256 * q); }
    f32x4 g2r[4], b2r[4];
#pragma unroll
    for (int q = 0; q < 4; ++q) { g2r[q] = *(const f32x4*)(g2p + 4 * F.lane + 256 * q); b2r[q] = *(const f32x4*)(b2p + 4 * F.lane + 256 * q); }
    for (int m = gw; m < nrows; m += NGW) { const int j = m < ML ? (m >> 12) : 16; const float* md = mod + (size_t)j * 6144; const float* mdn = modn + (size_t)j * 6144;
        const int tmv = tmn; const float scv = scn;
        f32x4 xr[4], g2m[4], shn[4], scq[4];
#pragma unroll
        for (int q = 0; q < 4; ++q) { xr[q] = xnx[q]; g2m[q] = *(const f32x4*)(md + 5 * D + 4 * F.lane + 256 * q); }
        if (!last) {
#pragma unroll
            for (int q = 0; q < 4; ++q) { shn[q] = *(const f32x4*)(mdn + 4 * F.lane + 256 * q); scq[q] = *(const f32x4*)(mdn + D + 4 * F.lane + 256 * q); } }
        unsigned long long mask = __builtin_amdgcn_ballot_w64(tmv >= 0);
        f32x4 a[4];
#pragma unroll
        for (int q = 0; q < 4; ++q) a[q] = (f32x4){0.f, 0.f, 0.f, 0.f};
        bool first = true;
        do {
            int yr[4]; float gg[4];
#pragma unroll
            for (int k = 0; k < 4; ++k) { if (mask) { const int e = __builtin_ctzll(mask); mask &= mask - 1; yr[k] = __builtin_amdgcn_readlane(tmv, e); gg[k] = __builtin_bit_cast(float, __builtin_amdgcn_readlane(__builtin_bit_cast(int, scv), e)); } else { yr[k] = 0; gg[k] = 0.f; } }
            unsigned w[4][4];
#pragma unroll
            for (int k = 0; k < 4; ++k)
#pragma unroll
                for (int q = 0; q < 4; ++q) w[k][q] = *(const unsigned*)(Y + (size_t)yr[k] * D + 4 * F.lane + 256 * q);
            asm volatile("" ::: "memory");
            if (first && m + NGW < nrows) { if (F.lane < 16) { tmn = TM[(size_t)(m + NGW) * NE + F.lane]; scn = SC[(size_t)(m + NGW) * NE + F.lane]; }
#pragma unroll
                for (int q = 0; q < 4; ++q) xnx[q] = *(const f32x4*)(X + (size_t)(m + NGW) * D + 4 * F.lane + 256 * q); }
            first = false;
            asm volatile("" ::: "memory");
#pragma unroll
            for (int k = 0; k < 4; ++k)
#pragma unroll
                for (int q = 0; q < 4; ++q) { const float gs = gg[k] * (1.0f / SY8); a[q][0] += gs * __builtin_amdgcn_cvt_f32_fp8((int)w[k][q], 0); a[q][1] += gs * __builtin_amdgcn_cvt_f32_fp8((int)w[k][q], 1); a[q][2] += gs * __builtin_amdgcn_cvt_f32_fp8((int)w[k][q], 2); a[q][3] += gs * __builtin_amdgcn_cvt_f32_fp8((int)w[k][q], 3); }
        } while (mask);
        f32x4 v[4]; float s = 0.f;
#pragma unroll
        for (int q = 0; q < 4; ++q) { v[q] = xr[q] * DN_ALPHA + g2m[q] * a[q]; s += (v[q][0] + v[q][1]) + (v[q][2] + v[q][3]); }
        const float mean = wave_sum(s) * (1.f / D); float s2 = 0.f;
#pragma unroll
        for (int q = 0; q < 4; ++q) { v[q] = v[q] - mean; s2 += (v[q][0] * v[q][0] + v[q][1] * v[q][1]) + (v[q][2] * v[q][2] + v[q][3] * v[q][3]); }
        const float rstd = __builtin_amdgcn_rsqf(wave_sum(s2) * (1.f / D) + LN_EPS);
        float* dst = last ? args.out + (size_t)m * D : X + (size_t)m * D; s = 0.f;
#pragma unroll
        for (int q = 0; q < 4; ++q) { const int col = 4 * F.lane + 256 * q; v[q] = v[q] * rstd * g2r[q] + b2r[q]; *(f32x4*)(dst + col) = v[q]; s += (v[q][0] + v[q][1]) + (v[q][2] + v[q][3]); }
        if (!last) { const float mean2 = wave_sum(s) * (1.f / D); s2 = 0.f;
#pragma unroll
            for (int q = 0; q < 4; ++q) { v[q] = v[q] - mean2; s2 += (v[q][0] * v[q][0] + v[q][1] * v[q][1]) + (v[q][2] * v[q][2] + v[q][3] * v[q][3]); }
            const float rstd2 = __builtin_amdgcn_rsqf(wave_sum(s2) * (1.f / D) + LN_EPS);
#pragma unroll
            for (int q = 0; q < 4; ++q) { const int col = 4 * F.lane + 256 * q; const f32x4 h = v[q] * rstd2 * (scq[q] + 1.0f) + shn[q]; u32x2 w; w.x = cvt_pk_bf16(h[0], h[1]); w.y = cvt_pk_bf16(h[2], h[3]); *(u32x2*)(H + (size_t)m * D + col) = w; } } }
}
constexpr int LRU_U = 0, LRU_SA = 33280, LRU_SI = LRU_SA + 32768, LRU_HS = LRU_SI + 32768;
static_assert(LRU_HS + 32768 + 5 * 256 * 4 <= PH_LDS, "lru lds");
constexpr int NCHUNK = 2048 + 128;
constexpr size_t WS_AX = WS_HM + 64 * MiB;
template <bool FINAL>
__device__ __forceinline__ void lru_phase(Frame& F, const Args& args, int l, int nunits) {
    const bf16_t* Z = (const bf16_t*)(F.ws + WS_ZR); bf16_t* CC = (bf16_t*)(F.ws + WS_CC);
    f32x2* SUMM = (f32x2*)(F.ws + WS_SUM); const float* CAR = (const float*)(F.ws + WS_CAR); unsigned* AX = (unsigned*)(F.ws + WS_AX);
    LAS float* U32 = (LAS float*)(F.lds + LRU_U); LAS float* SA = (LAS float*)(F.lds + LRU_SA); LAS float* SI = (LAS float*)(F.lds + LRU_SI); LAS float* HS = (LAS float*)(F.lds + LRU_HS);
    const int fr = F.lane & 15, fq = F.lane >> 4, dw = F.wave >> 2, blk = F.wave & 3;
    bf16x8 bw[2][4][2];
    { const bf16_t* LW = (const bf16_t*)(F.ws + WS_SMALL + SM_LRUW);
#pragma unroll
      for (int gate = 0; gate < 2; ++gate)
#pragma unroll
        for (int nt = 0; nt < 4; ++nt)
#pragma unroll
          for (int s = 0; s < 2; ++s) bw[gate][nt][s] = *(const bf16x8*)(LW + ((size_t)((((l * 2 + dw) * 2 + gate) * 4 + blk) * 64 + 16 * nt + fr)) * 64 + 32 * s + 8 * fq); }
    float gba[4], gbx[4], gsp[4];
#pragma unroll
    for (int nt = 0; nt < 4; ++nt) { const int ch = blk * 64 + 16 * nt + fr, o = (l * 2 + dw) * 256 + ch; gba[nt] = args.in[I_LBA][o]; gbx[nt] = args.in[I_LBX][o]; gsp[nt] = log1pf(expf(-args.in[I_LLAM][o])); }
    const float* cw = args.in[I_CONVW] + l * 4 * 256; const float* cb = args.in[I_CONVB] + l * 256;
    const int dt = F.tid >> 8, cht = F.tid & 255;
    const int ctt = F.tid >> 5, cch0 = (F.tid & 31) * 8;
    LAS float* CW = (LAS float*)(F.lds + LRU_HS + 32768);
    for (int i = F.tid; i < 5 * 256; i += NTHR) CW[i] = (i < 1024) ? cw[i] : cb[i - 1024];
    __syncthreads();
    u32x4 zr[2][4];
#define LRU_DECODE(u_, m0_, sl_, t0_) do { if ((u_) < 2048) { m0_ = ((u_) >> 7) * T; sl_ = T; t0_ = ((u_) & 127) * 32; } else { const int u2_ = (u_) - 2048; m0_ = ML + (u2_ >> 3) * TC; sl_ = TC; t0_ = (u2_ & 7) * 32; } } while (0)
#define LRU_ZLOAD(u_) do { int m0_, sl_, t0_; LRU_DECODE(u_, m0_, sl_, t0_); _Pragma("unroll") for (int hh = 0; hh < 2; ++hh) _Pragma("unroll") for (int j = 0; j < 4; ++j) { const int ts = t0_ + ctt + 16 * hh + j - 2; \
        zr[hh][j] = (ts >= 0 && ts < sl_) ? *(const u32x4*)(Z + (size_t)(m0_ + ts) * INW + 1536 + cch0) : (u32x4){0u, 0u, 0u, 0u}; } } while (0)
    if (F.vcu < nunits) LRU_ZLOAD(F.vcu);
    for (int uidx = F.vcu; uidx < nunits; uidx += F.G) {
        int m0, seqlen, t0; LRU_DECODE(uidx, m0, seqlen, t0);
        {
#pragma unroll
          for (int hh = 0; hh < 2; ++hh) { const int tk = ctt + 16 * hh; float u[8];
#pragma unroll
            for (int i = 0; i < 8; ++i) u[i] = CW[1024 + cch0 + i];
#pragma unroll
            for (int j = 0; j < 4; ++j) { const u32x4 z = zr[hh][j];
                    const f32x4 wa = *(const LAS f32x4*)(CW + j * 256 + cch0), wb = *(const LAS f32x4*)(CW + j * 256 + cch0 + 4);
                    u[0] += bflo(z.x) * wa[0]; u[1] += bfhi(z.x) * wa[1]; u[2] += bflo(z.y) * wa[2]; u[3] += bfhi(z.y) * wa[3];
                    u[4] += bflo(z.z) * wb[0]; u[5] += bfhi(z.z) * wb[1]; u[6] += bflo(z.w) * wb[2]; u[7] += bfhi(z.w) * wb[3]; }
            *(LAS f32x4*)(U32 + tk * 260 + cch0) = (f32x4){u[0], u[1], u[2], u[3]}; *(LAS f32x4*)(U32 + tk * 260 + cch0 + 4) = (f32x4){u[4], u[5], u[6], u[7]}; } }
        if (uidx + F.G < nunits) LRU_ZLOAD(uidx + F.G);
        __syncthreads();
        float h = FINAL ? CAR[(size_t)uidx * 512 + F.tid] : 0.f, P = 1.f;
#pragma unroll
        for (int j = 0; j < 2; ++j) {
            { const int sc = dw ? 1 - j : j;
              bf16x8 af[2];
#pragma unroll
              for (int s = 0; s < 2; ++s) { const LAS float* up = U32 + (16 * sc + fr) * 260 + blk * 64 + 32 * s + 8 * fq; const f32x4 x0 = *(const LAS f32x4*)up, x1 = *(const LAS f32x4*)(up + 4);
                  u32x4 w; w.x = cvt_pk_bf16(x0[0], x0[1]); w.y = cvt_pk_bf16(x0[2], x0[3]); w.z = cvt_pk_bf16(x1[0], x1[1]); w.w = cvt_pk_bf16(x1[2], x1[3]); af[s] = __builtin_bit_cast(bf16x8, w); }
#pragma unroll
              for (int nt = 0; nt < 4; ++nt) { f32x4 pa = (f32x4){0.f, 0.f, 0.f, 0.f}, px = pa;
#pragma unroll
                for (int s = 0; s < 2; ++s) { pa = __builtin_amdgcn_mfma_f32_16x16x32_bf16(af[s], bw[0][nt][s], pa, 0, 0, 0); px = __builtin_amdgcn_mfma_f32_16x16x32_bf16(af[s], bw[1][nt][s], px, 0, 0, 0); }
                const int ch = blk * 64 + 16 * nt + fr;
#pragma unroll
                for (int i = 0; i < 4; ++i) { const int tk = 4 * fq + i; const float e1 = 1.0f + __expf(-(pa[i] + gba[nt])), e2 = 1.0f + __expf(-(px[i] + gbx[nt])), t12 = __builtin_amdgcn_rcpf(e1 * e2), r = t12 * e2, ig = t12 * e1;
                    const float la = -8.0f * r * gsp[nt], a = __expf(la), mult = __builtin_amdgcn_sqrtf(fmaxf(1.0f - a * a, 0.f)), u = U32[(16 * sc + tk) * 260 + ch];
                    SA[tk * 512 + dw * 256 + ch] = a; SI[tk * 512 + dw * 256 + ch] = mult * ig * u; } } }
            __syncthreads();
            { const int sct = dt ? 1 - j : j;
#pragma unroll
              for (int k = 0; k < 16; ++k) { const int tk = dt ? 15 - k : k; const float a = SA[tk * 512 + F.tid], x = SI[tk * 512 + F.tid]; h = a * h + x; P *= a;
                  if (!FINAL) AX[(size_t)(m0 + t0 + 16 * sct + tk) * 512 + F.tid] = pk2(1.0f - a, x);
                  if (FINAL) { LAS float* hp = HS + (16 * sct + tk) * 256 + cht; *hp = (j == 0) ? h : *hp + h; } } }
            __syncthreads();
        }
        if (!FINAL) SUMM[(size_t)uidx * 512 + F.tid] = (f32x2){P, h};
        else { const int tok = F.tid >> 4, ch0 = (F.tid & 15) * 16; const size_t m = (size_t)(m0 + t0 + tok);
#pragma unroll
            for (int hh = 0; hh < 2; ++hh) { const u32x4 g = *(const u32x4*)(Z + m * INW + 1792 + ch0 + 8 * hh); const unsigned gw_[4] = {g.x, g.y, g.z, g.w}; float y[8];
#pragma unroll
                for (int i = 0; i < 8; ++i) { const float gv = (i & 1) ? bfhi(gw_[i >> 1]) : bflo(gw_[i >> 1]); const float ge = gv * fast_sigmoid(1.5957691216057308f * (gv + 0.044715f * gv * gv * gv));
                    y[i] = HS[tok * 256 + ch0 + 8 * hh + i] * ge; }
                u32x4 w; w.x = cvt_pk_bf16(y[0], y[1]); w.y = cvt_pk_bf16(y[2], y[3]); w.z = cvt_pk_bf16(y[4], y[5]); w.w = cvt_pk_bf16(y[6], y[7]);
                *(u32x4*)(CC + m * D + 512 + ch0 + 8 * hh) = w; }
            __syncthreads(); }
    }
}
#undef LRU_DECODE
#undef LRU_ZLOAD

__device__ __forceinline__ void lru_final(Frame& F, int nunits) {
    const bf16_t* Z = (const bf16_t*)(F.ws + WS_ZR); bf16_t* CC = (bf16_t*)(F.ws + WS_CC);
    const float* CAR = (const float*)(F.ws + WS_CAR); const unsigned* AX = (const unsigned*)(F.ws + WS_AX);
    LAS float* HF = (LAS float*)F.lds; LAS float* HB = HF + 32 * 256;
    const int dt = F.tid >> 8, cht = F.tid & 255;
    unsigned ax[32]; float hin = 0.f;
#define LF_DECODE(u_, m0_, t0_) do { if ((u_) < 2048) { m0_ = ((u_) >> 7) * T; t0_ = ((u_) & 127) * 32; } else { const int u2_ = (u_) - 2048; m0_ = ML + (u2_ >> 3) * TC; t0_ = (u2_ & 7) * 32; } } while (0)
#define LF_LOAD(u_) do { int m0_, t0_; LF_DECODE(u_, m0_, t0_); _Pragma("unroll") for (int k = 0; k < 32; ++k) ax[k] = AX[(size_t)(m0_ + t0_ + (dt ? 31 - k : k)) * 512 + F.tid]; hin = CAR[(size_t)(u_) * 512 + F.tid]; } while (0)
    if (F.vcu < nunits) LF_LOAD(F.vcu);
    for (int uidx = F.vcu; uidx < nunits; uidx += F.G) {
        int m0, t0; LF_DECODE(uidx, m0, t0);
        const int tok = F.tid >> 4, ch0 = (F.tid & 15) * 16; const size_t m = (size_t)(m0 + t0 + tok);
        const u32x4 g0 = *(const u32x4*)(Z + m * INW + 1792 + ch0), g1 = *(const u32x4*)(Z + m * INW + 1792 + ch0 + 8);
        float h = hin; LAS float* hp = (dt ? HB : HF) + cht;
#pragma unroll
        for (int k = 0; k < 32; ++k) { const int tk = dt ? 31 - k : k; const unsigned w = ax[k]; h = (1.0f - bflo(w)) * h + bfhi(w); hp[tk * 256] = h; }
        if (uidx + F.G < nunits) LF_LOAD(uidx + F.G);
        __syncthreads();
        { const unsigned gw_[8] = {g0.x, g0.y, g0.z, g0.w, g1.x, g1.y, g1.z, g1.w};
#pragma unroll
          for (int hh = 0; hh < 2; ++hh) { float y[8];
#pragma unroll
            for (int i = 0; i < 8; ++i) { const unsigned wv = gw_[4 * hh + (i >> 1)]; const float gv = (i & 1) ? bfhi(wv) : bflo(wv); const float ge = gv * fast_sigmoid(1.5957691216057308f * (gv + 0.044715f * gv * gv * gv));
                y[i] = (HF[tok * 256 + ch0 + 8 * hh + i] + HB[tok * 256 + ch0 + 8 * hh + i]) * ge; }
            u32x4 w; w.x = cvt_pk_bf16(y[0], y[1]); w.y = cvt_pk_bf16(y[2], y[3]); w.z = cvt_pk_bf16(y[4], y[5]); w.w = cvt_pk_bf16(y[6], y[7]);
            *(u32x4*)(CC + m * D + 512 + ch0 + 8 * hh) = w; } }
        __syncthreads();
    }
#undef LF_DECODE
#undef LF_LOAD
}
__device__ __forceinline__ void lru_carry(Frame& F) {
    const int gid = (F.vcu - (F.G - NB)) * NTHR + F.tid; if (gid < 0 || gid >= NB * 512) return;
    const f32x2* SUMM = (const f32x2*)(F.ws + WS_SUM); float* CAR = (float*)(F.ws + WS_CAR);
    const int b = gid >> 9, dch = gid & 511, d = dch >> 8; float h = 0.f;
#pragma unroll 1
    for (int s0 = 0; s0 < 136; s0 += 34) { f32x2 sm[34];
#pragma unroll
        for (int k = 0; k < 34; ++k) { const int s = s0 + k; const int ux = (s < 8) ? 2048 + b * 8 + (d ? 7 - s : s) : b * 128 + (d ? 127 - (s - 8) : (s - 8)); sm[k] = SUMM[(size_t)ux * 512 + dch]; }
#pragma unroll
        for (int k = 0; k < 34; ++k) { const int s = s0 + k; const int ux = (s < 8) ? 2048 + b * 8 + (d ? 7 - s : s) : b * 128 + (d ? 127 - (s - 8) : (s - 8)); CAR[(size_t)ux * 512 + dch] = h; h = sm[k].x * h + sm[k].y; } }
}

constexpr int CW_F2 = 232000;
constexpr int CW_BAR = 1024, NPH_L = 10, NPHASE = 2 + DEPTH * NPH_L;
__global__ void __launch_bounds__(NTHR, 2) fwd_kernel(Args args) {
    extern __shared__ __attribute__((aligned(16))) unsigned char lds_raw[];
    Frame F;
    F.lds = (LAS unsigned char*)lds_raw;
    int wave_s = __builtin_amdgcn_readfirstlane((int)threadIdx.x >> 6);
    F.tid = threadIdx.x; F.lane = F.tid & 63; F.wave = wave_s;
    F.G = gridDim.x; { const int bx = blockIdx.x; F.vcu = (F.G % 8 == 0) ? (bx % 8) * (F.G / 8) + bx / 8 : bx; }
    F.ws = args.ws;
    volatile LAS unsigned* MISC = (volatile LAS unsigned*)(F.lds + MISC_OFF);
    if (F.tid < 128) MISC[F.tid] = 0u;
    { LAS f32x2* rope = (LAS f32x2*)(F.lds + ROPE_OFF);
      for (int i = F.tid; i < 1024; i += NTHR) { const int pos = i >> 4, j = i & 15; const float inv = exp2f(-(float)j * (13.287712379549449f / 16.0f)); float s, c; sincosf((float)pos * inv, &s, &c); rope[i] = (f32x2){c, s}; } }
    __syncthreads();
    XcdBarrier bar = xcd_barrier_post((unsigned*)(F.ws + WS_CTL) + CW_BAR + args.li * XCD_BAR_WORDS, MISC + 8);
    const int lo = args.ph_lo, hi = args.ph_hi;
#ifndef PHMASK
#define PHMASK 0xFFFFFFFFu
#endif
#define IN(k) (lo <= (k) && (k) < hi)
#define ON(b) ((PHMASK >> (b)) & 1u)
#define SEAM(k) do { if (IN(k) && IN((k) + 1)) { XcdBarrier b2_ = bar; unsigned x_ = b2_.x; asm volatile("" : "+s"(x_)); b2_.x = x_; unsigned* p_ = b2_.bar; asm volatile("" : "+s"(p_)); b2_.bar = p_; xcd_barrier(b2_); } RELAUNDER(); } while (0)
#define RELAUNDER() do { asm volatile("" : "+s"(wave_s)); int l_ = lane_id(); asm volatile("" : "+v"(l_)); F.lane = l_; F.wave = wave_s; F.tid = wave_s * 64 + l_; int v_ = F.vcu; asm volatile("" : "+s"(v_)); F.vcu = v_; size_t z_ = 0; asm volatile("" : "+s"(z_)); F.ws = args.ws + z_;     } while (0)
    LAS unsigned char* lds = F.lds;
    if (IN(0)) p0a(F, args);
    SEAM(0);
    if (IN(1)) p0b(F, args);
    SEAM(1);
    for (int l = 0; l < DEPTH; ++l) {
        RELAUNDER();
        const int pb = 2 + l * NPH_L; const bool last = (l == DEPTH - 1); const int nrows = last ? ML : M;
        const char* wsb = (const char*)F.ws;
        if (IN(pb + 0)) {
            pg8::GemmP g{D, D, D, (size_t)128 * D * 2, (size_t)128 * D * 2};
            pg8::SchedPlain S{9, (M / 256) * 9, F.G, F.vcu, wsb + WS_H, wsb + WS_WIN + (size_t)l * INW * D * 2, (size_t)256 * D * 2, (size_t)256 * D * 2, true};
            pg8::EpiInProj E{(bf16_t*)(F.ws + WS_ZR), (const LAS f32x2*)(F.lds + ROPE_OFF)};
            pg8::gemm_phase<pg8::EpiInProj, pg8::SchedPlain, true>(lds, g, S, E, F.tid);
        }
        SEAM(pb + 0);
        if (IN(pb + 1)) pw_experts(F, args, l);
        if (IN(pb + 1)) lru_phase<false>(F, args, l, NCHUNK);
        if (IN(pb + 1)) {
            pg8::GemmP g{256, 256, INW, (size_t)128 * 256 * 2, (size_t)128 * INW * 2};
            pg8::SchedF1 S{2 * (nrows / 256), F.G, F.vcu, wsb + WS_SMALL + SM_DC, wsb + WS_ZR + 2048 * 2};
            pg8::EpiF1 E{(bf16_t*)(F.ws + WS_GT), (bf16_t*)(F.ws + WS_GTC)};
            pg8::gemm_phase<pg8::EpiF1, pg8::SchedF1, true>(lds, g, S, E, F.tid);
        }
        if (IN(pb + 1) && !last) {
            const float lam = ((const float*)(F.ws + WS_SMALL + SM_LAM))[l], gsc = 1.0f - (0.8f - 0.6f * expf(-0.3f * (float)l));
            int bx_ = blockIdx.x; asm volatile("" : "+s"(bx_)); float* o1s = (float*)(F.ws + WS_O1) + (size_t)bx_ * 32768;
            for (int u2 = F.G - 1 - F.vcu; u2 < 64; u2 += F.G) { const int b = u2 >> 2, h = u2 & 3, qrow0 = ML + b * TC;
                att::diff_attn_unit((const bf16_t*)(F.ws + WS_ZR), (bf16_t*)(F.ws + WS_CC), o1s, args.in[I_ANG] + l * 512, lam, gsc, qrow0, h, qrow0, 4, qrow0, 4, (LAS char*)lds, F.tid); }
            __syncthreads();
        }
        SEAM(pb + 1);
        if (IN(pb + 2)) lru_carry(F);
        if (IN(pb + 2)) {
            const float lam = ((const float*)(F.ws + WS_SMALL + SM_LAM))[l], gsc = 1.0f - (0.8f - 0.6f * expf(-0.3f * (float)l));
            int bx_ = blockIdx.x; asm volatile("" : "+s"(bx_)); float* o1s = (float*)(F.ws + WS_O1) + (size_t)bx_ * 32768;
            for (int u = F.vcu; u < 1024; u += F.G) {
                const int b = u >> 6, h = (u >> 4) & 3, qrow0 = b * T + (u & 15) * 256, seg0 = b * T, n0 = 64, seg1 = ML + b * TC, NT = 68;
                att::diff_attn_unit((const bf16_t*)(F.ws + WS_ZR), (bf16_t*)(F.ws + WS_CC), o1s, args.in[I_ANG] + l * 512, lam, gsc, qrow0, h, seg0, n0, seg1, NT, (LAS char*)lds, F.tid);
            }
            __syncthreads();
        }
        SEAM(pb + 2);
        if (IN(pb + 3)) lru_final(F, last ? 2048 : NCHUNK);
        if (IN(pb + 3)) {
            { pg8::GemmP g{4096, 8192, 8192, (size_t)128 * 8192 * 2, (size_t)128 * 8192 * 2};
              pg8::SchedF2H S{F.G, F.vcu, wsb + WS_AT, wsb + WS_GT};
              pg8::EpiF2H E{(float*)(F.ws + WS_HM), (bf16_t*)(F.ws + WS_CC), (unsigned*)(F.ws + WS_CTL) + CW_F2, (unsigned)(l + 1)};
              pg8::gemm_phase<pg8::EpiF2H, pg8::SchedF2H, true>(lds, g, S, E, F.tid); }
            {
              const bf16_t* GT = (const bf16_t*)(F.ws + WS_GT); bf16_t* CC = (bf16_t*)(F.ws + WS_CC);
              for (int pr = F.vcu * NWAVES + F.wave; pr < NB * 256; pr += F.G * NWAVES) { const int b = pr >> 8, cp = pr & 255; const bf16_t* g = GT + ((size_t)(b * 256 + cp) * 2) * 4096 + F.lane * 64; float s = 0.f;
#pragma unroll
                  for (int q = 0; q < 8; ++q) { const u32x4 w = *(const u32x4*)(g + 8 * q); s += (bflo(w.x) - bfhi(w.x)) + (bflo(w.y) - bfhi(w.y)) + (bflo(w.z) - bfhi(w.z)) + (bflo(w.w) - bfhi(w.w)); }
                  s = wave_sum(s) * (1.0f / 64.0f); if (F.lane == 0) CC[(size_t)(b * T + T / 2) * D + 768 + cp] = (bf16_t)f2bf(s); } }
            if (!last) { pg8::GemmP g{512, 512, 512, (size_t)128 * 512 * 2, (size_t)128 * 512 * 2};
              pg8::SchedF2C S{F.G, F.vcu, wsb + WS_SMALL + SM_AC, wsb + WS_GTC};
              pg8::EpiBf16 E{(bf16_t*)(F.ws + WS_CC), D, 1.0f};
              pg8::gemm_phase<pg8::EpiBf16, pg8::SchedF2C, true>(lds, g, S, E, F.tid); }
        }
        SEAM(pb + 3);
        if (IN(pb + 4)) {
            pg8::GemmP g{D, D, D, (size_t)128 * D * 2, (size_t)128 * D * 2};
            pg8::SchedPlain S{4, (nrows / 256) * 4, F.G, F.vcu, wsb + WS_CC, wsb + WS_WOUT + (size_t)l * D * D * 2, (size_t)256 * D * 2, (size_t)256 * D * 2, false};
            pg8::EpiBf16 E{(bf16_t*)(F.ws + WS_ZR), D, 1.0f};
            pg8::gemm_phase<pg8::EpiBf16, pg8::SchedPlain, true>(lds, g, S, E, F.tid);
        }
        SEAM(pb + 4);
        if (IN(pb + 5)) pe_phase(F, args, l, nrows);
        SEAM(pb + 5);
        if (IN(pb + 6)) pk_phase(F, !last);
        SEAM(pb + 6);
        if (IN(pb + 7)) {
            pg8::GemmP g{D / 2, D / 2, D / 2, (size_t)128 * D, (size_t)FE * D};
            pg8::SchedGU S{last ? 32 : 34, F.G, F.vcu, wsb + WS_H, wsb + WS_WEXP, (const int*)(wsb + WS_IDX)};
            pg8::EpiGateUp E{F.ws + WS_HM};
            pg8::gemm_phase<pg8::EpiGateUp, pg8::SchedGU, true, true, true>(lds, g, S, E, F.tid);
        }
        SEAM(pb + 7);
        if (IN(pb + 8)) {
            pg8::GemmP g{FE / 2, FE / 2, FE / 2, (size_t)128 * FE, (size_t)128 * FE};
            pg8::SchedDN S{last ? 32 : 34, F.G, F.vcu, wsb + WS_HM, wsb + WS_WDN};
            pg8::EpiFp8 E{F.ws + WS_ZR, D, SY8 / (SH8 * SWD8)};
            pg8::gemm_phase<pg8::EpiFp8, pg8::SchedDN, true, true>(lds, g, S, E, F.tid);
        }
        SEAM(pb + 8);
        if (IN(pb + 9)) pj_phase(F, args, l, nrows);
        SEAM(pb + 9);
    }
#undef IN
#undef SEAM
}

#ifndef MK_PER_PHASE
#define MK_PER_PHASE 0
#endif
extern "C" void kernel_launch(void* const* d_in, const int* in_sizes, int n_in, void* d_out, int out_size, void* d_ws, size_t ws_size, hipStream_t stream) {
    static int grid = 0;
    if (grid == 0) {
        if (n_in != 28 || in_sizes[0] != ML * D || out_size != ML * D || ws_size < WS_END) { fprintf(stderr, "kernel_launch: unexpected shapes / workspace (n_in %d, ws %zu < %zu)\n", n_in, ws_size, (size_t)WS_END); grid = -1; return; }
        int dev = 0, cus = 0, per_cu = 0;
        if (hipGetDevice(&dev) != hipSuccess || hipDeviceGetAttribute(&cus, hipDeviceAttributeMultiprocessorCount, dev) != hipSuccess) { grid = -1; return; }
        if (hipFuncSetAttribute((const void*)fwd_kernel, hipFuncAttributeMaxDynamicSharedMemorySize, LDS_BYTES) != hipSuccess) { fprintf(stderr, "kernel_launch: hipFuncSetAttribute failed\n"); grid = -1; return; }
        if (hipOccupancyMaxActiveBlocksPerMultiprocessor(&per_cu, (const void*)fwd_kernel, NTHR, LDS_BYTES) != hipSuccess || per_cu < 1) { fprintf(stderr, "kernel_launch: occupancy query says %d\n", per_cu); }
        (void)hipGetLastError();
        grid = cus < 256 ? cus : 256;
    }
    if (grid < 0) return;
    if (hipMemsetAsync((char*)d_ws + WS_CTL, 0, CTL_ZERO_BYTES, stream) != hipSuccess) return;
    Args a{};
    for (int i = 0; i < 28; ++i) a.in[i] = (const float*)d_in[i];
    a.out = (float*)d_out; a.ws = (unsigned char*)d_ws;
#if MK_PER_PHASE
#ifdef DIAG
    hipMemsetAsync((char*)d_ws + WS_DIAG, 0, 256, stream);
#ifndef DIAG_L
#define DIAG_L 0
#endif
#ifndef DIAG_VAL
#define DIAG_VAL -1
#endif
#endif
    for (int p = 0; p < NPHASE; ++p) { a.ph_lo = p; a.ph_hi = p + 1; a.li = p; hipLaunchKernelGGL(fwd_kernel, dim3(grid), dim3(NTHR), LDS_BYTES, stream, a);
#ifdef DIAG
        const int l = (p - 2) / NPH_L, k = (p - 2) % NPH_L; int ids[2] = {-1, -1};
        if (p == 1) ids[0] = 0;
        if (p >= 2 && l == DIAG_L) { if (k == 0) ids[0] = 1; if (k == 2) ids[0] = 2; if (k == 3) { ids[0] = 3; ids[1] = 4; } if (k == 4) ids[0] = 5; if (k == 5) ids[0] = 6; if (k == 6) ids[0] = 7; if (k == 7) ids[0] = 8; if (k == 8) ids[0] = 9; }
        if (p >= 2 && l == 3 && k == 9) ids[0] = 10;
        for (int q = 0; q < 2; ++q) if (ids[q] >= 0) hipLaunchKernelGGL(chk_kernel, dim3(48), dim3(256), 0, stream, a, ids[q], ids[q] == 0 ? 0 : (ids[q] == 10 ? 3 : DIAG_L));
#endif
    }
#ifdef DIAG
    hipLaunchKernelGGL(fin_kernel, dim3(1), dim3(1), 0, stream, a, 16, DIAG_VAL);
#endif
#else
    a.ph_lo = 0; a.ph_hi = NPHASE; a.li = 0; hipLaunchKernelGGL(fwd_kernel, dim3(grid), dim3(NTHR), LDS_BYTES, stream, a);
#endif
}
```

```cpp
#include <hip/hip_runtime.h>
#include <cstdio>
#include <cstdint>

#define GAS __attribute__((address_space(1)))
#define LAS __attribute__((address_space(3)))
typedef unsigned short bf16_t;
typedef short bf16x8 __attribute__((ext_vector_type(8)));
typedef short s16x4 __attribute__((ext_vector_type(4)));
typedef float f32x4 __attribute__((ext_vector_type(4)));
typedef float f32x2 __attribute__((ext_vector_type(2)));
typedef float f32x16 __attribute__((ext_vector_type(16)));
typedef unsigned u32x4 __attribute__((ext_vector_type(4)));
typedef unsigned u32x2 __attribute__((ext_vector_type(2)));
typedef GAS unsigned gu32;
#define RLX_AGENT __ATOMIC_RELAXED, __HIP_MEMORY_SCOPE_AGENT
#define LDS_WAIT() asm volatile("s_waitcnt lgkmcnt(0)" ::: "memory")
#define VM_WAIT() asm volatile("s_waitcnt vmcnt(0)" ::: "memory")

constexpr int D = 1024, NB = 16, T = 4096, TC = 256, DEPTH = 4;
constexpr int ML = NB * T, MC = NB * TC, M = ML + MC;
constexpr int INW = 2304, NE = 16, FE = 2048;
constexpr int CAPL = 512, CAPC = 32;
constexpr int NPAIR = NE * 17;
constexpr float LN_EPS = 1e-5f, RMS_EPS = 1e-6f;
constexpr float DN_ALPHA = 1.6817928305074290f;
constexpr int NWAVES = 8, NTHR = 512;

constexpr size_t MiB = 1u << 20;
constexpr size_t WS_CTL = 0, CTL_ZERO_BYTES = 1 * MiB;
constexpr size_t WS_MOD = 1 * MiB;
constexpr size_t WS_SMALL = 3 * MiB;
constexpr size_t SM_LAM = 0, SM_LRUW = 4096, SM_DC = SM_LRUW + 4 * 2 * 2 * 4 * 4096 * 2, SM_AC = SM_DC + 512 * 256 * 2, SM_END = SM_AC + 256 * 512 * 2;
static_assert(SM_END <= 3 * MiB, "small region");
constexpr size_t WS_WIN = 6 * MiB;
constexpr size_t WS_WOUT = 24 * MiB;
constexpr size_t WS_AT = 32 * MiB;
constexpr size_t WS_WEXP = 96 * MiB;
constexpr size_t WS_WDN = WS_WEXP + 128 * MiB;
constexpr size_t WS_X = 288 * MiB;
constexpr size_t WS_H = 560 * MiB;
constexpr size_t WS_CC = 696 * MiB;
constexpr size_t WS_ZR = 832 * MiB;
constexpr size_t WS_O1 = 1138 * MiB;
constexpr size_t WS_GT = 1170 * MiB;
constexpr size_t WS_GTC = 1234 * MiB;
constexpr size_t WS_SC = 1238 * MiB;
constexpr size_t WS_TM = 1243 * MiB;
constexpr size_t WS_IDX = 1248 * MiB;
constexpr size_t WS_SUM = 1249 * MiB;
constexpr size_t WS_CAR = 1258 * MiB;
constexpr size_t WS_HM = 1270 * MiB;
constexpr size_t WS_END = 1814 * MiB;
static_assert(WS_HM + (size_t)NPAIR * 512 * FE * 2 <= WS_END, "ws map");
static_assert(WS_ZR + (size_t)M * INW * 2 <= WS_O1 && WS_ZR + (size_t)NPAIR * 512 * D * 2 <= WS_O1, "ws map zr");

constexpr int PH_LDS = 147456;
constexpr int ROPE_OFF = PH_LDS;
constexpr int MISC_OFF = ROPE_OFF + 8192;
constexpr int LDS_BYTES = MISC_OFF + 512;

__device__ __forceinline__ unsigned f2bf(float f) { unsigned u = __builtin_bit_cast(unsigned, f); return (u + 0x7fffu + ((u >> 16) & 1u)) >> 16; }
__device__ __forceinline__ unsigned pk2(float lo, float hi) { return f2bf(lo) | (f2bf(hi) << 16); }
__device__ __forceinline__ float bf2f(unsigned short h) { return __builtin_bit_cast(float, (unsigned)h << 16); }
__device__ __forceinline__ float bflo(unsigned w) { return __builtin_bit_cast(float, w << 16); }
__device__ __forceinline__ float bfhi(unsigned w) { return __builtin_bit_cast(float, w & 0xffff0000u); }
__device__ __forceinline__ unsigned cvt_pk_bf16(float lo, float hi) { unsigned r; asm volatile("v_cvt_pk_bf16_f32 %0, %1, %2" : "=v"(r) : "v"(lo), "v"(hi)); return r; }
typedef int v8i __attribute__((ext_vector_type(8)));
__device__ __forceinline__ float clamp448(float x) { return __builtin_amdgcn_fmed3f(x, -448.f, 448.f); }
__device__ __forceinline__ unsigned cvt4_fp8(float a, float b, float c, float d) { int w = 0; w = __builtin_amdgcn_cvt_pk_fp8_f32(a, b, w, false); w = __builtin_amdgcn_cvt_pk_fp8_f32(c, d, w, true); return (unsigned)w; }
__device__ __forceinline__ float fp8_dec(unsigned char b) { return __builtin_amdgcn_cvt_f32_fp8((int)b, 0); }
constexpr float SX8 = 16.f, SWG8 = 128.f, SH8 = 8.f, SWD8 = 512.f, SY8 = 64.f;
__device__ __forceinline__ float fast_sigmoid(float x) { return __builtin_amdgcn_rcpf(1.0f + __expf(-x)); }
__device__ __forceinline__ int lane_id() { int r; asm volatile("v_mbcnt_lo_u32_b32 %0, -1, 0\n\tv_mbcnt_hi_u32_b32 %0, -1, %0" : "=v"(r)); return r; }
template <int CTRL> __device__ __forceinline__ float dppf(float v) { return __builtin_bit_cast(float, __builtin_amdgcn_update_dpp(0, __builtin_bit_cast(int, v), CTRL, 0xF, 0xF, true)); }
template <int CTRL> __device__ __forceinline__ int dppi(int v) { return __builtin_amdgcn_update_dpp(0, v, CTRL, 0xF, 0xF, true); }
__device__ __forceinline__ float swz16f(float v) { return __builtin_bit_cast(float, __builtin_amdgcn_ds_swizzle(__builtin_bit_cast(int, v), 0x401F)); }
__device__ __forceinline__ float row32_sum(float v) {
    v += dppf<0xB1>(v); v += dppf<0x4E>(v); v += dppf<0x141>(v); v += dppf<0x140>(v); v += swz16f(v); return v; }
__device__ __forceinline__ void swap32(unsigned x, unsigned& r0, unsigned& r1) { unsigned y = x; asm volatile("" : "+v"(y)); auto r = __builtin_amdgcn_permlane32_swap(x, y, false, false); r0 = r[0]; r1 = r[1]; }
__device__ __forceinline__ float wave_sum(float v) {
    v = row32_sum(v); unsigned r0, r1; swap32(__builtin_bit_cast(unsigned, v), r0, r1);
    return __builtin_bit_cast(float, r0) + __builtin_bit_cast(float, r1);
}
__device__ __forceinline__ int wave_sum_i(int v) {
    v += dppi<0xB1>(v); v += dppi<0x4E>(v); v += dppi<0x141>(v); v += dppi<0x140>(v); v += __builtin_amdgcn_ds_swizzle(v, 0x401F);
    unsigned r0, r1; swap32((unsigned)v, r0, r1); return (int)r0 + (int)r1;
}
__device__ __forceinline__ float xor32f(float v, bool lo_half) { unsigned r0, r1; swap32(__builtin_bit_cast(unsigned, v), r0, r1); return __builtin_bit_cast(float, lo_half ? r1 : r0); }

#define XB_TMO      128
#define XB_XCNT(j)  (256  + 64 * (j))
#define XB_XSUB(j)  (1280 + 64 * (j))
#define XB_XGEN(j)  (2304 + 64 * (j))
#define XB_TOP      3328
#define XB_TOPGEN   3392
#define XCD_BAR_WORDS 3456
#define XB_SPIN_CAP (1u << 18)
__device__ __forceinline__ unsigned xb_ld(unsigned* p)              { return __hip_atomic_load(p, __ATOMIC_RELAXED, __HIP_MEMORY_SCOPE_AGENT); }
__device__ __forceinline__ unsigned xb_add(unsigned* p, unsigned v) { return __hip_atomic_fetch_add(p, v, __ATOMIC_RELAXED, __HIP_MEMORY_SCOPE_AGENT); }
__device__ __forceinline__ unsigned xb_xcc_id() { return (unsigned)__builtin_amdgcn_s_getreg((3 << 11) | 20) & 0xFu; }
#define XB_SPIN(cond, bar) do { unsigned _sp = 0; while (cond) { __builtin_amdgcn_s_sleep(1); \
    if ((++_sp & 255u) == 0u) { if (xb_ld(&(bar)[XB_TMO])) break; if (_sp > XB_SPIN_CAP) { atomicAdd(&(bar)[XB_TMO], 1u); break; } } } } while (0)
struct XcdBarrier { unsigned* bar; unsigned x; volatile LAS unsigned* st; };
__device__ __forceinline__ XcdBarrier xcd_barrier_post(unsigned* bar, volatile LAS unsigned* st) {
    XcdBarrier b; b.bar = bar; b.x = xb_xcc_id(); b.st = st;
    if (threadIdx.x == 0) (void)xb_add(&bar[XB_XCNT(b.x)], 1u);
    return b;
}
__device__ __forceinline__ void xcd_barrier_complete(unsigned* bar, unsigned x, unsigned& nloc, unsigned& nx) {
    const unsigned G = gridDim.x * gridDim.y * gridDim.z;
    unsigned sum, cnt, mine, sp = 0u;
    for (;;) {
        sum = 0u; cnt = 0u; mine = 0u;
#pragma unroll
        for (unsigned j = 0; j < 16; ++j) { const unsigned c = xb_ld(&bar[XB_XCNT(j)]); sum += c; cnt += (c > 0u) ? 1u : 0u; mine = (j == x) ? c : mine; }
        if (sum == G) break;
        __builtin_amdgcn_s_sleep(1);
        if ((++sp & 255u) == 0u) { if (xb_ld(&bar[XB_TMO])) break; if (sp > XB_SPIN_CAP) { atomicAdd(&bar[XB_TMO], 1u); break; } }
    }
    nloc = mine > 0u ? mine : 1u; nx = cnt > 0u ? cnt : 1u;
}
__device__ __forceinline__ void xcd_barrier(const XcdBarrier& b) {
    asm volatile("s_waitcnt vmcnt(0)" ::: "memory");
    __syncthreads();
    if (threadIdx.x == 0) {
        unsigned* bar = b.bar;
        __builtin_amdgcn_s_waitcnt(0);
        unsigned nloc = b.st[0], nx = b.st[1];
        if (nloc == 0u) { xcd_barrier_complete(bar, b.x, nloc, nx); b.st[0] = nloc; b.st[1] = nx; }
        const unsigned old = xb_add(&bar[XB_XSUB(b.x)], 1u);
        const unsigned gen = old / nloc;
        if (old + 1u == (gen + 1u) * nloc) {
            __builtin_amdgcn_fence(__ATOMIC_RELEASE, "agent");
            asm volatile("s_waitcnt vmcnt(0)" ::: "memory");
            const unsigned og = xb_add(&bar[XB_TOP], 1u);
            const unsigned tg = og / nx;
            if (og + 1u == (tg + 1u) * nx) xb_add(&bar[XB_TOPGEN], 1u);
            else XB_SPIN(xb_ld(&bar[XB_TOPGEN]) == tg, bar);
            __builtin_amdgcn_fence(__ATOMIC_ACQUIRE, "agent");
            xb_add(&bar[XB_XGEN(b.x)], 1u);
            asm volatile("s_waitcnt vmcnt(0)" ::: "memory");
        } else {
            XB_SPIN(xb_ld(&bar[XB_XGEN(b.x)]) == gen, bar);
            __builtin_amdgcn_fence(__ATOMIC_ACQUIRE, "agent");
            asm volatile("s_waitcnt vmcnt(0)" ::: "memory");
        }
    }
    __syncthreads();
}
namespace pg8 {
constexpr int BM = 256, BK = 64, HALF = 128, HTB = HALF * BK * 2, STAGE_BYTES = 8 * HTB;
__host__ __device__ __forceinline__ int lds_byte(int r, int c) { const int st = (r >> 4) * 2 + (c >> 5), rr = r & 15, cc = c & 31, ob = rr * 64 + cc * 2; return st * 1024 + (ob ^ (((ob >> 9) & 1) << 5)); }
__host__ __device__ __forceinline__ void stage_rc(int b, int& R, int& C) { const int st = b / 1024, sb = b % 1024, swz = sb ^ (((sb >> 9) & 1) << 5); R = (st >> 1) * 16 + swz / 64; C = (st & 1) * 32 + (swz % 64) / 2; }
__host__ __device__ __forceinline__ int perm32(int rho) { const int n = rho >> 4, i = rho & 15; return 8 * (i >> 2) + 4 * n + (i & 3); }

struct Unit { const char* a; const char* b; int orow, ocol; const int* idx; };
struct GemmP { int K; unsigned lda, ldb; size_t hstepA, hstepB; };

template <class Epi, class Sched, bool ALIGN_EPI, bool FP8 = false, bool GATHER = false>
__device__ __forceinline__ void gemm_phase(LAS unsigned char* lds, const GemmP g, const Sched& S, const Epi& E, int tid) {
    const int wid = __builtin_amdgcn_readfirstlane(tid >> 6), lane = tid & 63, wr = wid >> 2, wc = wid & 3, fr = lane & 15, fq = lane >> 4;
    const int K = g.K, nt = K / BK;
    unsigned voffA[2], voffB[2];
#pragma unroll
    for (int i = 0; i < 2; ++i) { int R, C; stage_rc(tid * 16 + i * 8192, R, C); const int Rb = Epi::PERM ? ((R & ~31) + perm32(R & 31)) : R;
        voffA[i] = (unsigned)(R * g.lda + C) * 2u; voffB[i] = (unsigned)(Rb * g.ldb + C) * 2u; }
    const size_t kstep = (size_t)(BK * 2);
    const size_t hA = GATHER ? (size_t)0 : g.hstepA, hB = g.hstepB;
    unsigned a0c[2], a1c[2], a0n[2], a1n[2]; int gR[2], gC[2];
#pragma unroll
    for (int i = 0; i < 2; ++i) { stage_rc(tid * 16 + i * 8192, gR[i], gC[i]); a0c[i] = a1c[i] = a0n[i] = a1n[i] = voffA[i]; }
#define PG8_IDX(u_, v0_, v1_) do { if constexpr (GATHER) { _Pragma("unroll") for (int _i = 0; _i < 2; ++_i) { v0_[_i] = (unsigned)(u_).idx[gR[_i]] * (g.lda * 2u) + (unsigned)gC[_i] * 2u; v1_[_i] = (unsigned)(u_).idx[128 + gR[_i]] * (g.lda * 2u) + (unsigned)gC[_i] * 2u; } } } while (0)
    const unsigned ldsw = (unsigned)wid * 1024u;
    const int aoff = FP8 ? lds_byte(wr * 64 + fr, (fq & 1) * 16) + (fq >> 1) * 1024 : lds_byte(wr * 64 + fr, fq * 8), boff = FP8 ? lds_byte(wc * 32 + fr, (fq & 1) * 16) + (fq >> 1) * 1024 : lds_byte(wc * 32 + fr, fq * 8);
#define PG8_SA(b, h) (((b) * 2 + (h)) * HTB)
#define PG8_SB(b, h) ((4 + (b) * 2 + (h)) * HTB)
#define PG8_STAGE(bufoff, gbase, voff) do { _Pragma("unroll") for (int _i = 0; _i < 2; ++_i) \
        __builtin_amdgcn_global_load_lds((const unsigned*)((const char*)(gbase) + (voff)[_i]), (LAS unsigned*)(lds + (bufoff) + ldsw + _i * 8192), 16, 0, 0); } while (0)
#define PG8_LD8(p_) ({ const u32x4 lo_ = *(const LAS u32x4*)(p_), hi_ = *(const LAS u32x4*)((p_) + 16); (v8i){(int)lo_.x, (int)lo_.y, (int)lo_.z, (int)lo_.w, (int)hi_.x, (int)hi_.y, (int)hi_.z, (int)hi_.w}; })
#define PG8_LDA(dst, b, h) do { if constexpr (FP8) { _Pragma("unroll") for (int m = 0; m < 4; ++m) dst##8[m] = PG8_LD8(lds + PG8_SA(b, h) + aoff + m * 2048); } \
        else { _Pragma("unroll") for (int m = 0; m < 4; ++m) _Pragma("unroll") for (int k = 0; k < 2; ++k) dst[m][k] = *(const LAS bf16x8*)(lds + PG8_SA(b, h) + aoff + m * 2048 + k * 1024); } } while (0)
#define PG8_LDB(dst, b, h) do { if constexpr (FP8) { _Pragma("unroll") for (int n = 0; n < 2; ++n) dst##8[n] = PG8_LD8(lds + PG8_SB(b, h) + boff + n * 2048); } \
        else { _Pragma("unroll") for (int n = 0; n < 2; ++n) _Pragma("unroll") for (int k = 0; k < 2; ++k) dst[n][k] = *(const LAS bf16x8*)(lds + PG8_SB(b, h) + boff + n * 2048 + k * 1024); } } while (0)
#define PG8_MMA(ai, bj, At, Bt) do { __builtin_amdgcn_s_setprio(1); if constexpr (FP8) { _Pragma("unroll") for (int m = 0; m < 4; ++m) _Pragma("unroll") for (int n = 0; n < 2; ++n) \
        asm volatile("v_mfma_f32_16x16x128_f8f6f4 %0, %1, %2, %0" : "+v"(acc[ai][bj][m][n]) : "v"(Bt##8[n]), "v"(At##8[m])); }   \
        else { _Pragma("unroll") for (int m = 0; m < 4; ++m) _Pragma("unroll") for (int n = 0; n < 2; ++n) _Pragma("unroll") for (int k = 0; k < 2; ++k) \
        acc[ai][bj][m][n] = __builtin_amdgcn_mfma_f32_16x16x32_bf16(Bt[n][k], At[m][k], acc[ai][bj][m][n], 0, 0, 0); } __builtin_amdgcn_s_setprio(0); } while (0)
#define PG8_WAIT_V(n) asm volatile("s_waitcnt vmcnt(" #n ")" ::: "memory")
#define PG8_WAIT_L(n) asm volatile("s_waitcnt lgkmcnt(" #n ")" ::: "memory")
#define PG8_BAR __builtin_amdgcn_s_barrier()
#define PG8_SCHED __builtin_amdgcn_sched_barrier(0)
    Unit cur, nxt; int ui = 0;
    if (!S.next(0, cur)) return;
    f32x4 acc[2][2][4][2];
#pragma unroll
    for (int a = 0; a < 2; ++a)
#pragma unroll
        for (int b = 0; b < 2; ++b)
#pragma unroll
            for (int m = 0; m < 4; ++m)
#pragma unroll
                for (int n = 0; n < 2; ++n) acc[a][b][m][n] = (f32x4){0.f, 0.f, 0.f, 0.f};
    bf16x8 At[4][2], B0[2][2], B1[2][2]; v8i At8[4], B08[2], B18[2];
    const char* cA = cur.a; const char* cB = cur.b;
    PG8_IDX(cur, a0c, a1c);
    PG8_STAGE(PG8_SB(0, 0), cB, voffB); PG8_STAGE(PG8_SB(0, 1), cB + hB, voffB); PG8_STAGE(PG8_SA(0, 0), cA, a0c); PG8_STAGE(PG8_SA(0, 1), cA + hA, a1c);
    if (wr == 1) PG8_BAR;
    PG8_WAIT_V(2); PG8_BAR;
    PG8_STAGE(PG8_SB(1, 0), cB + kstep, voffB); PG8_STAGE(PG8_SA(1, 0), cA + kstep, a0c); PG8_STAGE(PG8_SB(1, 1), cB + hB + kstep, voffB);
    PG8_WAIT_V(6); PG8_BAR;
    for (;;) {
        const bool has_next = S.next(ui + 1, nxt);
        const char* nA = has_next ? nxt.a : cA; const char* nB = has_next ? nxt.b : cB;
        if constexpr (GATHER) { if (has_next)
            __builtin_amdgcn_global_load_lds((const unsigned*)(nxt.idx + 4 * lane), (LAS unsigned*)(lds + STAGE_BYTES + wid * 1024), 16, 0, 0); }
#pragma unroll 1
        for (int t = 0; t < nt; t += 2) {
            const bool last = (t == nt - 2);
            const char* a1 = cA + (size_t)(t + 1) * kstep;
            const char* a2 = last ? nA : cA + (size_t)(t + 2) * kstep; const char* b2 = last ? nB : cB + (size_t)(t + 2) * kstep;
            const char* a3 = a2 + kstep; const char* b3 = b2 + kstep;
            PG8_LDB(B0, 0, 0); PG8_LDB(B1, 0, 1); PG8_SCHED; PG8_LDA(At, 0, 0); PG8_STAGE(PG8_SA(1, 1), a1 + hA, a1c);
            if constexpr (GATHER) { if (last && has_next) {
                { const LAS unsigned* ix = (const LAS unsigned*)(lds + STAGE_BYTES + wid * 1024); a0n[0] = ix[gR[0]]; a0n[1] = ix[gR[1]]; a1n[0] = ix[128 + gR[0]]; a1n[1] = ix[128 + gR[1]]; }
                a0c[0] = a0n[0] * (g.lda * 2u) + (unsigned)gC[0] * 2u; a0c[1] = a0n[1] * (g.lda * 2u) + (unsigned)gC[1] * 2u; a1c[0] = a1n[0] * (g.lda * 2u) + (unsigned)gC[0] * 2u; a1c[1] = a1n[1] * (g.lda * 2u) + (unsigned)gC[1] * 2u; } }
            PG8_WAIT_V(8); PG8_WAIT_L(0); PG8_BAR; PG8_MMA(0, 0, At, B0); PG8_MMA(0, 1, At, B1); PG8_BAR; PG8_SCHED;
            PG8_LDA(At, 0, 1); PG8_STAGE(PG8_SB(0, 0), b2, voffB); PG8_STAGE(PG8_SB(0, 1), b2 + hB, voffB); PG8_STAGE(PG8_SA(0, 0), a2, a0c);
            PG8_WAIT_V(8); PG8_WAIT_L(0); PG8_BAR; PG8_MMA(1, 0, At, B0); PG8_MMA(1, 1, At, B1); PG8_BAR; PG8_SCHED;
            PG8_LDB(B0, 1, 0); PG8_LDB(B1, 1, 1); PG8_SCHED; PG8_LDA(At, 1, 0); PG8_STAGE(PG8_SA(0, 1), a2 + hA, a1c);
            PG8_WAIT_V(8); PG8_WAIT_L(0); PG8_BAR; PG8_MMA(0, 0, At, B0); PG8_MMA(0, 1, At, B1); PG8_BAR; PG8_SCHED;
            PG8_LDA(At, 1, 1); PG8_STAGE(PG8_SB(1, 0), b3, voffB); PG8_STAGE(PG8_SB(1, 1), b3 + hB, voffB); PG8_STAGE(PG8_SA(1, 0), a3, a0c);
            PG8_WAIT_V(8); PG8_WAIT_L(0); PG8_BAR; PG8_MMA(1, 0, At, B0); PG8_MMA(1, 1, At, B1); PG8_BAR; PG8_SCHED;
        }
        if constexpr (ALIGN_EPI) { if (wr == 0) PG8_BAR; }
        if constexpr (FP8) asm volatile("s_nop 15\n\ts_nop 15" ::: "memory");
        { int fr_ = fr, fq_ = fq; asm volatile("" : "+v"(fr_), "+v"(fq_)); E(acc, cur, wr, wc, fr_, fq_); }
        if (!has_next) break;
#pragma unroll
        for (int a = 0; a < 2; ++a)
#pragma unroll
            for (int b = 0; b < 2; ++b)
#pragma unroll
                for (int m = 0; m < 4; ++m)
#pragma unroll
                    for (int n = 0; n < 2; ++n) acc[a][b][m][n] = (f32x4){0.f, 0.f, 0.f, 0.f};
        cur = nxt; cA = nA; cB = nB; ++ui;
        if constexpr (ALIGN_EPI) { if (wr == 1) PG8_BAR; }
    }
    PG8_WAIT_V(0);
    if constexpr (!ALIGN_EPI) { if (wr == 0) PG8_BAR; }
    PG8_BAR;
#undef PG8_SA
#undef PG8_SB
#undef PG8_STAGE
#undef PG8_LDA
#undef PG8_IDX
#undef PG8_LD8
#undef PG8_LDB
#undef PG8_MMA
#undef PG8_WAIT_V
#undef PG8_WAIT_L
#undef PG8_BAR
#undef PG8_SCHED
}

typedef const f32x4 (&AccRef)[2][2][4][2];
__device__ __forceinline__ u32x4 pack8(const f32x4 v0, const f32x4 v1) { u32x4 w; w.x = cvt_pk_bf16(v0[0], v0[1]); w.y = cvt_pk_bf16(v0[2], v0[3]); w.z = cvt_pk_bf16(v1[0], v1[1]); w.w = cvt_pk_bf16(v1[2], v1[3]); return w; }

struct EpiBf16 {
    static constexpr bool PERM = true;
    bf16_t* O; int ldc; float scale;
    __device__ __forceinline__ void operator()(AccRef acc, const Unit& u, int wr, int wc, int fr, int fq) const {
        const int row0 = u.orow + wr * 64 + fr, col0 = u.ocol + wc * 32 + 8 * fq;
#pragma unroll
        for (int ai = 0; ai < 2; ++ai)
#pragma unroll
            for (int m = 0; m < 4; ++m) { bf16_t* rowp = O + (size_t)(row0 + ai * HALF + m * 16) * ldc + col0;
#pragma unroll
                for (int bj = 0; bj < 2; ++bj) *(u32x4*)(rowp + bj * HALF) = pack8(acc[ai][bj][m][0] * scale, acc[ai][bj][m][1] * scale); }
    }
};
struct EpiFp8 {
    static constexpr bool PERM = true;
    unsigned char* O; int ldc; float scale;
    __device__ __forceinline__ void operator()(AccRef acc, const Unit& u, int wr, int wc, int fr, int fq) const {
        const int row0 = u.orow + wr * 64 + fr, col0 = u.ocol + wc * 32 + 8 * fq;
#pragma unroll
        for (int ai = 0; ai < 2; ++ai)
#pragma unroll
            for (int m = 0; m < 4; ++m) { unsigned char* rowp = O + (size_t)(row0 + ai * HALF + m * 16) * ldc + col0;
#pragma unroll
                for (int bj = 0; bj < 2; ++bj) { const f32x4 v0 = acc[ai][bj][m][0] * scale, v1 = acc[ai][bj][m][1] * scale; u32x2 w;
                    w.x = cvt4_fp8(clamp448(v0[0]), clamp448(v0[1]), clamp448(v0[2]), clamp448(v0[3])); w.y = cvt4_fp8(clamp448(v1[0]), clamp448(v1[1]), clamp448(v1[2]), clamp448(v1[3]));
                    *(u32x2*)(rowp + bj * HALF) = w; } }
    }
};
struct EpiInProj {
    static constexpr bool PERM = true;
    bf16_t* O; const LAS f32x2* rope;
    __device__ __forceinline__ void operator()(AccRef acc, const Unit& u, int wr, int wc, int fr, int fq) const {
        const int row0 = u.orow + wr * 64 + fr, col0 = u.ocol + wc * 32 + 8 * fq;
        const bool do_rope = (u.ocol < 1024) && (u.orow < ML);
        const float sgn = (fq < 2) ? -1.f : 1.f;
#pragma unroll
        for (int ai = 0; ai < 2; ++ai)
#pragma unroll
            for (int m = 0; m < 4; ++m) { const int row = row0 + ai * HALF + m * 16; bf16_t* rowp = O + (size_t)row * INW + col0;
                f32x2 cs[8];
                if (do_rope) { const int t = row & (T - 1); const int pos = (wc & 1) ? (t & 63) : (t >> 6);
                    const LAS f32x4* rp = (const LAS f32x4*)(rope + pos * 16 + 8 * (fq & 1));
#pragma unroll
                    for (int k = 0; k < 4; ++k) { const f32x4 q = rp[k]; cs[2 * k] = (f32x2){q[0], q[1]}; cs[2 * k + 1] = (f32x2){q[2], q[3]}; } }
#pragma unroll
                for (int bj = 0; bj < 2; ++bj) { f32x4 v0 = acc[ai][bj][m][0], v1 = acc[ai][bj][m][1];
                    if (do_rope) {
#pragma unroll
                        for (int k = 0; k < 4; ++k) { const float p0 = xor32f(v0[k], fq < 2), p1 = xor32f(v1[k], fq < 2);
                            v0[k] = v0[k] * cs[k].x + sgn * p0 * cs[k].y; v1[k] = v1[k] * cs[4 + k].x + sgn * p1 * cs[4 + k].y; } }
                    *(u32x4*)(rowp + bj * HALF) = pack8(v0, v1); } }
    }
};
struct EpiF32 {
    static constexpr bool PERM = false;
    float* C; int ldc;
    __device__ __forceinline__ void operator()(AccRef acc, const Unit& u, int wr, int wc, int fr, int fq) const {
        const int row0 = u.orow + wr * 64 + fr, col0 = u.ocol + wc * 32 + 4 * fq;
#pragma unroll
        for (int ai = 0; ai < 2; ++ai)
#pragma unroll
            for (int m = 0; m < 4; ++m) { float* rowp = C + (size_t)(row0 + ai * HALF + m * 16) * ldc + col0;
#pragma unroll
                for (int bj = 0; bj < 2; ++bj)
#pragma unroll
                    for (int n = 0; n < 2; ++n) *(f32x4*)(rowp + bj * HALF + n * 16) = acc[ai][bj][m][n]; }
    }
};
struct EpiGateUp {
    static constexpr bool PERM = true;
    unsigned char* O;
    __device__ __forceinline__ void operator()(AccRef acc, const Unit& u, int wr, int wc, int fr, int fq) const {
        const int row0 = u.orow + wr * 64 + fr, col0 = u.ocol + wc * 32 + 8 * fq; constexpr float sg = 1.0f / (SX8 * SWG8);
#pragma unroll
        for (int ai = 0; ai < 2; ++ai)
#pragma unroll
            for (int m = 0; m < 4; ++m) { unsigned char* rowp = O + (size_t)(row0 + ai * HALF + m * 16) * FE + col0;
                float h[8];
#pragma unroll
                for (int k = 0; k < 4; ++k) { const float g0 = acc[ai][0][m][0][k] * sg, g1 = acc[ai][0][m][1][k] * sg;
                    h[k] = clamp448(g0 * fast_sigmoid(g0) * acc[ai][1][m][0][k] * (sg * SH8)); h[4 + k] = clamp448(g1 * fast_sigmoid(g1) * acc[ai][1][m][1][k] * (sg * SH8)); }
                u32x2 w; w.x = cvt4_fp8(h[0], h[1], h[2], h[3]); w.y = cvt4_fp8(h[4], h[5], h[6], h[7]); *(u32x2*)rowp = w; }
    }
};
struct EpiF1 {
    static constexpr bool PERM = true;
    bf16_t* GT; bf16_t* GTC;
    __device__ __forceinline__ void operator()(AccRef acc, const Unit& u, int wr, int wc, int fr, int fq) const {
        const int p = u.orow >> 8, pn = u.ocol >> 8, c0 = wr * 64 + fr, t0 = wc * 32 + 8 * fq;
        bf16_t* base; int cs;
        if (pn < 256) { base = GT + ((size_t)(pn >> 4) << 21) + (size_t)p * 4096 + (pn & 15) * 256; cs = 8192; }
        else { base = GTC + (size_t)(pn - 256) * 131072 + p * 256; cs = 512; }
        bf16_t* lp = base + (size_t)c0 * cs + t0;
#pragma unroll
        for (int ai = 0; ai < 2; ++ai)
#pragma unroll
            for (int m = 0; m < 4; ++m) { bf16_t* rp = lp + (size_t)(ai * HALF + m * 16) * cs;
#pragma unroll
                for (int bj = 0; bj < 2; ++bj) *(u32x4*)(rp + bj * HALF) = pack8(acc[ai][bj][m][0], acc[ai][bj][m][1]); }
    }
};

struct EpiF2H {
    static constexpr bool PERM = true;
    float* PQ; bf16_t* CC; unsigned* flags; unsigned epoch;
    __device__ __forceinline__ void operator()(AccRef acc, const Unit& u, int wr, int wc, int fr, int fq) const {
        const int part = u.ocol, b = u.orow >> 3, pm8 = u.orow & 7;
        float* tile = PQ + (size_t)u.orow * 65536; const int r0 = wr * 64 + fr, c0 = wc * 32 + 8 * fq;
        if (part == 0) {
#pragma unroll
            for (int ai = 0; ai < 2; ++ai)
#pragma unroll
                for (int m = 0; m < 4; ++m) { float* rp = tile + (size_t)(r0 + ai * HALF + m * 16) * 256 + c0;
#pragma unroll
                    for (int bj = 0; bj < 2; ++bj) { *(f32x4*)(rp + bj * HALF) = acc[ai][bj][m][0]; *(f32x4*)(rp + bj * HALF + 4) = acc[ai][bj][m][1]; } }
            asm volatile("s_waitcnt vmcnt(0)" ::: "memory"); __builtin_amdgcn_s_barrier();
            if (threadIdx.x == 0) { __builtin_amdgcn_fence(__ATOMIC_RELEASE, "agent"); asm volatile("s_waitcnt vmcnt(0)" ::: "memory"); __hip_atomic_store(flags + u.orow * 64, epoch, __ATOMIC_RELAXED, __HIP_MEMORY_SCOPE_AGENT); }
        } else {
            if (threadIdx.x == 0) { unsigned sp = 0; while (__hip_atomic_load(flags + u.orow * 64, __ATOMIC_RELAXED, __HIP_MEMORY_SCOPE_AGENT) < epoch) { __builtin_amdgcn_s_sleep(2); if (++sp > (1u << 20)) break; }
                __builtin_amdgcn_fence(__ATOMIC_ACQUIRE, "agent"); asm volatile("s_waitcnt vmcnt(0)" ::: "memory"); }
            __builtin_amdgcn_s_barrier(); asm volatile("" ::: "memory");
#pragma unroll
            for (int ai = 0; ai < 2; ++ai)
#pragma unroll
                for (int m = 0; m < 4; ++m) { const int r = r0 + ai * HALF + m * 16, k = pm8 * 256 + r; const float* rp = tile + (size_t)r * 256 + c0;
                    bf16_t* y0 = CC + (size_t)(b * T + k) * D + 768 + c0; bf16_t* y1 = CC + (size_t)(b * T + (T - k)) * D + 768 + c0;
#pragma unroll
                    for (int bj = 0; bj < 2; ++bj) { const f32x4 p0 = __builtin_nontemporal_load((const f32x4*)(rp + bj * HALF)), p1 = __builtin_nontemporal_load((const f32x4*)(rp + bj * HALF + 4));
                        *(u32x4*)(y0 + bj * HALF) = pack8(p0 + acc[ai][bj][m][0], p1 + acc[ai][bj][m][1]);
                        if (k > 0) *(u32x4*)(y1 + bj * HALF) = pack8(p0 - acc[ai][bj][m][0], p1 - acc[ai][bj][m][1]); } }
        }
    }
};

struct SchedPlain {
    int nN, total, G, c; const char* A; const char* B; size_t tA, tB; bool grp8;
    __device__ __forceinline__ bool next(int i, Unit& u) const { const int L = i * G + c; if (L >= total) return false; int pm = L / nN, pn = L - pm * nN;
        if (grp8) { const int gsz = 8 * nN, gi = L / gsz, r = L - gi * gsz; pm = gi * 8 + (r & 7); pn = r >> 3; }
        u.a = A + (size_t)pm * tA; u.b = B + (size_t)pn * tB; u.orow = pm * BM; u.ocol = pn * BM; u.idx = nullptr; return true; }
};
struct SchedF1 {
    int total, G, c; const char* A; const char* B;
    __device__ __forceinline__ bool next(int i, Unit& u) const { const int L = i * G + c; if (L >= total) return false; const int pn = L >> 1, pm = L & 1;
        u.a = A + (size_t)pm * (256 * 256 * 2); u.b = B + (size_t)pn * (256 * (size_t)INW * 2); u.orow = pm * BM; u.ocol = pn * BM; u.idx = nullptr; return true; }
};
struct SchedF2L {
    int G, c; const char* AT; const char* GT;
    __device__ __forceinline__ bool next(int i, Unit& u) const { const int L = i * G + c; if (L >= 256) return false;
        int b = L >> 4, pm = L & 15; if (G == 256) { const int x = L >> 5, w = L & 31; pm = (x & 3) * 4 + (w & 3); b = (x >> 2) * 8 + (w >> 2); }
        u.a = AT + (size_t)pm * (256 * 8192 * 2); u.b = GT + (size_t)b * (256 * 8192 * 2); u.orow = b * T + pm * BM; u.ocol = 768; u.idx = nullptr; return true; }
};
struct SchedF2H {
    int G, c; const char* AT; const char* GT;
    __device__ __forceinline__ bool next(int i, Unit& u) const { const int L = i * G + c; if (L >= 256) return false;
        const int x = L >> 5, w = L & 31, part = w & 1, pm8 = (x & 1) * 4 + ((w >> 1) & 3), b = (x >> 1) * 4 + (w >> 3);
        u.a = AT + (size_t)pm8 * (256 * 8192 * 2) + (size_t)part * (4096 * 2); u.b = GT + (size_t)b * (256 * 8192 * 2) + (size_t)part * (4096 * 2); u.orow = b * 8 + pm8; u.ocol = part; u.idx = nullptr; return true; }
};
struct SchedF2C {
    int G, c; const char* AC; const char* GTC;
    __device__ __forceinline__ bool next(int i, Unit& u) const { const int L = i * G + c; if (L >= 16) return false;
        u.a = AC; u.b = GTC + (size_t)L * (256 * 512 * 2); u.orow = ML + L * TC; u.ocol = 768; u.idx = nullptr; return true; }
};
struct SchedGU {
    int nrt, G, c; const char* XS; const char* W; const int* IDX;
    __device__ __forceinline__ bool next(int i, Unit& u) const { const int L = i * G + c; if (L >= 16 * 16 * nrt) return false;
        const int e = L / (16 * nrt), r = L - e * 16 * nrt;
        const int gi = r >> 6, rr = r & 63, gsz = (nrt - 4 * gi) < 4 ? (nrt - 4 * gi) : 4, half = rr / (gsz * 8), w = rr - half * gsz * 8, rt = gi * 4 + w % gsz, ct = half * 8 + w / gsz;
        const int rowbase = (rt < 32) ? (e * 17 + (rt >> 1)) * 512 + (rt & 1) * 256 : (e * 17 + 16) * 512 + (rt - 32) * 256;
        u.a = XS; u.idx = IDX + rowbase; u.b = W + (size_t)e * (2 * FE * D) + (size_t)ct * (128 * D); u.orow = rowbase; u.ocol = ct * 128; return true; }
};
struct SchedDN {
    int nrt, G, c; const char* HM; const char* W;
    __device__ __forceinline__ bool next(int i, Unit& u) const { const int L = i * G + c; if (L >= 16 * 4 * nrt) return false;
        const int e = L / (4 * nrt), r = L - e * 4 * nrt, rt = r >> 2, ct = r & 3;
        const int rowbase = (rt < 32) ? (e * 17 + (rt >> 1)) * 512 + (rt & 1) * 256 : (e * 17 + 16) * 512 + (rt - 32) * 256;
        u.a = HM + (size_t)rowbase * FE; u.b = W + (size_t)e * (D * FE) + (size_t)ct * (256 * FE); u.orow = rowbase; u.ocol = ct * 256; u.idx = nullptr; return true; }
};
}
namespace att {
constexpr int NW = 8, QBLK = 32, KVBLK = 64, LDZ = INW;
constexpr float SCALE = 0.125f, THR = 8.f;
#ifndef ATT_SDEPTH
#define ATT_SDEPTH 2
#endif
constexpr int SDEPTH = ATT_SDEPTH;
constexpr int SHM_V = KVBLK * 128 * 2, SHM_K = KVBLK * 64 * 2;
#ifndef ATT_RING3
#define ATT_RING3 1
#endif
constexpr int NBUF = ATT_RING3 ? 3 : 2;
constexpr int OFF_V = 0, OFF_K = NBUF * SHM_V, OFF_WS = OFF_K + NBUF * SHM_K, ATT_LDS = OFF_WS + NW * 64 * 4;
#define KSWZ(row, colB) ((row) * 128 + ((colB) ^ ((((row) >> 1) & 7) << 4)))
#define SBAR() __builtin_amdgcn_sched_barrier(0)
__device__ __forceinline__ int crow(int r, int hi) { return (r & 3) + 8 * (r >> 2) + 4 * hi; }
__device__ __forceinline__ void partialSM(f32x16& p0, f32x16& p1, float& m_reg, float& mn, float& alpha) {
  constexpr float C = SCALE * 1.4426950408889634f;
  float pmax = p0[0];
#pragma unroll
  for (int r = 1; r < 16; ++r) pmax = fmaxf(pmax, p0[r]);
#pragma unroll
  for (int r = 0; r < 16; ++r) pmax = fmaxf(pmax, p1[r]);
  { unsigned r0, r1; swap32(__float_as_uint(pmax), r0, r1); pmax = fmaxf(__uint_as_float(r0), __uint_as_float(r1)); }
  if (__builtin_expect(__all(pmax - m_reg <= THR / SCALE), 1)) { mn = m_reg; alpha = 1.f; }
  else { mn = fmaxf(m_reg, pmax); alpha = __builtin_amdgcn_exp2f((m_reg - mn) * C); m_reg = mn; }
  float mnC = -mn * C;
#pragma unroll
  for (int r = 0; r < 16; ++r) p0[r] = fmaf(p0[r], C, mnC);
#pragma unroll
  for (int r = 0; r < 16; ++r) p1[r] = fmaf(p1[r], C, mnC);
#ifndef ABL_NOEXP
#pragma unroll
  for (int r = 0; r < 16; ++r) p0[r] = __builtin_amdgcn_exp2f(p0[r]);
#endif
}
__device__ __forceinline__ void finishSM(f32x16& p0, f32x16& p1, float alpha, float& l_reg, bf16x8& pa0, bf16x8& pa1, bf16x8& pa2, bf16x8& pa3) {
#ifndef ABL_NOEXP
#pragma unroll
  for (int r = 0; r < 16; ++r) p1[r] = __builtin_amdgcn_exp2f(p1[r]);
#endif
  float ps = 0;
#pragma unroll
  for (int r = 0; r < 16; ++r) ps += p0[r];
#pragma unroll
  for (int r = 0; r < 16; ++r) ps += p1[r];
  { unsigned r0, r1; swap32(__float_as_uint(ps), r0, r1); ps = __uint_as_float(r0) + __uint_as_float(r1); }
  l_reg = l_reg * alpha + ps;
#define PK4(P, BASE, OUT) do { unsigned a0 = cvt_pk_bf16(P[BASE + 0], P[BASE + 1]), a1 = cvt_pk_bf16(P[BASE + 2], P[BASE + 3]);   \
    unsigned b0 = cvt_pk_bf16(P[BASE + 4], P[BASE + 5]), b1 = cvt_pk_bf16(P[BASE + 6], P[BASE + 7]);                              \
    auto r0 = __builtin_amdgcn_permlane32_swap(a0, b0, false, false); auto r1 = __builtin_amdgcn_permlane32_swap(a1, b1, false, false); \
    u32x4 w = {r0[0], r1[0], r0[1], r1[1]}; OUT = __builtin_bit_cast(bf16x8, w); } while (0)
  PK4(p0, 0, pa0); PK4(p0, 8, pa1); PK4(p1, 0, pa2); PK4(p1, 8, pa3);
#undef PK4
}
__device__ __forceinline__ void qkt(f32x16& p0, f32x16& p1, const LAS char* Ks, const bf16x8* qr, int r32, int hi) {
#pragma unroll
  for (int r = 0; r < 16; ++r) { p0[r] = 0.f; p1[r] = 0.f; }
#pragma unroll
  for (int d0 = 0; d0 < 4; ++d0) { const int cb = (d0 * 16 + hi * 8) * 2;
    bf16x8 b0 = *(const LAS bf16x8*)(Ks + KSWZ(r32, cb));
    bf16x8 b1 = *(const LAS bf16x8*)(Ks + KSWZ(32 + r32, cb));
    p0 = __builtin_amdgcn_mfma_f32_32x32x16_bf16(b0, qr[d0], p0, 0, 0, 0);
    p1 = __builtin_amdgcn_mfma_f32_32x32x16_bf16(b1, qr[d0], p1, 0, 0, 0); }
}
__device__ __forceinline__ int v_st(int k, int c) { const int kk = (k & ~0xC) | ((k & 4) << 1) | ((k & 8) >> 1); return ((kk >> 3) * 4 + (c >> 5)) * 512 + ((kk & 7) * 32 + (c & 31)) * 2; }
__device__ __forceinline__ int v_rd_base(int lane) { return ((lane & 3) << 3) | (((lane >> 2) & 3) << 6) | (((lane >> 4) & 1) << 5) | (((lane >> 5) & 1) << 8); }
constexpr int v_rd_off(int d0, int ks, int half) { return d0 * 512 + ks * 4096 + half * 2048; }
template <int OFF> __device__ __forceinline__ s16x4 tr_read(int vb) {
  s16x4 r; asm volatile("ds_read_b64_tr_b16 %0, %1 offset:%2" : "=&v"(r) : "v"(vb), "i"(OFF) : "memory"); return r;
}
template <int D0> __device__ __forceinline__ void pv_one(f32x16& od, int vb, bf16x8 pa0, bf16x8 pa1, bf16x8 pa2, bf16x8 pa3) {
  const s16x4 l0 = tr_read<v_rd_off(D0, 0, 0)>(vb), h0 = tr_read<v_rd_off(D0, 0, 1)>(vb), l1 = tr_read<v_rd_off(D0, 1, 0)>(vb), h1 = tr_read<v_rd_off(D0, 1, 1)>(vb);
  const s16x4 l2 = tr_read<v_rd_off(D0, 2, 0)>(vb), h2 = tr_read<v_rd_off(D0, 2, 1)>(vb), l3 = tr_read<v_rd_off(D0, 3, 0)>(vb), h3 = tr_read<v_rd_off(D0, 3, 1)>(vb);
  asm volatile("s_waitcnt lgkmcnt(0)" ::: "memory"); SBAR();
#define PK(L, H) (bf16x8){L[0], L[1], L[2], L[3], H[0], H[1], H[2], H[3]}
  od = __builtin_amdgcn_mfma_f32_32x32x16_bf16(pa0, PK(l0, h0), od, 0, 0, 0);
  od = __builtin_amdgcn_mfma_f32_32x32x16_bf16(pa1, PK(l1, h1), od, 0, 0, 0);
  od = __builtin_amdgcn_mfma_f32_32x32x16_bf16(pa2, PK(l2, h2), od, 0, 0, 0);
  od = __builtin_amdgcn_mfma_f32_32x32x16_bf16(pa3, PK(l3, h3), od, 0, 0, 0);
#undef PK
}
__device__ __forceinline__ void pv_d0(f32x16* o, int vb, bf16x8 pa0, bf16x8 pa1, bf16x8 pa2, bf16x8 pa3) {
  pv_one<0>(o[0], vb, pa0, pa1, pa2, pa3); pv_one<1>(o[1], vb, pa0, pa1, pa2, pa3); pv_one<2>(o[2], vb, pa0, pa1, pa2, pa3); pv_one<3>(o[3], vb, pa0, pa1, pa2, pa3);
}

__device__ __forceinline__ void diff_attn_unit(const bf16_t* __restrict__ Z, bf16_t* __restrict__ CC, float* o1s, const float* __restrict__ gvec, float lam, float gsc,
                                               int qrow0, int h, int seg0, int n0, int seg1, int NT, LAS char* lds, int tid) {
  asm volatile("" : "+v"(tid));
  const int wid = tid >> 6, lane = tid & 63, r32 = lane & 31, hi = lane >> 5;
  LAS char* V_lds = lds + OFF_V; LAS char* K_lds = lds + OFF_K;
  LAS float* ws = (LAS float*)(lds + OFF_WS) + wid * 64; LAS float* li_l = ws; LAS float* al_l = ws + 32;
  const int sr = tid >> 4, sc = (tid & 15) * 8, vst0 = v_st(sr, sc), vst1 = v_st(32 + sr, sc);
  const int kr = tid >> 3, kc = (tid & 7) * 8, kst = KSWZ(kr, kc * 2);
  const int vb0 = (int)(uintptr_t)V_lds + v_rd_base(lane);
  const bf16_t* Vcol = Z + 1024 + h * 128 + sc;
  for (int mp = 0; mp < 2; ++mp) {
    __syncthreads();
    const bf16_t* Kcol = Z + 512 + h * 128 + mp * 64 + kc;
    float m_reg = -1e30f, l_reg = 0; f32x16 o[4]; bf16x8 qr[4];
#pragma unroll
    for (int d = 0; d < 4; ++d)
#pragma unroll
      for (int r = 0; r < 16; ++r) o[d][r] = 0.f;
    const bf16_t* Qw = Z + (size_t)(qrow0 + wid * QBLK + r32) * LDZ + h * 128 + mp * 64 + hi * 8;
#pragma unroll
    for (int d0 = 0; d0 < 4; ++d0) qr[d0] = *(const bf16x8*)(Qw + d0 * 16);
    struct { bf16x8 vs0, vs1, ks; } sr_[SDEPTH];
#define TROW(j) ((j) < n0 ? seg0 + (j) * KVBLK : seg1 + ((j) - n0) * KVBLK)
#define SLOAD(i, j) do { const int _k0 = TROW(j); sr_[i].vs0 = *(const bf16x8*)(Vcol + (size_t)(_k0 + sr) * LDZ); sr_[i].vs1 = *(const bf16x8*)(Vcol + (size_t)(_k0 + 32 + sr) * LDZ); \
    sr_[i].ks = *(const bf16x8*)(Kcol + (size_t)(_k0 + kr) * LDZ); } while (0)
#define SWRITE(b, i) do { *(LAS bf16x8*)(V_lds + (b) * SHM_V + vst0) = sr_[i].vs0; *(LAS bf16x8*)(V_lds + (b) * SHM_V + vst1) = sr_[i].vs1; \
    *(LAS bf16x8*)(K_lds + (b) * SHM_K + kst) = sr_[i].ks; } while (0)
#define SWAIT() do { if constexpr (SDEPTH == 2) asm volatile("s_waitcnt vmcnt(3)" ::: "memory"); else asm volatile("s_waitcnt vmcnt(0)" ::: "memory"); } while (0)
#define RESC(a) do { if (__any((a) < 1.f)) { if (hi == 0) al_l[r32] = (a); asm volatile("s_waitcnt lgkmcnt(0)" ::: "memory"); \
    _Pragma("unroll") for (int d = 0; d < 4; ++d) _Pragma("unroll") for (int r = 0; r < 16; ++r) o[d][r] *= al_l[crow(r, hi)]; } } while (0)
    f32x16 pA0, pA1, pB0, pB1; float mnA, mnB, alA, alB; bf16x8 pa0, pa1, pa2, pa3;
    constexpr int SE = 0, SO = SDEPTH - 1;
    SLOAD(SE, 0); asm volatile("s_waitcnt vmcnt(0)" ::: "memory"); SWRITE(0, SE); __syncthreads();
    qkt(pA0, pA1, K_lds, qr, r32, hi); partialSM(pA0, pA1, m_reg, mnA, alA);
    SLOAD(SO, 1); if constexpr (SDEPTH == 2) { if (2 < NT) SLOAD(SE, 2); }
    SWAIT(); SWRITE(1, SO); __syncthreads();
#if ATT_RING3
    int b0 = 0, b1 = 1, b2 = 2;
    for (int j = 1; j + 1 < NT; j += 2) {
      SBAR(); qkt(pB0, pB1, K_lds + b1 * SHM_K, qr, r32, hi);
      finishSM(pA0, pA1, alA, l_reg, pa0, pa1, pa2, pa3); SBAR();
      SLOAD(SO, j + SDEPTH); SBAR();
      pv_d0(o, vb0 + b0 * SHM_V, pa0, pa1, pa2, pa3); partialSM(pB0, pB1, m_reg, mnB, alB);
      SWAIT(); SWRITE(b2, SE);
      RESC(alB); __syncthreads();
      SBAR(); qkt(pA0, pA1, K_lds + b2 * SHM_K, qr, r32, hi);
      finishSM(pB0, pB1, alB, l_reg, pa0, pa1, pa2, pa3); SBAR();
      if (SDEPTH == 1 || j + 3 < NT) SLOAD(SE, j + 1 + SDEPTH); SBAR();
      pv_d0(o, vb0 + b1 * SHM_V, pa0, pa1, pa2, pa3); partialSM(pA0, pA1, m_reg, mnA, alA);
      SWAIT(); SWRITE(b0, SO);
      RESC(alA); __syncthreads();
      { const int t0_ = b0; b0 = b2; b2 = b1; b1 = t0_; }
    }
    SBAR(); qkt(pB0, pB1, K_lds + b1 * SHM_K, qr, r32, hi);
    finishSM(pA0, pA1, alA, l_reg, pa0, pa1, pa2, pa3); SBAR();
    pv_d0(o, vb0 + b0 * SHM_V, pa0, pa1, pa2, pa3); partialSM(pB0, pB1, m_reg, mnB, alB);
    RESC(alB);
    finishSM(pB0, pB1, alB, l_reg, pa0, pa1, pa2, pa3); SBAR();
    pv_d0(o, vb0 + b1 * SHM_V, pa0, pa1, pa2, pa3);
#else
    for (int j = 1; j + 1 < NT; j += 2) {
      SBAR(); qkt(pB0, pB1, K_lds + SHM_K, qr, r32, hi);
      finishSM(pA0, pA1, alA, l_reg, pa0, pa1, pa2, pa3); SBAR();
      SLOAD(SO, j + SDEPTH); SBAR();
      pv_d0(o, vb0, pa0, pa1, pa2, pa3); partialSM(pB0, pB1, m_reg, mnB, alB);
      __syncthreads(); SWAIT(); SWRITE(0, SE);
      RESC(alB); __syncthreads();
      SBAR(); qkt(pA0, pA1, K_lds, qr, r32, hi);
      finishSM(pB0, pB1, alB, l_reg, pa0, pa1, pa2, pa3); SBAR();
      if (SDEPTH == 1 || j + 3 < NT) SLOAD(SE, j + 1 + SDEPTH); SBAR();
      pv_d0(o, vb0 + SHM_V, pa0, pa1, pa2, pa3); partialSM(pA0, pA1, m_reg, mnA, alA);
      __syncthreads(); SWAIT(); SWRITE(1, SO);
      RESC(alA); __syncthreads();
    }
    SBAR(); qkt(pB0, pB1, K_lds + SHM_K, qr, r32, hi);
    finishSM(pA0, pA1, alA, l_reg, pa0, pa1, pa2, pa3); SBAR();
    pv_d0(o, vb0, pa0, pa1, pa2, pa3); partialSM(pB0, pB1, m_reg, mnB, alB);
    __syncthreads(); RESC(alB);
    finishSM(pB0, pB1, alB, l_reg, pa0, pa1, pa2, pa3); SBAR();
    pv_d0(o, vb0 + SHM_V, pa0, pa1, pa2, pa3);
#endif
    if (hi == 0) li_l[r32] = l_reg; asm volatile("s_waitcnt lgkmcnt(0)" ::: "memory");
    float rli[16];
#pragma unroll
    for (int r = 0; r < 16; ++r) rli[r] = __builtin_amdgcn_rcpf(li_l[crow(r, hi)]);
    float* op = o1s + tid * 64;
    if (mp == 0) {
#pragma unroll
      for (int d0 = 0; d0 < 4; ++d0)
#pragma unroll
        for (int r4 = 0; r4 < 4; ++r4) *(f32x4*)(op + d0 * 16 + r4 * 4) = (f32x4){o[d0][4 * r4] * rli[4 * r4], o[d0][4 * r4 + 1] * rli[4 * r4 + 1], o[d0][4 * r4 + 2] * rli[4 * r4 + 2], o[d0][4 * r4 + 3] * rli[4 * r4 + 3]};
    } else {
      float ss[16];
#pragma unroll
      for (int r = 0; r < 16; ++r) ss[r] = 0.f;
#pragma unroll
      for (int d0 = 0; d0 < 4; ++d0)
#pragma unroll
        for (int r4 = 0; r4 < 4; ++r4) { const f32x4 o1 = __builtin_nontemporal_load((const f32x4*)(op + d0 * 16 + r4 * 4));
#pragma unroll
          for (int k = 0; k < 4; ++k) { const int r = 4 * r4 + k; const float v = o1[k] - lam * (o[d0][r] * rli[r]); o[d0][r] = v; ss[r] += v * v; } }
#pragma unroll
      for (int r = 0; r < 16; ++r) {
        ss[r] = row32_sum(ss[r]);
        ss[r] = __builtin_amdgcn_rsqf(ss[r] * (1.0f / 128.0f) + RMS_EPS) * gsc; }
      float gg[4];
#pragma unroll
      for (int d0 = 0; d0 < 4; ++d0) gg[d0] = gvec[h * 128 + d0 * 32 + r32];
      bf16_t* Ow = CC + (size_t)(qrow0 + wid * QBLK) * D + h * 128 + r32;
#pragma unroll
      for (int r = 0; r < 16; ++r) { int roff = crow(r, hi) * D; asm volatile("" : "+v"(roff)); bf16_t* rp = Ow + roff;
#pragma unroll
        for (int d0 = 0; d0 < 4; ++d0) rp[d0 * 32] = (bf16_t)f2bf(o[d0][r] * ss[r] * gg[d0]); }
    }
#undef TROW
#undef SLOAD
#undef SWRITE
#undef SWAIT
#undef RESC
  }
}
#undef KSWZ
}
struct Args { const float* in[28]; float* out; unsigned char* ws; int ph_lo, ph_hi, li, pad; };
struct Frame {
    LAS unsigned char* lds;
    int tid, lane, wave, vcu, G;
    unsigned char* ws;
};
enum { I_X = 0, I_C, I_CTX, I_CCTX, I_WMOD, I_BMOD, I_WIN, I_LQ1, I_LK1, I_LQ2, I_LK2, I_ANG, I_CONVW, I_CONVB, I_LWA, I_LBA, I_LWX, I_LBX, I_LLAM, I_WOUT,
       I_LN1G, I_LN1B, I_WR, I_WG, I_WU, I_WD, I_LN2G, I_LN2B };

__device__ __forceinline__ void transpose_item(const float* W, int N, bf16_t* WT, int ldt, LAS float* scr, int kb, int nb, int lane) {
    const int k0 = 64 * kb, n0 = 32 * nb;
#pragma unroll 8
    for (int i = 0; i < 32; ++i) { const int kk = 2 * i + (lane >> 5); scr[kk * 33 + (lane & 31)] = W[(size_t)(k0 + kk) * N + n0 + (lane & 31)]; }
    LDS_WAIT(); asm volatile("" ::: "memory");
    const int c = lane & 7;
#pragma unroll
    for (int j = 0; j < 4; ++j) { const int n = (lane >> 3) + 8 * j; const LAS float* s = scr + (8 * c) * 33 + n;
        u32x4 o; o.x = pk2(s[0 * 33], s[1 * 33]); o.y = pk2(s[2 * 33], s[3 * 33]); o.z = pk2(s[4 * 33], s[5 * 33]); o.w = pk2(s[6 * 33], s[7 * 33]);
        *(u32x4*)(WT + (size_t)(n0 + n) * ldt + k0 + 8 * c) = o; }
    LDS_WAIT(); asm volatile("" ::: "memory");
}

__device__ __forceinline__ void p0a(Frame& F, const Args& args) {
    const int gw = F.vcu * NWAVES + F.wave, NGW = F.G * NWAVES;
    LAS float* scr = (LAS float*)(F.lds + F.wave * 16384);
    { constexpr int IA = 16 * 72, IB = 16 * 32, PER = IA + IB;
      for (int it = gw; it < DEPTH * PER; it += NGW) { const int l = it / PER, r = it - l * PER;
        if (r < IA) transpose_item(args.in[I_WIN] + (size_t)l * D * INW, INW, (bf16_t*)(F.ws + WS_WIN) + (size_t)l * INW * D, D, scr, r / 72, r % 72, F.lane);
        else { const int r2 = r - IA; transpose_item(args.in[I_WOUT] + (size_t)l * D * D, D, (bf16_t*)(F.ws + WS_WOUT) + (size_t)l * D * D, D, scr, r2 / 32, r2 % 32, F.lane); } } }
    __syncthreads();
    { LAS float* sl = (LAS float*)F.lds;
      LAS float* cmb = sl + 17 * 1024;
      bool loaded = false;
      for (int it = F.vcu; it < DEPTH * 24; it += F.G) {
        if (!loaded) { for (int i = F.tid; i < 17 * 1024; i += NTHR) { const float c = (i < 16 * 1024) ? args.in[I_C][i] : args.in[I_CCTX][i - 16 * 1024]; sl[i] = c * fast_sigmoid(c); } loaded = true; }
        __syncthreads();
        const int l = it / 24, nb = it % 24, col = nb * 256 + (F.tid & 255), kh = F.tid >> 8;
        const float* wp = args.in[I_WMOD] + (size_t)l * D * 6144 + (size_t)(kh * 512) * 6144 + col;
        float acc[17];
#pragma unroll
        for (int j = 0; j < 17; ++j) acc[j] = 0.f;
        const float* wq = wp; float w0 = wq[0], w1 = wq[6144], w2 = wq[2 * 6144], w3 = wq[3 * 6144];
#pragma unroll 1
        for (int k = 0; k < 512; k += 4) {
            wq += 4 * 6144; const bool more = (k + 4 < 512);
            const float n0 = more ? wq[0] : 0.f, n1 = more ? wq[6144] : 0.f, n2 = more ? wq[2 * 6144] : 0.f, n3 = more ? wq[3 * 6144] : 0.f;
#pragma unroll
            for (int j = 0; j < 17; ++j) { const f32x4 s = *(const LAS f32x4*)(sl + j * 1024 + kh * 512 + k); acc[j] += s[0] * w0 + s[1] * w1 + s[2] * w2 + s[3] * w3; }
            w0 = n0; w1 = n1; w2 = n2; w3 = n3; }
        if (kh == 1) {
#pragma unroll
            for (int j = 0; j < 17; ++j) cmb[j * 256 + (F.tid & 255)] = acc[j]; }
        __syncthreads();
        if (kh == 0) { const float bm = args.in[I_BMOD][l * 6144 + col]; float* mo = (float*)(F.ws + WS_MOD) + (size_t)l * 17 * 6144 + col;
#pragma unroll
            for (int j = 0; j < 17; ++j) mo[(size_t)j * 6144] = acc[j] + cmb[j * 256 + (F.tid & 255)] + bm; }
        __syncthreads(); } }
    __syncthreads();
    { LAS f32x2* tab = (LAS f32x2*)F.lds;
      for (int r = F.tid; r < 4096; r += NTHR) { float s, c; sincospif((float)r * (1.0f / 2048.0f), &s, &c); tab[r] = (f32x2){c, s}; }
      __syncthreads();
      bf16_t* AT = (bf16_t*)(F.ws + WS_AT);
      for (int k = F.vcu; k < 2048; k += F.G) {
        for (int c8 = F.tid; c8 < 1024; c8 += NTHR) { const int half = c8 >> 9, t0 = (c8 & 511) * 8; unsigned w[4];
#pragma unroll
            for (int q = 0; q < 4; ++q) { const f32x2 e0 = tab[(k * (t0 + 2 * q)) & 4095], e1 = tab[(k * (t0 + 2 * q + 1)) & 4095];
                w[q] = half ? pk2(-e0.y * (1.f / 64.f), -e1.y * (1.f / 64.f)) : pk2(e0.x * (1.f / 64.f), e1.x * (1.f / 64.f)); }
            *(u32x4*)(AT + (size_t)k * 8192 + half * 4096 + t0) = (u32x4){w[0], w[1], w[2], w[3]}; } }
      bf16_t* AC = (bf16_t*)(F.ws + WS_SMALL + SM_AC);
      for (int i = gw * 64 + F.lane; i < 256 * 512; i += NGW * 64) { const int k = i >> 9, c = i & 511, half = c >> 8, t = c & 255; const f32x2 e = tab[((k * t) & 255) * 16];
        AC[i] = (bf16_t)f2bf(half ? -e.y * (1.f / 16.f) : e.x * (1.f / 16.f)); }
      bf16_t* DC = (bf16_t*)(F.ws + WS_SMALL + SM_DC);
      for (int i = gw * 64 + F.lane; i < 512 * 256; i += NGW * 64) { const int r = i >> 8, col = i & 255, p = r >> 8, g = (r >> 6) & 3, cp = r & 63, g2 = col >> 6, c = col & 63;
        const f32x2 e = tab[((c * cp) & 63) * 64]; DC[i] = (bf16_t)((g == g2) ? f2bf((p ? e.y : e.x) * 0.125f) : 0u); }
    }
    { bf16_t* LW = (bf16_t*)(F.ws + WS_SMALL + SM_LRUW);
      for (int i = gw * 64 + F.lane; i < 4 * 2 * 2 * 4 * 4096; i += NGW * 64) { const int k = i & 63, n = (i >> 6) & 63, blk = (i >> 12) & 3, gate = (i >> 14) & 1, ld = i >> 15;
        const float* src = (gate ? args.in[I_LWX] : args.in[I_LWA]) + ((size_t)(ld * 4 + blk) * 64 + k) * 64 + n; LW[i] = (bf16_t)f2bf(*src); } }
    if (F.vcu == 0 && F.wave == 0) { float* lamv = (float*)(F.ws + WS_SMALL + SM_LAM);
      for (int l = 0; l < DEPTH; ++l) { const float a = wave_sum(args.in[I_LQ1][l * 64 + F.lane] * args.in[I_LK1][l * 64 + F.lane]), b = wave_sum(args.in[I_LQ2][l * 64 + F.lane] * args.in[I_LK2][l * 64 + F.lane]);
        const float li = 0.8f - 0.6f * expf(-0.3f * (float)l); if (F.lane == 0) lamv[l] = expf(a) - expf(b) + li; } }
    __syncthreads();
}

__device__ __forceinline__ void ln_mod_store(const f32x4 (&v)[4], const float* md_sh, const float* md_sc, bf16_t* hrow, int lane) {
    float s = 0.f;
#pragma unroll
    for (int q = 0; q < 4; ++q) s += (v[q][0] + v[q][1]) + (v[q][2] + v[q][3]);
    const float mean = wave_sum(s) * (1.f / D); float s2 = 0.f; f32x4 d[4];
#pragma unroll
    for (int q = 0; q < 4; ++q) { d[q] = v[q] - mean; s2 += (d[q][0] * d[q][0] + d[q][1] * d[q][1]) + (d[q][2] * d[q][2] + d[q][3] * d[q][3]); }
    const float rstd = __builtin_amdgcn_rsqf(wave_sum(s2) * (1.f / D) + LN_EPS);
#pragma unroll
    for (int q = 0; q < 4; ++q) { const int col = 4 * lane + 256 * q; const f32x4 sh = *(const f32x4*)(md_sh + col), sc = *(const f32x4*)(md_sc + col);
        const f32x4 h = d[q] * rstd * (sc + 1.0f) + sh; u32x2 w; w.x = cvt_pk_bf16(h[0], h[1]); w.y = cvt_pk_bf16(h[2], h[3]); *(u32x2*)(hrow + col) = w; }
}
__device__ __forceinline__ void p0b(Frame& F, const Args& args) {
    const int gw = F.vcu * NWAVES + F.wave, NGW = F.G * NWAVES;
    bf16_t* H = (bf16_t*)(F.ws + WS_H); const float* mod = (const float*)(F.ws + WS_MOD);
#define SRCROW(mm) ((mm) < ML ? args.in[I_X] + (size_t)(mm) * D : args.in[I_CTX] + (size_t)((mm) - ML) * D)
    f32x4 vn[4];
    if (gw < M) {
#pragma unroll
        for (int q = 0; q < 4; ++q) vn[q] = *(const f32x4*)(SRCROW(gw) + 4 * F.lane + 256 * q); }
    for (int m = gw; m < M; m += NGW) { const int j = m < ML ? (m >> 12) : 16;
        f32x4 v[4], shp[4], scp[4]; const float* md = mod + (size_t)j * 6144;
#pragma unroll
        for (int q = 0; q < 4; ++q) { v[q] = vn[q]; shp[q] = *(const f32x4*)(md + 4 * F.lane + 256 * q); scp[q] = *(const f32x4*)(md + D + 4 * F.lane + 256 * q); }
        asm volatile("" ::: "memory");
        if (m + NGW < M) {
#pragma unroll
            for (int q = 0; q < 4; ++q) vn[q] = *(const f32x4*)(SRCROW(m + NGW) + 4 * F.lane + 256 * q); }
        asm volatile("" ::: "memory");
        float s = 0.f;
#pragma unroll
        for (int q = 0; q < 4; ++q) s += (v[q][0] + v[q][1]) + (v[q][2] + v[q][3]);
        const float mean = wave_sum(s) * (1.f / D); float s2 = 0.f;
#pragma unroll
        for (int q = 0; q < 4; ++q) { v[q] = v[q] - mean; s2 += (v[q][0] * v[q][0] + v[q][1] * v[q][1]) + (v[q][2] * v[q][2] + v[q][3] * v[q][3]); }
        const float rstd = __builtin_amdgcn_rsqf(wave_sum(s2) * (1.f / D) + LN_EPS);
#pragma unroll
        for (int q = 0; q < 4; ++q) { const f32x4 h = v[q] * rstd * (scp[q] + 1.0f) + shp[q]; u32x2 w; w.x = cvt_pk_bf16(h[0], h[1]); w.y = cvt_pk_bf16(h[2], h[3]); *(u32x2*)(H + (size_t)m * D + 4 * F.lane + 256 * q) = w; } }
#undef SRCROW
}

__device__ __forceinline__ void pw_item(const float* W, int N, unsigned char* WT, int ldt, LAS float* scr, int kb, int nb, int tid, float scale) {
    const int wave = tid >> 6, lane = tid & 63, k0 = 128 * kb, n0 = 256 * nb;
    const float* src = W + (size_t)(k0 + wave * 16) * N + n0 + lane * 4;
#pragma unroll
    for (int i = 0; i < 16; ++i) *(LAS f32x4*)(scr + (wave * 16 + i) * 260 + lane * 4) = *(const f32x4*)(src + (size_t)i * N);
    __syncthreads();
    const int n = tid & 255, kh = tid >> 8; const LAS float* s = scr + (64 * kh) * 260 + n; unsigned char* dst = WT + (size_t)(n0 + n) * ldt + k0 + 64 * kh;
#pragma unroll
    for (int h = 0; h < 4; ++h) { unsigned w[4];
#pragma unroll
        for (int g = 0; g < 4; ++g) { const LAS float* p = s + (16 * h + 4 * g) * 260; w[g] = cvt4_fp8(p[0] * scale, p[260] * scale, p[520] * scale, p[780] * scale); }
        *(u32x4*)(dst + 16 * h) = (u32x4){w[0], w[1], w[2], w[3]}; }
    __syncthreads();
}
__device__ __forceinline__ void pw_experts(Frame& F, const Args& args, int l) {
    LAS float* scr = (LAS float*)F.lds;
    unsigned char* WGU = F.ws + WS_WEXP; unsigned char* WDN = F.ws + WS_WDN;
    for (int it = F.vcu; it < NE * 192; it += F.G) { const int e = it / 192, r = it - e * 192, which = r >> 6, q = r & 63;
        if (which < 2) pw_item(args.in[which ? I_WU : I_WG] + ((size_t)l * NE + e) * D * FE, FE, WGU + ((size_t)e * 2 + which) * FE * D, D, scr, q >> 3, q & 7, F.tid, SWG8);
        else pw_item(args.in[I_WD] + ((size_t)l * NE + e) * FE * D, D, WDN + (size_t)e * D * FE, FE, scr, q >> 2, q & 3, F.tid, SWD8); }
}

__device__ __forceinline__ void pe_phase(Frame& F, const Args& args, int l, int nrows) {
    const int gw = F.vcu * NWAVES + F.wave, NGW = F.G * NWAVES;
    LAS f32x4* WR4 = (LAS f32x4*)F.lds;
    { const float* wr = args.in[I_WR] + (size_t)l * D * NE;
      for (int i = F.tid; i < 16 * 4 * 64; i += NTHR) { const int ln = i & 63, e4 = (i >> 6) & 3, qi = i >> 8, q = qi >> 2, ii = qi & 3; WR4[i] = *(const f32x4*)(wr + (size_t)(4 * ln + ii + 256 * q) * NE + 4 * e4); } }
    __syncthreads();
    float* X = (float*)(F.ws + WS_X); const bf16_t* MIX = (const bf16_t*)(F.ws + WS_ZR); unsigned char* H8 = F.ws + WS_H; float* SC = (float*)(F.ws + WS_SC);
    const float* mod = (const float*)(F.ws + WS_MOD) + (size_t)l * 17 * 6144;
    const float* g1p = args.in[I_LN1G] + l * D; const float* b1p = args.in[I_LN1B] + l * D;
    f32x4 xn[4]; u32x2 mn[4];
    const float* Xin0 = (l == 0) ? args.in[I_X] : X; const float* Xin1 = (l == 0) ? args.in[I_CTX] - (size_t)ML * D : X;
#define XROW(mm) (((mm) < ML ? Xin0 : Xin1) + (size_t)(mm) * D)
    if (gw < nrows) {
#pragma unroll
        for (int q = 0; q < 4; ++q) { const int col = 4 * F.lane + 256 * q; xn[q] = *(const f32x4*)(XROW(gw) + col); mn[q] = *(const u32x2*)(MIX + (size_t)gw * D + col); } }
    f32x4 g1r[4], b1r[4];
#pragma unroll
    for (int q = 0; q < 4; ++q) { g1r[q] = *(const f32x4*)(g1p + 4 * F.lane + 256 * q); b1r[q] = *(const f32x4*)(b1p + 4 * F.lane + 256 * q); }
    for (int m = gw; m < nrows; m += NGW) { const int j = m < ML ? (m >> 12) : 16; const float* md = mod + (size_t)j * 6144;
        f32x4 v[4], gm[4], sh2[4], sc2[4]; float s = 0.f;
#pragma unroll
        for (int q = 0; q < 4; ++q) { const int col = 4 * F.lane + 256 * q; gm[q] = *(const f32x4*)(md + 2 * D + col); }
#pragma unroll
        for (int q = 0; q < 4; ++q) { const int col = 4 * F.lane + 256 * q; sh2[q] = *(const f32x4*)(md + 3 * D + col); sc2[q] = *(const f32x4*)(md + 4 * D + col); }
#pragma unroll
        for (int q = 0; q < 4; ++q) { const f32x4 mx4 = (f32x4){bflo(mn[q].x), bfhi(mn[q].x), bflo(mn[q].y), bfhi(mn[q].y)};
            v[q] = xn[q] * DN_ALPHA + gm[q] * mx4; s += (v[q][0] + v[q][1]) + (v[q][2] + v[q][3]); }
        asm volatile("" ::: "memory");
        if (m + NGW < nrows) {
#pragma unroll
            for (int q = 0; q < 4; ++q) { const int col = 4 * F.lane + 256 * q; xn[q] = *(const f32x4*)(XROW(m + NGW) + col); mn[q] = *(const u32x2*)(MIX + (size_t)(m + NGW) * D + col); } }
        asm volatile("" ::: "memory");
        const float mean = wave_sum(s) * (1.f / D); float s2 = 0.f;
#pragma unroll
        for (int q = 0; q < 4; ++q) { v[q] = v[q] - mean; s2 += (v[q][0] * v[q][0] + v[q][1] * v[q][1]) + (v[q][2] * v[q][2] + v[q][3] * v[q][3]); }
        const float rstd = __builtin_amdgcn_rsqf(wave_sum(s2) * (1.f / D) + LN_EPS); s = 0.f;
#pragma unroll
        for (int q = 0; q < 4; ++q) { const int col = 4 * F.lane + 256 * q; v[q] = v[q] * rstd * g1r[q] + b1r[q]; *(f32x4*)(X + (size_t)m * D + col) = v[q];
            s += (v[q][0] + v[q][1]) + (v[q][2] + v[q][3]); }
        const float mean2 = wave_sum(s) * (1.f / D); s2 = 0.f;
#pragma unroll
        for (int q = 0; q < 4; ++q) { v[q] = v[q] - mean2; s2 += (v[q][0] * v[q][0] + v[q][1] * v[q][1]) + (v[q][2] * v[q][2] + v[q][3] * v[q][3]); }
        const float rstd2 = __builtin_amdgcn_rsqf(wave_sum(s2) * (1.f / D) + LN_EPS);
        float lg[16];
#pragma unroll
        for (int e = 0; e < 16; ++e) lg[e] = 0.f;
#pragma unroll
        for (int q = 0; q < 4; ++q) { const int col = 4 * F.lane + 256 * q;
            const f32x4 h = v[q] * rstd2 * (sc2[q] + 1.0f) + sh2[q]; *(unsigned*)(H8 + (size_t)m * D + col) = cvt4_fp8(clamp448(h[0] * SX8), clamp448(h[1] * SX8), clamp448(h[2] * SX8), clamp448(h[3] * SX8));
#pragma unroll
            for (int ii = 0; ii < 4; ++ii)
#pragma unroll
                for (int e4 = 0; e4 < 4; ++e4) { const f32x4 w4 = WR4[((q * 4 + ii) * 4 + e4) * 64 + F.lane];
#pragma unroll
                    for (int k = 0; k < 4; ++k) lg[e4 * 4 + k] += h[ii] * w4[k]; } }
        float r1[8], r2[4];
#pragma unroll
        for (int k = 0; k < 8; ++k) { const float ta = lg[k] + xor32f(lg[k], F.lane < 32), tb = lg[k + 8] + xor32f(lg[k + 8], F.lane < 32); r1[k] = (F.lane & 32) ? tb : ta; }
#pragma unroll
        for (int k = 0; k < 4; ++k) { const float ta = r1[k] + swz16f(r1[k]), tb = r1[k + 4] + swz16f(r1[k + 4]); r2[k] = (F.lane & 16) ? tb : ta; }
        float mx = -1e30f;
#pragma unroll
        for (int k = 0; k < 4; ++k) { float t = r2[k]; t += dppf<0xB1>(t); t += dppf<0x4E>(t); t += dppf<0x141>(t); t += dppf<0x140>(t); r2[k] = t; mx = fmaxf(mx, t); }
        mx = fmaxf(mx, swz16f(mx)); mx = fmaxf(mx, xor32f(mx, F.lane < 32));
        float se = 0.f;
#pragma unroll
        for (int k = 0; k < 4; ++k) { r2[k] = __expf(r2[k] - mx); se += r2[k]; }
        se += swz16f(se); se += xor32f(se, F.lane < 32);
        const float inv = 1.0f / se;
        if ((F.lane & 15) == 0) *(f32x4*)(SC + (size_t)m * NE + 4 * (F.lane >> 4)) = (f32x4){r2[0] * inv, r2[1] * inv, r2[2] * inv, r2[3] * inv}; }
#undef XROW
    __syncthreads();
}

__device__ __forceinline__ int block_sum_i(LAS int* red, int v, int wave, int lane) {
    v = wave_sum_i(v);
    if (lane == 0) red[wave] = v;
    __syncthreads();
    int s = 0;
#pragma unroll
    for (int w = 0; w < 8; ++w) s += red[w];
    return s;
}
__device__ __forceinline__ int lower_lanes(unsigned long long m) { return (int)__builtin_amdgcn_mbcnt_hi((unsigned)(m >> 32), __builtin_amdgcn_mbcnt_lo((unsigned)m, 0u)); }
__device__ __forceinline__ void topk_pair(Frame& F, const float* SC, int* TM, int m0, int n, int e, int cap, int yrow0, LAS int* sel, LAS int* red) {
    unsigned key[8];
#pragma unroll
    for (int k = 0; k < 8; ++k) { const int t = k * NTHR + F.tid; key[k] = (t < n) ? __builtin_bit_cast(unsigned, SC[(size_t)(m0 + t) * NE + e]) : 0u; }
    unsigned v = 0u; int it = 0;
    for (int shift = 28; shift >= -2; shift -= 3, ++it) { const int sh = shift < 0 ? 0 : shift; const unsigned jmax = shift < 0 ? 1u : 7u;
        int c[8];
#pragma unroll
        for (int j = 0; j < 8; ++j) c[j] = 0;
#pragma unroll
        for (int k = 0; k < 8; ++k) { const unsigned t = key[k] >= v ? min((key[k] - v) >> sh, jmax) : 0u;
#pragma unroll
            for (int j = 1; j < 8; ++j) c[j] += (t >= (unsigned)j) ? 1 : 0; }
        int pk[4];
#pragma unroll
        for (int q = 0; q < 4; ++q) pk[q] = wave_sum_i(c[2 * q] | (c[2 * q + 1] << 16));
        LAS int* rb = red + (it & 1) * 32;
        if (F.lane == 0) {
#pragma unroll
            for (int q = 0; q < 4; ++q) rb[F.wave * 4 + q] = pk[q]; }
        __syncthreads();
        int tot[4] = {0, 0, 0, 0};
#pragma unroll
        for (int w = 0; w < 8; ++w)
#pragma unroll
            for (int q = 0; q < 4; ++q) tot[q] += rb[w * 4 + q];
        unsigned best = 0u;
#pragma unroll
        for (int j = 1; j < 8; ++j) { const int cj = (j & 1) ? (tot[j >> 1] >> 16) : (tot[j >> 1] & 0xffff); if (cj >= cap && (unsigned)j <= jmax) best = (unsigned)j; }
        v |= best << sh; }
    LAS int* cgt = red + 64; LAS int* ceq = red + 64 + 64;
    __syncthreads();
    int lg[8], le[8];
#pragma unroll
    for (int k = 0; k < 8; ++k) { const unsigned long long mg = __builtin_amdgcn_ballot_w64(key[k] > v), me = __builtin_amdgcn_ballot_w64(key[k] == v);
        lg[k] = lower_lanes(mg); le[k] = lower_lanes(me);
        if (F.lane == 0) { cgt[k * 8 + F.wave] = __builtin_popcountll(mg); ceq[k * 8 + F.wave] = __builtin_popcountll(me); } }
    __syncthreads();
    int tot_gt = 0;
    for (int i = 0; i < 64; ++i) tot_gt += cgt[i];
    const int need_eq = cap - tot_gt;
    int gb = 0, eb = 0, idx = 0;
#pragma unroll
    for (int k = 0; k < 8; ++k) {
        for (; idx < k * 8 + F.wave; ++idx) { gb += cgt[idx]; eb += ceq[idx]; }
        const int t = k * NTHR + F.tid;
        if (t < n) { const bool gt = key[k] > v, eq = key[k] == v; const int myg = gb + lg[k], mye = eb + le[k];
            const bool selx = gt || (eq && mye < need_eq); const int slot = myg + (mye < need_eq ? mye : need_eq);
            if (selx) sel[slot] = m0 + t;
            TM[(size_t)(m0 + t) * NE + e] = selx ? (yrow0 + slot) : -1; } }
    __syncthreads();
}
__device__ __forceinline__ void pk_phase(Frame& F, bool with_ctx) {
    LAS int* sel = (LAS int*)F.lds; LAS int* red = sel + 512;
    const float* SC = (const float*)(F.ws + WS_SC); int* TM = (int*)(F.ws + WS_TM);
    int* IDXp = (int*)(F.ws + WS_IDX);
    for (int pr = F.vcu; pr < (with_ctx ? 512 : 256); pr += F.G) {
        const bool lat = pr < 256; const int q = lat ? pr : pr - 256, b = q >> 4, e = q & 15;
        const int cap = lat ? CAPL : CAPC, yrow0 = lat ? (e * 17 + b) * 512 : (e * 17 + 16) * 512 + b * CAPC;
        topk_pair(F, SC, TM, lat ? b * T : ML + b * TC, lat ? T : TC, e, cap, yrow0, sel, red);
        for (int s = F.tid; s < cap; s += NTHR) IDXp[yrow0 + s] = sel[s];
        __syncthreads(); }
}

__device__ __forceinline__ void pj_phase(Frame& F, const Args& args, int l, int nrows) {
    const int gw = F.vcu * NWAVES + F.wave, NGW = F.G * NWAVES; const bool last = (l == DEPTH - 1);
    float* X = (float*)(F.ws + WS_X); bf16_t* H = (bf16_t*)(F.ws + WS_H); const float* SC = (const float*)(F.ws + WS_SC); const int* TM = (const int*)(F.ws + WS_TM);
    const unsigned char* Y = F.ws + WS_ZR;
    const float* mod = (const float*)(F.ws + WS_MOD) + (size_t)l * 17 * 6144; const float* modn = mod + 17 * 6144;
    const float* g2p = args.in[I_LN2G] + l * D; const float* b2p = args.in[I_LN2B] + l * D;
    int tmn = -1; float scn = 0.f; f32x4 xnx[4];
    if (gw < nrows) { if (F.lane < 16) { tmn = TM[(size_t)gw * NE + F.lane]; scn = SC[(size_t)gw * NE + F.lane]; }
#pragma unroll
        for (int q = 0; q < 4; ++q) xnx[q] = *(const f32x4*)(X + (size_t)gw * D + 4 * F.lane + 256 * q); }
    f32x4 g2r[4], b2r[4];
#pragma unroll
    for (int q = 0; q < 4; ++q) { g2r[q] = *(const f32x4*)(g2p + 4 * F.lane + 256 * q); b2r[q] = *(const f32x4*)(b2p + 4 * F.lane + 256 * q); }
    for (int m = gw; m < nrows; m += NGW) { const int j = m < ML ? (m >> 12) : 16; const float* md = mod + (size_t)j * 6144; const float* mdn = modn + (size_t)j * 6144;
        const int tmv = tmn; const float scv = scn;
        f32x4 xr[4], g2m[4], shn[4], scq[4];
#pragma unroll
        for (int q = 0; q < 4; ++q) { xr[q] = xnx[q]; g2m[q] = *(const f32x4*)(md + 5 * D + 4 * F.lane + 256 * q); }
        if (!last) {
#pragma unroll
            for (int q = 0; q < 4; ++q) { shn[q] = *(const f32x4*)(mdn + 4 * F.lane + 256 * q); scq[q] = *(const f32x4*)(mdn + D + 4 * F.lane + 256 * q); } }
        unsigned long long mask = __builtin_amdgcn_ballot_w64(tmv >= 0);
        f32x4 a[4];
#pragma unroll
        for (int q = 0; q < 4; ++q) a[q] = (f32x4){0.f, 0.f, 0.f, 0.f};
        bool first = true;
        do {
            int yr[4]; float gg[4];
#pragma unroll
            for (int k = 0; k < 4; ++k) { if (mask) { const int e = __builtin_ctzll(mask); mask &= mask - 1; yr[k] = __builtin_amdgcn_readlane(tmv, e); gg[k] = __builtin_bit_cast(float, __builtin_amdgcn_readlane(__builtin_bit_cast(int, scv), e)); } else { yr[k] = 0; gg[k] = 0.f; } }
            unsigned w[4][4];
#pragma unroll
            for (int k = 0; k < 4; ++k)
#pragma unroll
                for (int q = 0; q < 4; ++q) w[k][q] = *(const unsigned*)(Y + (size_t)yr[k] * D + 4 * F.lane + 256 * q);
            asm volatile("" ::: "memory");
            if (first && m + NGW < nrows) { if (F.lane < 16) { tmn = TM[(size_t)(m + NGW) * NE + F.lane]; scn = SC[(size_t)(m + NGW) * NE + F.lane]; }
#pragma unroll
                for (int q = 0; q < 4; ++q) xnx[q] = *(const f32x4*)(X + (size_t)(m + NGW) * D + 4 * F.lane + 256 * q); }
            first = false;
            asm volatile("" ::: "memory");
#pragma unroll
            for (int k = 0; k < 4; ++k)
#pragma unroll
                for (int q = 0; q < 4; ++q) { const float gs = gg[k] * (1.0f / SY8); a[q][0] += gs * __builtin_amdgcn_cvt_f32_fp8((int)w[k][q], 0); a[q][1] += gs * __builtin_amdgcn_cvt_f32_fp8((int)w[k][q], 1); a[q][2] += gs * __builtin_amdgcn_cvt_f32_fp8((int)w[k][q], 2); a[q][3] += gs * __builtin_amdgcn_cvt_f32_fp8((int)w[k][q], 3); }
        } while (mask);
        f32x4 v[4]; float s = 0.f;
#pragma unroll
        for (int q = 0; q < 4; ++q) { v[q] = xr[q] * DN_ALPHA + g2m[q] * a[q]; s += (v[q][0] + v[q][1]) + (v[q][2] + v[q][3]); }
        const float mean = wave_sum(s) * (1.f / D); float s2 = 0.f;
#pragma unroll
        for (int q = 0; q < 4; ++q) { v[q] = v[q] - mean; s2 += (v[q][0] * v[q][0] + v[q][1] * v[q][1]) + (v[q][2] * v[q][2] + v[q][3] * v[q][3]); }
        const float rstd = __builtin_amdgcn_rsqf(wave_sum(s2) * (1.f / D) + LN_EPS);
        float* dst = last ? args.out + (size_t)m * D : X + (size_t)m * D; s = 0.f;
#pragma unroll
        for (int q = 0; q < 4; ++q) { const int col = 4 * F.lane + 256 * q; v[q] = v[q] * rstd * g2r[q] + b2r[q]; *(f32x4*)(dst + col) = v[q]; s += (v[q][0] + v[q][1]) + (v[q][2] + v[q][3]); }
        if (!last) { const float mean2 = wave_sum(s) * (1.f / D); s2 = 0.f;
#pragma unroll
            for (int q = 0; q < 4; ++q) { v[q] = v[q] - mean2; s2 += (v[q][0] * v[q][0] + v[q][1] * v[q][1]) + (v[q][2] * v[q][2] + v[q][3] * v[q][3]); }
            const float rstd2 = __builtin_amdgcn_rsqf(wave_sum(s2) * (1.f / D) + LN_EPS);
#pragma unroll
            for (int q = 0; q < 4; ++q) { const int col = 4 * F.lane + 256 * q; const f32x4 h = v[q] * rstd2 * (scq[q] + 1.0f) + shn[q]; u32x2 w; w.x = cvt_pk_bf16(h[0], h[1]); w.y = cvt_pk_bf16(h[2], h[3]); *(u32x2*)(H + (size_t)m * D + col) = w; } } }
}
constexpr int LRU_U = 0, LRU_SA = 33280, LRU_SI = LRU_SA + 32768, LRU_HS = LRU_SI + 32768;
static_assert(LRU_HS + 32768 + 5 * 256 * 4 <= PH_LDS, "lru lds");
constexpr int NCHUNK = 2048 + 128;
constexpr size_t WS_AX = WS_HM + 64 * MiB;
template <bool FINAL>
__device__ __forceinline__ void lru_phase(Frame& F, const Args& args, int l, int nunits) {
    const bf16_t* Z = (const bf16_t*)(F.ws + WS_ZR); bf16_t* CC = (bf16_t*)(F.ws + WS_CC);
    f32x2* SUMM = (f32x2*)(F.ws + WS_SUM); const float* CAR = (const float*)(F.ws + WS_CAR); unsigned* AX = (unsigned*)(F.ws + WS_AX);
    LAS float* U32 = (LAS float*)(F.lds + LRU_U); LAS float* SA = (LAS float*)(F.lds + LRU_SA); LAS float* SI = (LAS float*)(F.lds + LRU_SI); LAS float* HS = (LAS float*)(F.lds + LRU_HS);
    const int fr = F.lane & 15, fq = F.lane >> 4, dw = F.wave >> 2, blk = F.wave & 3;
    bf16x8 bw[2][4][2];
    { const bf16_t* LW = (const bf16_t*)(F.ws + WS_SMALL + SM_LRUW);
#pragma unroll
      for (int gate = 0; gate < 2; ++gate)
#pragma unroll
        for (int nt = 0; nt < 4; ++nt)
#pragma unroll
          for (int s = 0; s < 2; ++s) bw[gate][nt][s] = *(const bf16x8*)(LW + ((size_t)((((l * 2 + dw) * 2 + gate) * 4 + blk) * 64 + 16 * nt + fr)) * 64 + 32 * s + 8 * fq); }
    float gba[4], gbx[4], gsp[4];
#pragma unroll
    for (int nt = 0; nt < 4; ++nt) { const int ch = blk * 64 + 16 * nt + fr, o = (l * 2 + dw) * 256 + ch; gba[nt] = args.in[I_LBA][o]; gbx[nt] = args.in[I_LBX][o]; gsp[nt] = log1pf(expf(-args.in[I_LLAM][o])); }
    const float* cw = args.in[I_CONVW] + l * 4 * 256; const float* cb = args.in[I_CONVB] + l * 256;
    const int dt = F.tid >> 8, cht = F.tid & 255;
    const int ctt = F.tid >> 5, cch0 = (F.tid & 31) * 8;
    LAS float* CW = (LAS float*)(F.lds + LRU_HS + 32768);
    for (int i = F.tid; i < 5 * 256; i += NTHR) CW[i] = (i < 1024) ? cw[i] : cb[i - 1024];
    __syncthreads();
    u32x4 zr[2][4];
#define LRU_DECODE(u_, m0_, sl_, t0_) do { if ((u_) < 2048) { m0_ = ((u_) >> 7) * T; sl_ = T; t0_ = ((u_) & 127) * 32; } else { const int u2_ = (u_) - 2048; m0_ = ML + (u2_ >> 3) * TC; sl_ = TC; t0_ = (u2_ & 7) * 32; } } while (0)
#define LRU_ZLOAD(u_) do { int m0_, sl_, t0_; LRU_DECODE(u_, m0_, sl_, t0_); _Pragma("unroll") for (int hh = 0; hh < 2; ++hh) _Pragma("unroll") for (int j = 0; j < 4; ++j) { const int ts = t0_ + ctt + 16 * hh + j - 2; \
        zr[hh][j] = (ts >= 0 && ts < sl_) ? *(const u32x4*)(Z + (size_t)(m0_ + ts) * INW + 1536 + cch0) : (u32x4){0u, 0u, 0u, 0u}; } } while (0)
    if (F.vcu < nunits) LRU_ZLOAD(F.vcu);
    for (int uidx = F.vcu; uidx < nunits; uidx += F.G) {
        int m0, seqlen, t0; LRU_DECODE(uidx, m0, seqlen, t0);
        {
#pragma unroll
          for (int hh = 0; hh < 2; ++hh) { const int tk = ctt + 16 * hh; float u[8];
#pragma unroll
            for (int i = 0; i < 8; ++i) u[i] = CW[1024 + cch0 + i];
#pragma unroll
            for (int j = 0; j < 4; ++j) { const u32x4 z = zr[hh][j];
                    const f32x4 wa = *(const LAS f32x4*)(CW + j * 256 + cch0), wb = *(const LAS f32x4*)(CW + j * 256 + cch0 + 4);
                    u[0] += bflo(z.x) * wa[0]; u[1] += bfhi(z.x) * wa[1]; u[2] += bflo(z.y) * wa[2]; u[3] += bfhi(z.y) * wa[3];
                    u[4] += bflo(z.z) * wb[0]; u[5] += bfhi(z.z) * wb[1]; u[6] += bflo(z.w) * wb[2]; u[7] += bfhi(z.w) * wb[3]; }
            *(LAS f32x4*)(U32 + tk * 260 + cch0) = (f32x4){u[0], u[1], u[2], u[3]}; *(LAS f32x4*)(U32 + tk * 260 + cch0 + 4) = (f32x4){u[4], u[5], u[6], u[7]}; } }
        if (uidx + F.G < nunits) LRU_ZLOAD(uidx + F.G);
        __syncthreads();
        float h = FINAL ? CAR[(size_t)uidx * 512 + F.tid] : 0.f, P = 1.f;
#pragma unroll
        for (int j = 0; j < 2; ++j) {
            { const int sc = dw ? 1 - j : j;
              bf16x8 af[2];
#pragma unroll
              for (int s = 0; s < 2; ++s) { const LAS float* up = U32 + (16 * sc + fr) * 260 + blk * 64 + 32 * s + 8 * fq; const f32x4 x0 = *(const LAS f32x4*)up, x1 = *(const LAS f32x4*)(up + 4);
                  u32x4 w; w.x = cvt_pk_bf16(x0[0], x0[1]); w.y = cvt_pk_bf16(x0[2], x0[3]); w.z = cvt_pk_bf16(x1[0], x1[1]); w.w = cvt_pk_bf16(x1[2], x1[3]); af[s] = __builtin_bit_cast(bf16x8, w); }
#pragma unroll
              for (int nt = 0; nt < 4; ++nt) { f32x4 pa = (f32x4){0.f, 0.f, 0.f, 0.f}, px = pa;
#pragma unroll
                for (int s = 0; s < 2; ++s) { pa = __builtin_amdgcn_mfma_f32_16x16x32_bf16(af[s], bw[0][nt][s], pa, 0, 0, 0); px = __builtin_amdgcn_mfma_f32_16x16x32_bf16(af[s], bw[1][nt][s], px, 0, 0, 0); }
                const int ch = blk * 64 + 16 * nt + fr;
#pragma unroll
                for (int i = 0; i < 4; ++i) { const int tk = 4 * fq + i; const float e1 = 1.0f + __expf(-(pa[i] + gba[nt])), e2 = 1.0f + __expf(-(px[i] + gbx[nt])), t12 = __builtin_amdgcn_rcpf(e1 * e2), r = t12 * e2, ig = t12 * e1;
                    const float la = -8.0f * r * gsp[nt], a = __expf(la), mult = __builtin_amdgcn_sqrtf(fmaxf(1.0f - a * a, 0.f)), u = U32[(16 * sc + tk) * 260 + ch];
                    SA[tk * 512 + dw * 256 + ch] = a; SI[tk * 512 + dw * 256 + ch] = mult * ig * u; } } }
            __syncthreads();
            { const int sct = dt ? 1 - j : j;
#pragma unroll
              for (int k = 0; k < 16; ++k) { const int tk = dt ? 15 - k : k; const float a = SA[tk * 512 + F.tid], x = SI[tk * 512 + F.tid]; h = a * h + x; P *= a;
                  if (!FINAL) AX[(size_t)(m0 + t0 + 16 * sct + tk) * 512 + F.tid] = pk2(1.0f - a, x);
                  if (FINAL) { LAS float* hp = HS + (16 * sct + tk) * 256 + cht; *hp = (j == 0) ? h : *hp + h; } } }
            __syncthreads();
        }
        if (!FINAL) SUMM[(size_t)uidx * 512 + F.tid] = (f32x2){P, h};
        else { const int tok = F.tid >> 4, ch0 = (F.tid & 15) * 16; const size_t m = (size_t)(m0 + t0 + tok);
#pragma unroll
            for (int hh = 0; hh < 2; ++hh) { const u32x4 g = *(const u32x4*)(Z + m * INW + 1792 + ch0 + 8 * hh); const unsigned gw_[4] = {g.x, g.y, g.z, g.w}; float y[8];
#pragma unroll
                for (int i = 0; i < 8; ++i) { const float gv = (i & 1) ? bfhi(gw_[i >> 1]) : bflo(gw_[i >> 1]); const float ge = gv * fast_sigmoid(1.5957691216057308f * (gv + 0.044715f * gv * gv * gv));
                    y[i] = HS[tok * 256 + ch0 + 8 * hh + i] * ge; }
                u32x4 w; w.x = cvt_pk_bf16(y[0], y[1]); w.y = cvt_pk_bf16(y[2], y[3]); w.z = cvt_pk_bf16(y[4], y[5]); w.w = cvt_pk_bf16(y[6], y[7]);
                *(u32x4*)(CC + m * D + 512 + ch0 + 8 * hh) = w; }
            __syncthreads(); }
    }
}
#undef LRU_DECODE
#undef LRU_ZLOAD

__device__ __forceinline__ void lru_final(Frame& F, int nunits) {
    const bf16_t* Z = (const bf16_t*)(F.ws + WS_ZR); bf16_t* CC = (bf16_t*)(F.ws + WS_CC);
    const float* CAR = (const float*)(F.ws + WS_CAR); const unsigned* AX = (const unsigned*)(F.ws + WS_AX);
    LAS float* HF = (LAS float*)F.lds; LAS float* HB = HF + 32 * 256;
    const int dt = F.tid >> 8, cht = F.tid & 255;
    unsigned ax[32]; float hin = 0.f;
#define LF_DECODE(u_, m0_, t0_) do { if ((u_) < 2048) { m0_ = ((u_) >> 7) * T; t0_ = ((u_) & 127) * 32; } else { const int u2_ = (u_) - 2048; m0_ = ML + (u2_ >> 3) * TC; t0_ = (u2_ & 7) * 32; } } while (0)
#define LF_LOAD(u_) do { int m0_, t0_; LF_DECODE(u_, m0_, t0_); _Pragma("unroll") for (int k = 0; k < 32; ++k) ax[k] = AX[(size_t)(m0_ + t0_ + (dt ? 31 - k : k)) * 512 + F.tid]; hin = CAR[(size_t)(u_) * 512 + F.tid]; } while (0)
    if (F.vcu < nunits) LF_LOAD(F.vcu);
    for (int uidx = F.vcu; uidx < nunits; uidx += F.G) {
        int m0, t0; LF_DECODE(uidx, m0, t0);
        const int tok = F.tid >> 4, ch0 = (F.tid & 15) * 16; const size_t m = (size_t)(m0 + t0 + tok);
        const u32x4 g0 = *(const u32x4*)(Z + m * INW + 1792 + ch0), g1 = *(const u32x4*)(Z + m * INW + 1792 + ch0 + 8);
        float h = hin; LAS float* hp = (dt ? HB : HF) + cht;
#pragma unroll
        for (int k = 0; k < 32; ++k) { const int tk = dt ? 31 - k : k; const unsigned w = ax[k]; h = (1.0f - bflo(w)) * h + bfhi(w); hp[tk * 256] = h; }
        if (uidx + F.G < nunits) LF_LOAD(uidx + F.G);
        __syncthreads();
        { const unsigned gw_[8] = {g0.x, g0.y, g0.z, g0.w, g1.x, g1.y, g1.z, g1.w};
#pragma unroll
          for (int hh = 0; hh < 2; ++hh) { float y[8];
#pragma unroll
            for (int i = 0; i < 8; ++i) { const unsigned wv = gw_[4 * hh + (i >> 1)]; const float gv = (i & 1) ? bfhi(wv) : bflo(wv); const float ge = gv * fast_sigmoid(1.5957691216057308f * (gv + 0.044715f * gv * gv * gv));
                y[i] = (HF[tok * 256 + ch0 + 8 * hh + i] + HB[tok * 256 + ch0 + 8 * hh + i]) * ge; }
            u32x4 w; w.x = cvt_pk_bf16(y[0], y[1]); w.y = cvt_pk_bf16(y[2], y[3]); w.z = cvt_pk_bf16(y[4], y[5]); w.w = cvt_pk_bf16(y[6], y[7]);
            *(u32x4*)(CC + m * D + 512 + ch0 + 8 * hh) = w; } }
        __syncthreads();
    }
#undef LF_DECODE
#undef LF_LOAD
}
__device__ __forceinline__ void lru_carry(Frame& F) {
    const int gid = (F.vcu - (F.G - NB)) * NTHR + F.tid; if (gid < 0 || gid >= NB * 512) return;
    const f32x2* SUMM = (const f32x2*)(F.ws + WS_SUM); float* CAR = (float*)(F.ws + WS_CAR);
    const int b = gid >> 9, dch = gid & 511, d = dch >> 8; float h = 0.f;
#pragma unroll 1
    for (int s0 = 0; s0 < 136; s0 += 34) { f32x2 sm[34];
#pragma unroll
        for (int k = 0; k < 34; ++k) { const int s = s0 + k; const int ux = (s < 8) ? 2048 + b * 8 + (d ? 7 - s : s) : b * 128 + (d ? 127 - (s - 8) : (s - 8)); sm[k] = SUMM[(size_t)ux * 512 + dch]; }
#pragma unroll
        for (int k = 0; k < 34; ++k) { const int s = s0 + k; const int ux = (s < 8) ? 2048 + b * 8 + (d ? 7 - s : s) : b * 128 + (d ? 127 - (s - 8) : (s - 8)); CAR[(size_t)ux * 512 + dch] = h; h = sm[k].x * h + sm[k].y; } }
}

constexpr int CW_F2 = 232000;
constexpr int CW_BAR = 1024, NPH_L = 10, NPHASE = 2 + DEPTH * NPH_L;
__global__ void __launch_bounds__(NTHR, 2) fwd_kernel(Args args) {
    extern __shared__ __attribute__((aligned(16))) unsigned char lds_raw[];
    Frame F;
    F.lds = (LAS unsigned char*)lds_raw;
    int wave_s = __builtin_amdgcn_readfirstlane((int)threadIdx.x >> 6);
    F.tid = threadIdx.x; F.lane = F.tid & 63; F.wave = wave_s;
    F.G = gridDim.x; { const int bx = blockIdx.x; F.vcu = (F.G % 8 == 0) ? (bx % 8) * (F.G / 8) + bx / 8 : bx; }
    F.ws = args.ws;
    volatile LAS unsigned* MISC = (volatile LAS unsigned*)(F.lds + MISC_OFF);
    if (F.tid < 128) MISC[F.tid] = 0u;
    { LAS f32x2* rope = (LAS f32x2*)(F.lds + ROPE_OFF);
      for (int i = F.tid; i < 1024; i += NTHR) { const int pos = i >> 4, j = i & 15; const float inv = exp2f(-(float)j * (13.287712379549449f / 16.0f)); float s, c; sincosf((float)pos * inv, &s, &c); rope[i] = (f32x2){c, s}; } }
    __syncthreads();
    XcdBarrier bar = xcd_barrier_post((unsigned*)(F.ws + WS_CTL) + CW_BAR + args.li * XCD_BAR_WORDS, MISC + 8);
    const int lo = args.ph_lo, hi = args.ph_hi;
#ifndef PHMASK
#define PHMASK 0xFFFFFFFFu
#endif
#define IN(k) (lo <= (k) && (k) < hi)
#define ON(b) ((PHMASK >> (b)) & 1u)
#define SEAM(k) do { if (IN(k) && IN((k) + 1)) { XcdBarrier b2_ = bar; unsigned x_ = b2_.x; asm volatile("" : "+s"(x_)); b2_.x = x_; unsigned* p_ = b2_.bar; asm volatile("" : "+s"(p_)); b2_.bar = p_; xcd_barrier(b2_); } RELAUNDER(); } while (0)
#define RELAUNDER() do { asm volatile("" : "+s"(wave_s)); int l_ = lane_id(); asm volatile("" : "+v"(l_)); F.lane = l_; F.wave = wave_s; F.tid = wave_s * 64 + l_; int v_ = F.vcu; asm volatile("" : "+s"(v_)); F.vcu = v_; size_t z_ = 0; asm volatile("" : "+s"(z_)); F.ws = args.ws + z_;     } while (0)
    LAS unsigned char* lds = F.lds;
    if (IN(0)) p0a(F, args);
    SEAM(0);
    if (IN(1)) p0b(F, args);
    SEAM(1);
    for (int l = 0; l < DEPTH; ++l) {
        RELAUNDER();
        const int pb = 2 + l * NPH_L; const bool last = (l == DEPTH - 1); const int nrows = last ? ML : M;
        const char* wsb = (const char*)F.ws;
        if (IN(pb + 0)) {
            pg8::GemmP g{D, D, D, (size_t)128 * D * 2, (size_t)128 * D * 2};
            pg8::SchedPlain S{9, (M / 256) * 9, F.G, F.vcu, wsb + WS_H, wsb + WS_WIN + (size_t)l * INW * D * 2, (size_t)256 * D * 2, (size_t)256 * D * 2, true};
            pg8::EpiInProj E{(bf16_t*)(F.ws + WS_ZR), (const LAS f32x2*)(F.lds + ROPE_OFF)};
            pg8::gemm_phase<pg8::EpiInProj, pg8::SchedPlain, true>(lds, g, S, E, F.tid);
        }
        SEAM(pb + 0);
        if (IN(pb + 1)) lru_phase<false>(F, args, l, NCHUNK);
        if (IN(pb + 1)) {
            pg8::GemmP g{256, 256, INW, (size_t)128 * 256 * 2, (size_t)128 * INW * 2};
            pg8::SchedF1 S{2 * (nrows / 256), F.G, F.vcu, wsb + WS_SMALL + SM_DC, wsb + WS_ZR + 2048 * 2};
            pg8::EpiF1 E{(bf16_t*)(F.ws + WS_GT), (bf16_t*)(F.ws + WS_GTC)};
            pg8::gemm_phase<pg8::EpiF1, pg8::SchedF1, true>(lds, g, S, E, F.tid);
        }
        if (IN(pb + 1) && !last) {
            const float lam = ((const float*)(F.ws + WS_SMALL + SM_LAM))[l], gsc = 1.0f - (0.8f - 0.6f * expf(-0.3f * (float)l));
            int bx_ = blockIdx.x; asm volatile("" : "+s"(bx_)); float* o1s = (float*)(F.ws + WS_O1) + (size_t)bx_ * 32768;
            for (int u2 = F.G - 1 - F.vcu; u2 < 64; u2 += F.G) { const int b = u2 >> 2, h = u2 & 3, qrow0 = ML + b * TC;
                att::diff_attn_unit((const bf16_t*)(F.ws + WS_ZR), (bf16_t*)(F.ws + WS_CC), o1s, args.in[I_ANG] + l * 512, lam, gsc, qrow0, h, qrow0, 4, qrow0, 4, (LAS char*)lds, F.tid); }
            __syncthreads();
        }
        SEAM(pb + 1);
        if (IN(pb + 2)) lru_carry(F);
        if (IN(pb + 2) && !(F.vcu & 1)) { pw_experts(F, args, l); __syncthreads(); }
        if (IN(pb + 2)) {
            const float lam = ((const float*)(F.ws + WS_SMALL + SM_LAM))[l], gsc = 1.0f - (0.8f - 0.6f * expf(-0.3f * (float)l));
            int bx_ = blockIdx.x; asm volatile("" : "+s"(bx_)); float* o1s = (float*)(F.ws + WS_O1) + (size_t)bx_ * 32768;
            for (int u = F.vcu; u < 1024; u += F.G) {
                const int b = u >> 6, h = (u >> 4) & 3, qrow0 = b * T + (u & 15) * 256, seg0 = b * T, n0 = 64, seg1 = ML + b * TC, NT = 68;
                att::diff_attn_unit((const bf16_t*)(F.ws + WS_ZR), (bf16_t*)(F.ws + WS_CC), o1s, args.in[I_ANG] + l * 512, lam, gsc, qrow0, h, seg0, n0, seg1, NT, (LAS char*)lds, F.tid);
            }
            __syncthreads();
        }
        if (IN(pb + 2) && (F.vcu & 1)) pw_experts(F, args, l);
        SEAM(pb + 2);
        if (IN(pb + 3)) lru_final(F, last ? 2048 : NCHUNK);
        if (IN(pb + 3)) {
            { pg8::GemmP g{4096, 8192, 8192, (size_t)128 * 8192 * 2, (size_t)128 * 8192 * 2};
              pg8::SchedF2H S{F.G, F.vcu, wsb + WS_AT, wsb + WS_GT};
              pg8::EpiF2H E{(float*)(F.ws + WS_HM), (bf16_t*)(F.ws + WS_CC), (unsigned*)(F.ws + WS_CTL) + CW_F2, (unsigned)(l + 1)};
              pg8::gemm_phase<pg8::EpiF2H, pg8::SchedF2H, true>(lds, g, S, E, F.tid); }
            {
              const bf16_t* GT = (const bf16_t*)(F.ws + WS_GT); bf16_t* CC = (bf16_t*)(F.ws + WS_CC);
              for (int pr = F.vcu * NWAVES + F.wave; pr < NB * 256; pr += F.G * NWAVES) { const int b = pr >> 8, cp = pr & 255; const bf16_t* g = GT + ((size_t)(b * 256 + cp) * 2) * 4096 + F.lane * 64; float s = 0.f;
#pragma unroll
                  for (int q = 0; q < 8; ++q) { const u32x4 w = *(const u32x4*)(g + 8 * q); s += (bflo(w.x) - bfhi(w.x)) + (bflo(w.y) - bfhi(w.y)) + (bflo(w.z) - bfhi(w.z)) + (bflo(w.w) - bfhi(w.w)); }
                  s = wave_sum(s) * (1.0f / 64.0f); if (F.lane == 0) CC[(size_t)(b * T + T / 2) * D + 768 + cp] = (bf16_t)f2bf(s); } }
            if (!last) { pg8::GemmP g{512, 512, 512, (size_t)128 * 512 * 2, (size_t)128 * 512 * 2};
              pg8::SchedF2C S{F.G, F.vcu, wsb + WS_SMALL + SM_AC, wsb + WS_GTC};
              pg8::EpiBf16 E{(bf16_t*)(F.ws + WS_CC), D, 1.0f};
              pg8::gemm_phase<pg8::EpiBf16, pg8::SchedF2C, true>(lds, g, S, E, F.tid); }
        }
        SEAM(pb + 3);
        if (IN(pb + 4)) {
            pg8::GemmP g{D, D, D, (size_t)128 * D * 2, (size_t)128 * D * 2};
            pg8::SchedPlain S{4, (nrows / 256) * 4, F.G, F.vcu, wsb + WS_CC, wsb + WS_WOUT + (size_t)l * D * D * 2, (size_t)256 * D * 2, (size_t)256 * D * 2, false};
            pg8::EpiBf16 E{(bf16_t*)(F.ws + WS_ZR), D, 1.0f};
            pg8::gemm_phase<pg8::EpiBf16, pg8::SchedPlain, true>(lds, g, S, E, F.tid);
        }
        SEAM(pb + 4);
        if (IN(pb + 5)) pe_phase(F, args, l, nrows);
        SEAM(pb + 5);
        if (IN(pb + 6)) pk_phase(F, !last);
        SEAM(pb + 6);
        if (IN(pb + 7)) {
            pg8::GemmP g{D / 2, D / 2, D / 2, (size_t)128 * D, (size_t)FE * D};
            pg8::SchedGU S{last ? 32 : 34, F.G, F.vcu, wsb + WS_H, wsb + WS_WEXP, (const int*)(wsb + WS_IDX)};
            pg8::EpiGateUp E{F.ws + WS_HM};
            pg8::gemm_phase<pg8::EpiGateUp, pg8::SchedGU, true, true, true>(lds, g, S, E, F.tid);
        }
        SEAM(pb + 7);
        if (IN(pb + 8)) {
            pg8::GemmP g{FE / 2, FE / 2, FE / 2, (size_t)128 * FE, (size_t)128 * FE};
            pg8::SchedDN S{last ? 32 : 34, F.G, F.vcu, wsb + WS_HM, wsb + WS_WDN};
            pg8::EpiFp8 E{F.ws + WS_ZR, D, SY8 / (SH8 * SWD8)};
            pg8::gemm_phase<pg8::EpiFp8, pg8::SchedDN, true, true>(lds, g, S, E, F.tid);
        }
        SEAM(pb + 8);
        if (IN(pb + 9)) pj_phase(F, args, l, nrows);
        SEAM(pb + 9);
    }
#undef IN
#undef SEAM
}

#ifndef MK_PER_PHASE
#define MK_PER_PHASE 0
#endif
extern "C" void kernel_launch(void* const* d_in, const int* in_sizes, int n_in, void* d_out, int out_size, void* d_ws, size_t ws_size, hipStream_t stream) {
    static int grid = 0;
    if (grid == 0) {
        if (n_in != 28 || in_sizes[0] != ML * D || out_size != ML * D || ws_size < WS_END) { fprintf(stderr, "kernel_launch: unexpected shapes / workspace (n_in %d, ws %zu < %zu)\n", n_in, ws_size, (size_t)WS_END); grid = -1; return; }
        int dev = 0, cus = 0, per_cu = 0;
        if (hipGetDevice(&dev) != hipSuccess || hipDeviceGetAttribute(&cus, hipDeviceAttributeMultiprocessorCount, dev) != hipSuccess) { grid = -1; return; }
        if (hipFuncSetAttribute((const void*)fwd_kernel, hipFuncAttributeMaxDynamicSharedMemorySize, LDS_BYTES) != hipSuccess) { fprintf(stderr, "kernel_launch: hipFuncSetAttribute failed\n"); grid = -1; return; }
        if (hipOccupancyMaxActiveBlocksPerMultiprocessor(&per_cu, (const void*)fwd_kernel, NTHR, LDS_BYTES) != hipSuccess || per_cu < 1) { fprintf(stderr, "kernel_launch: occupancy query says %d\n", per_cu); }
        (void)hipGetLastError();
        grid = cus < 256 ? cus : 256;
    }
    if (grid < 0) return;
    if (hipMemsetAsync((char*)d_ws + WS_CTL, 0, CTL_ZERO_BYTES, stream) != hipSuccess) return;
    Args a{};
    for (int i = 0; i < 28; ++i) a.in[i] = (const float*)d_in[i];
    a.out = (float*)d_out; a.ws = (unsigned char*)d_ws;
#if MK_PER_PHASE
#ifdef DIAG
    hipMemsetAsync((char*)d_ws + WS_DIAG, 0, 256, stream);
#ifndef DIAG_L
#define DIAG_L 0
#endif
#ifndef DIAG_VAL
#define DIAG_VAL -1
#endif
#endif
    for (int p = 0; p < NPHASE; ++p) { a.ph_lo = p; a.ph_hi = p + 1; a.li = p; hipLaunchKernelGGL(fwd_kernel, dim3(grid), dim3(NTHR), LDS_BYTES, stream, a);
#ifdef DIAG
        const int l = (p - 2) / NPH_L, k = (p - 2) % NPH_L; int ids[2] = {-1, -1};
        if (p == 1) ids[0] = 0;
        if (p >= 2 && l == DIAG_L) { if (k == 0) ids[0] = 1; if (k == 2) ids[0] = 2; if (k == 3) { ids[0] = 3; ids[1] = 4; } if (k == 4) ids[0] = 5; if (k == 5) ids[0] = 6; if (k == 6) ids[0] = 7; if (k == 7) ids[0] = 8; if (k == 8) ids[0] = 9; }
        if (p >= 2 && l == 3 && k == 9) ids[0] = 10;
        for (int q = 0; q < 2; ++q) if (ids[q] >= 0) hipLaunchKernelGGL(chk_kernel, dim3(48), dim3(256), 0, stream, a, ids[q], ids[q] == 0 ? 0 : (ids[q] == 10 ? 3 : DIAG_L));
#endif
    }
#ifdef DIAG
    hipLaunchKernelGGL(fin_kernel, dim3(1), dim3(1), 0, stream, a, 16, DIAG_VAL);
#endif
#else
    a.ph_lo = 0; a.ph_hi = NPHASE; a.li = 0; hipLaunchKernelGGL(fwd_kernel, dim3(grid), dim3(NTHR), LDS_BYTES, stream, a);
#endif
}
```

```cpp
#include <hip/hip_runtime.h>
#include <cstdio>
#include <cstdint>

#define GAS __attribute__((address_space(1)))
#define LAS __attribute__((address_space(3)))
typedef unsigned short bf16_t;
typedef short bf16x8 __attribute__((ext_vector_type(8)));
typedef short s16x4 __attribute__((ext_vector_type(4)));
typedef float f32x4 __attribute__((ext_vector_type(4)));
typedef float f32x2 __attribute__((ext_vector_type(2)));
typedef float f32x16 __attribute__((ext_vector_type(16)));
typedef unsigned u32x4 __attribute__((ext_vector_type(4)));
typedef unsigned u32x2 __attribute__((ext_vector_type(2)));
typedef GAS unsigned gu32;
#define RLX_AGENT __ATOMIC_RELAXED, __HIP_MEMORY_SCOPE_AGENT
#define LDS_WAIT() asm volatile("s_waitcnt lgkmcnt(0)" ::: "memory")
#define VM_WAIT() asm volatile("s_waitcnt vmcnt(0)" ::: "memory")

constexpr int D = 1024, NB = 16, T = 4096, TC = 256, DEPTH = 4;
constexpr int ML = NB * T, MC = NB * TC, M = ML + MC;
constexpr int INW = 2304, NE = 16, FE = 2048;
constexpr int CAPL = 512, CAPC = 32;
constexpr int NPAIR = NE * 17;
constexpr float LN_EPS = 1e-5f, RMS_EPS = 1e-6f;
constexpr float DN_ALPHA = 1.6817928305074290f;
constexpr int NWAVES = 8, NTHR = 512;

constexpr size_t MiB = 1u << 20;
constexpr size_t WS_CTL = 0, CTL_ZERO_BYTES = 1 * MiB;
constexpr size_t WS_MOD = 1 * MiB;
constexpr size_t WS_SMALL = 3 * MiB;
constexpr size_t SM_LAM = 0, SM_LRUW = 4096, SM_DC = SM_LRUW + 4 * 2 * 2 * 4 * 4096 * 2, SM_AC = SM_DC + 512 * 256 * 2, SM_END = SM_AC + 256 * 512 * 2;
static_assert(SM_END <= 3 * MiB, "small region");
constexpr size_t WS_WIN = 6 * MiB;
constexpr size_t WS_WOUT = 24 * MiB;
constexpr size_t WS_AT = 32 * MiB;
constexpr size_t WS_WEXP = 96 * MiB;
constexpr size_t WS_WDN = WS_WEXP + 128 * MiB;
constexpr size_t WS_X = 288 * MiB;
constexpr size_t WS_H = 560 * MiB;
constexpr size_t WS_CC = 696 * MiB;
constexpr size_t WS_ZR = 832 * MiB;
constexpr size_t WS_O1 = 1138 * MiB;
constexpr size_t WS_GT = 1170 * MiB;
constexpr size_t WS_GTC = 1234 * MiB;
constexpr size_t WS_SC = 1238 * MiB;
constexpr size_t WS_TM = 1243 * MiB;
constexpr size_t WS_IDX = 1248 * MiB;
constexpr size_t WS_SUM = 1249 * MiB;
constexpr size_t WS_CAR = 1258 * MiB;
constexpr size_t WS_HM = 1270 * MiB;
constexpr size_t WS_END = 1814 * MiB;
static_assert(WS_HM + (size_t)NPAIR * 512 * FE * 2 <= WS_END, "ws map");
static_assert(WS_ZR + (size_t)M * INW * 2 <= WS_O1 && WS_ZR + (size_t)NPAIR * 512 * D * 2 <= WS_O1, "ws map zr");

constexpr int PH_LDS = 147456;
constexpr int ROPE_OFF = PH_LDS;
constexpr int MISC_OFF = ROPE_OFF + 8192;
constexpr int LDS_BYTES = MISC_OFF + 512;

__device__ __forceinline__ unsigned f2bf(float f) { unsigned u = __builtin_bit_cast(unsigned, f); return (u + 0x7fffu + ((u >> 16) & 1u)) >> 16; }
__device__ __forceinline__ unsigned pk2(float lo, float hi) { return f2bf(lo) | (f2bf(hi) << 16); }
__device__ __forceinline__ float bf2f(unsigned short h) { return __builtin_bit_cast(float, (unsigned)h << 16); }
__device__ __forceinline__ float bflo(unsigned w) { return __builtin_bit_cast(float, w << 16); }
__device__ __forceinline__ float bfhi(unsigned w) { return __builtin_bit_cast(float, w & 0xffff0000u); }
__device__ __forceinline__ unsigned cvt_pk_bf16(float lo, float hi) { unsigned r; asm volatile("v_cvt_pk_bf16_f32 %0, %1, %2" : "=v"(r) : "v"(lo), "v"(hi)); return r; }
typedef int v8i __attribute__((ext_vector_type(8)));
__device__ __forceinline__ float clamp448(float x) { return __builtin_amdgcn_fmed3f(x, -448.f, 448.f); }
__device__ __forceinline__ unsigned cvt4_fp8(float a, float b, float c, float d) { int w = 0; w = __builtin_amdgcn_cvt_pk_fp8_f32(a, b, w, false); w = __builtin_amdgcn_cvt_pk_fp8_f32(c, d, w, true); return (unsigned)w; }
__device__ __forceinline__ float fp8_dec(unsigned char b) { return __builtin_amdgcn_cvt_f32_fp8((int)b, 0); }
constexpr float SX8 = 16.f, SWG8 = 128.f, SH8 = 8.f, SWD8 = 512.f, SY8 = 64.f;
__device__ __forceinline__ float fast_sigmoid(float x) { return __builtin_amdgcn_rcpf(1.0f + __expf(-x)); }
__device__ __forceinline__ int lane_id() { int r; asm volatile("v_mbcnt_lo_u32_b32 %0, -1, 0\n\tv_mbcnt_hi_u32_b32 %0, -1, %0" : "=v"(r)); return r; }
template <int CTRL> __device__ __forceinline__ float dppf(float v) { return __builtin_bit_cast(float, __builtin_amdgcn_update_dpp(0, __builtin_bit_cast(int, v), CTRL, 0xF, 0xF, true)); }
template <int CTRL> __device__ __forceinline__ int dppi(int v) { return __builtin_amdgcn_update_dpp(0, v, CTRL, 0xF, 0xF, true); }
__device__ __forceinline__ float swz16f(float v) { return __builtin_bit_cast(float, __builtin_amdgcn_ds_swizzle(__builtin_bit_cast(int, v), 0x401F)); }
__device__ __forceinline__ float row32_sum(float v) {
    v += dppf<0xB1>(v); v += dppf<0x4E>(v); v += dppf<0x141>(v); v += dppf<0x140>(v); v += swz16f(v); return v; }
__device__ __forceinline__ void swap32(unsigned x, unsigned& r0, unsigned& r1) { unsigned y = x; asm volatile("" : "+v"(y)); auto r = __builtin_amdgcn_permlane32_swap(x, y, false, false); r0 = r[0]; r1 = r[1]; }
__device__ __forceinline__ float wave_sum(float v) {
    v = row32_sum(v); unsigned r0, r1; swap32(__builtin_bit_cast(unsigned, v), r0, r1);
    return __builtin_bit_cast(float, r0) + __builtin_bit_cast(float, r1);
}
__device__ __forceinline__ int wave_sum_i(int v) {
    v += dppi<0xB1>(v); v += dppi<0x4E>(v); v += dppi<0x141>(v); v += dppi<0x140>(v); v += __builtin_amdgcn_ds_swizzle(v, 0x401F);
    unsigned r0, r1; swap32((unsigned)v, r0, r1); return (int)r0 + (int)r1;
}
__device__ __forceinline__ float xor32f(float v, bool lo_half) { unsigned r0, r1; swap32(__builtin_bit_cast(unsigned, v), r0, r1); return __builtin_bit_cast(float, lo_half ? r1 : r0); }

#define XB_TMO      128
#define XB_XCNT(j)  (256  + 64 * (j))
#define XB_XSUB(j)  (1280 + 64 * (j))
#define XB_XGEN(j)  (2304 + 64 * (j))
#define XB_TOP      3328
#define XB_TOPGEN   3392
#define XCD_BAR_WORDS 3456
#define XB_SPIN_CAP (1u << 18)
__device__ __forceinline__ unsigned xb_ld(unsigned* p)              { return __hip_atomic_load(p, __ATOMIC_RELAXED, __HIP_MEMORY_SCOPE_AGENT); }
__device__ __forceinline__ unsigned xb_add(unsigned* p, unsigned v) { return __hip_atomic_fetch_add(p, v, __ATOMIC_RELAXED, __HIP_MEMORY_SCOPE_AGENT); }
__device__ __forceinline__ unsigned xb_xcc_id() { return (unsigned)__builtin_amdgcn_s_getreg((3 << 11) | 20) & 0xFu; }
#define XB_SPIN(cond, bar) do { unsigned _sp = 0; while (cond) { __builtin_amdgcn_s_sleep(1); \
    if ((++_sp & 255u) == 0u) { if (xb_ld(&(bar)[XB_TMO])) break; if (_sp > XB_SPIN_CAP) { atomicAdd(&(bar)[XB_TMO], 1u); break; } } } } while (0)
struct XcdBarrier { unsigned* bar; unsigned x; volatile LAS unsigned* st; };
__device__ __forceinline__ XcdBarrier xcd_barrier_post(unsigned* bar, volatile LAS unsigned* st) {
    XcdBarrier b; b.bar = bar; b.x = xb_xcc_id(); b.st = st;
    if (threadIdx.x == 0) (void)xb_add(&bar[XB_XCNT(b.x)], 1u);
    return b;
}
__device__ __forceinline__ void xcd_barrier_complete(unsigned* bar, unsigned x, unsigned& nloc, unsigned& nx) {
    const unsigned G = gridDim.x * gridDim.y * gridDim.z;
    unsigned sum, cnt, mine, sp = 0u;
    for (;;) {
        sum = 0u; cnt = 0u; mine = 0u;
#pragma unroll
        for (unsigned j = 0; j < 16; ++j) { const unsigned c = xb_ld(&bar[XB_XCNT(j)]); sum += c; cnt += (c > 0u) ? 1u : 0u; mine = (j == x) ? c : mine; }
        if (sum == G) break;
        __builtin_amdgcn_s_sleep(1);
        if ((++sp & 255u) == 0u) { if (xb_ld(&bar[XB_TMO])) break; if (sp > XB_SPIN_CAP) { atomicAdd(&bar[XB_TMO], 1u); break; } }
    }
    nloc = mine > 0u ? mine : 1u; nx = cnt > 0u ? cnt : 1u;
}
__device__ __forceinline__ void xcd_barrier(const XcdBarrier& b) {
    asm volatile("s_waitcnt vmcnt(0)" ::: "memory");
    __syncthreads();
    if (threadIdx.x == 0) {
        unsigned* bar = b.bar;
        __builtin_amdgcn_s_waitcnt(0);
        unsigned nloc = b.st[0], nx = b.st[1];
        if (nloc == 0u) { xcd_barrier_complete(bar, b.x, nloc, nx); b.st[0] = nloc; b.st[1] = nx; }
        const unsigned old = xb_add(&bar[XB_XSUB(b.x)], 1u);
        const unsigned gen = old / nloc;
        if (old + 1u == (gen + 1u) * nloc) {
            __builtin_amdgcn_fence(__ATOMIC_RELEASE, "agent");
            asm volatile("s_waitcnt vmcnt(0)" ::: "memory");
            const unsigned og = xb_add(&bar[XB_TOP], 1u);
            const unsigned tg = og / nx;
            if (og + 1u == (tg + 1u) * nx) xb_add(&bar[XB_TOPGEN], 1u);
            else XB_SPIN(xb_ld(&bar[XB_TOPGEN]) == tg, bar);
            __builtin_amdgcn_fence(__ATOMIC_ACQUIRE, "agent");
            xb_add(&bar[XB_XGEN(b.x)], 1u);
            asm volatile("s_waitcnt vmcnt(0)" ::: "memory");
        } else {
            XB_SPIN(xb_ld(&bar[XB_XGEN(b.x)]) == gen, bar);
            __builtin_amdgcn_fence(__ATOMIC_ACQUIRE, "agent");
            asm volatile("s_waitcnt vmcnt(0)" ::: "memory");
        }
    }
    __syncthreads();
}
namespace pg8 {
constexpr int BM = 256, BK = 64, HALF = 128, HTB = HALF * BK * 2, STAGE_BYTES = 8 * HTB;
__host__ __device__ __forceinline__ int lds_byte(int r, int c) { const int st = (r >> 4) * 2 + (c >> 5), rr = r & 15, cc = c & 31, ob = rr * 64 + cc * 2; return st * 1024 + (ob ^ (((ob >> 9) & 1) << 5)); }
__host__ __device__ __forceinline__ void stage_rc(int b, int& R, int& C) { const int st = b / 1024, sb = b % 1024, swz = sb ^ (((sb >> 9) & 1) << 5); R = (st >> 1) * 16 + swz / 64; C = (st & 1) * 32 + (swz % 64) / 2; }
__host__ __device__ __forceinline__ int perm32(int rho) { const int n = rho >> 4, i = rho & 15; return 8 * (i >> 2) + 4 * n + (i & 3); }

struct Unit { const char* a; const char* b; int orow, ocol; const int* idx; };
struct GemmP { int K; unsigned lda, ldb; size_t hstepA, hstepB; };

template <class Epi, class Sched, bool ALIGN_EPI, bool FP8 = false, bool GATHER = false>
__device__ __forceinline__ void gemm_phase(LAS unsigned char* lds, const GemmP g, const Sched& S, const Epi& E, int tid) {
    const int wid = __builtin_amdgcn_readfirstlane(tid >> 6), lane = tid & 63, wr = wid >> 2, wc = wid & 3, fr = lane & 15, fq = lane >> 4;
    const int K = g.K, nt = K / BK;
    unsigned voffA[2], voffB[2];
#pragma unroll
    for (int i = 0; i < 2; ++i) { int R, C; stage_rc(tid * 16 + i * 8192, R, C); const int Rb = Epi::PERM ? ((R & ~31) + perm32(R & 31)) : R;
        voffA[i] = (unsigned)(R * g.lda + C) * 2u; voffB[i] = (unsigned)(Rb * g.ldb + C) * 2u; }
    const size_t kstep = (size_t)(BK * 2);
    const size_t hA = GATHER ? (size_t)0 : g.hstepA, hB = g.hstepB;
    unsigned a0c[2], a1c[2], a0n[2], a1n[2]; int gR[2], gC[2];
#pragma unroll
    for (int i = 0; i < 2; ++i) { stage_rc(tid * 16 + i * 8192, gR[i], gC[i]); a0c[i] = a1c[i] = a0n[i] = a1n[i] = voffA[i]; }
#define PG8_IDX(u_, v0_, v1_) do { if constexpr (GATHER) { _Pragma("unroll") for (int _i = 0; _i < 2; ++_i) { v0_[_i] = (unsigned)(u_).idx[gR[_i]] * (g.lda * 2u) + (unsigned)gC[_i] * 2u; v1_[_i] = (unsigned)(u_).idx[128 + gR[_i]] * (g.lda * 2u) + (unsigned)gC[_i] * 2u; } } } while (0)
    const unsigned ldsw = (unsigned)wid * 1024u;
    const int aoff = FP8 ? lds_byte(wr * 64 + fr, (fq & 1) * 16) + (fq >> 1) * 1024 : lds_byte(wr * 64 + fr, fq * 8), boff = FP8 ? lds_byte(wc * 32 + fr, (fq & 1) * 16) + (fq >> 1) * 1024 : lds_byte(wc * 32 + fr, fq * 8);
#define PG8_SA(b, h) (((b) * 2 + (h)) * HTB)
#define PG8_SB(b, h) ((4 + (b) * 2 + (h)) * HTB)
#define PG8_STAGE(bufoff, gbase, voff) do { _Pragma("unroll") for (int _i = 0; _i < 2; ++_i) \
        __builtin_amdgcn_global_load_lds((const unsigned*)((const char*)(gbase) + (voff)[_i]), (LAS unsigned*)(lds + (bufoff) + ldsw + _i * 8192), 16, 0, 0); } while (0)
#define PG8_LD8(p_) ({ const u32x4 lo_ = *(const LAS u32x4*)(p_), hi_ = *(const LAS u32x4*)((p_) + 16); (v8i){(int)lo_.x, (int)lo_.y, (int)lo_.z, (int)lo_.w, (int)hi_.x, (int)hi_.y, (int)hi_.z, (int)hi_.w}; })
#define PG8_LDA(dst, b, h) do { if constexpr (FP8) { _Pragma("unroll") for (int m = 0; m < 4; ++m) dst##8[m] = PG8_LD8(lds + PG8_SA(b, h) + aoff + m * 2048); } \
        else { _Pragma("unroll") for (int m = 0; m < 4; ++m) _Pragma("unroll") for (int k = 0; k < 2; ++k) dst[m][k] = *(const LAS bf16x8*)(lds + PG8_SA(b, h) + aoff + m * 2048 + k * 1024); } } while (0)
#define PG8_LDB(dst, b, h) do { if constexpr (FP8) { _Pragma("unroll") for (int n = 0; n < 2; ++n) dst##8[n] = PG8_LD8(lds + PG8_SB(b, h) + boff + n * 2048); } \
        else { _Pragma("unroll") for (int n = 0; n < 2; ++n) _Pragma("unroll") for (int k = 0; k < 2; ++k) dst[n][k] = *(const LAS bf16x8*)(lds + PG8_SB(b, h) + boff + n * 2048 + k * 1024); } } while (0)
#define PG8_MMA(ai, bj, At, Bt) do { __builtin_amdgcn_s_setprio(1); if constexpr (FP8) { _Pragma("unroll") for (int m = 0; m < 4; ++m) _Pragma("unroll") for (int n = 0; n < 2; ++n) \
        asm volatile("v_mfma_f32_16x16x128_f8f6f4 %0, %1, %2, %0" : "+v"(acc[ai][bj][m][n]) : "v"(Bt##8[n]), "v"(At##8[m])); }   \
        else { _Pragma("unroll") for (int m = 0; m < 4; ++m) _Pragma("unroll") for (int n = 0; n < 2; ++n) _Pragma("unroll") for (int k = 0; k < 2; ++k) \
        acc[ai][bj][m][n] = __builtin_amdgcn_mfma_f32_16x16x32_bf16(Bt[n][k], At[m][k], acc[ai][bj][m][n], 0, 0, 0); } __builtin_amdgcn_s_setprio(0); } while (0)
#define PG8_WAIT_V(n) asm volatile("s_waitcnt vmcnt(" #n ")" ::: "memory")
#define PG8_WAIT_L(n) asm volatile("s_waitcnt lgkmcnt(" #n ")" ::: "memory")
#define PG8_BAR __builtin_amdgcn_s_barrier()
#define PG8_SCHED __builtin_amdgcn_sched_barrier(0)
    Unit cur, nxt; int ui = 0;
    if (!S.next(0, cur)) return;
    f32x4 acc[2][2][4][2];
#pragma unroll
    for (int a = 0; a < 2; ++a)
#pragma unroll
        for (int b = 0; b < 2; ++b)
#pragma unroll
            for (int m = 0; m < 4; ++m)
#pragma unroll
                for (int n = 0; n < 2; ++n) acc[a][b][m][n] = (f32x4){0.f, 0.f, 0.f, 0.f};
    bf16x8 At[4][2], B0[2][2], B1[2][2]; v8i At8[4], B08[2], B18[2];
    const char* cA = cur.a; const char* cB = cur.b;
    PG8_IDX(cur, a0c, a1c);
    PG8_STAGE(PG8_SB(0, 0), cB, voffB); PG8_STAGE(PG8_SB(0, 1), cB + hB, voffB); PG8_STAGE(PG8_SA(0, 0), cA, a0c); PG8_STAGE(PG8_SA(0, 1), cA + hA, a1c);
    if (wr == 1) PG8_BAR;
    PG8_WAIT_V(2); PG8_BAR;
    PG8_STAGE(PG8_SB(1, 0), cB + kstep, voffB); PG8_STAGE(PG8_SA(1, 0), cA + kstep, a0c); PG8_STAGE(PG8_SB(1, 1), cB + hB + kstep, voffB);
    PG8_WAIT_V(6); PG8_BAR;
    for (;;) {
        const bool has_next = S.next(ui + 1, nxt);
        const char* nA = has_next ? nxt.a : cA; const char* nB = has_next ? nxt.b : cB;
        if constexpr (GATHER) { if (has_next)
            __builtin_amdgcn_global_load_lds((const unsigned*)(nxt.idx + 4 * lane), (LAS unsigned*)(lds + STAGE_BYTES + wid * 1024), 16, 0, 0); }
#pragma unroll 1
        for (int t = 0; t < nt; t += 2) {
            const bool last = (t == nt - 2);
            const char* a1 = cA + (size_t)(t + 1) * kstep;
            const char* a2 = last ? nA : cA + (size_t)(t + 2) * kstep; const char* b2 = last ? nB : cB + (size_t)(t + 2) * kstep;
            const char* a3 = a2 + kstep; const char* b3 = b2 + kstep;
            PG8_LDB(B0, 0, 0); PG8_LDB(B1, 0, 1); PG8_SCHED; PG8_LDA(At, 0, 0); PG8_STAGE(PG8_SA(1, 1), a1 + hA, a1c);
            if constexpr (GATHER) { if (last && has_next) {
                { const LAS unsigned* ix = (const LAS unsigned*)(lds + STAGE_BYTES + wid * 1024); a0n[0] = ix[gR[0]]; a0n[1] = ix[gR[1]]; a1n[0] = ix[128 + gR[0]]; a1n[1] = ix[128 + gR[1]]; }
                a0c[0] = a0n[0] * (g.lda * 2u) + (unsigned)gC[0] * 2u; a0c[1] = a0n[1] * (g.lda * 2u) + (unsigned)gC[1] * 2u; a1c[0] = a1n[0] * (g.lda * 2u) + (unsigned)gC[0] * 2u; a1c[1] = a1n[1] * (g.lda * 2u) + (unsigned)gC[1] * 2u; } }
            PG8_WAIT_V(8); PG8_WAIT_L(0); PG8_BAR; PG8_MMA(0, 0, At, B0); PG8_MMA(0, 1, At, B1); PG8_BAR; PG8_SCHED;
            PG8_LDA(At, 0, 1); PG8_STAGE(PG8_SB(0, 0), b2, voffB); PG8_STAGE(PG8_SB(0, 1), b2 + hB, voffB); PG8_STAGE(PG8_SA(0, 0), a2, a0c);
            PG8_WAIT_V(8); PG8_WAIT_L(0); PG8_BAR; PG8_MMA(1, 0, At, B0); PG8_MMA(1, 1, At, B1); PG8_BAR; PG8_SCHED;
            PG8_LDB(B0, 1, 0); PG8_LDB(B1, 1, 1); PG8_SCHED; PG8_LDA(At, 1, 0); PG8_STAGE(PG8_SA(0, 1), a2 + hA, a1c);
            PG8_WAIT_V(8); PG8_WAIT_L(0); PG8_BAR; PG8_MMA(0, 0, At, B0); PG8_MMA(0, 1, At, B1); PG8_BAR; PG8_SCHED;
            PG8_LDA(At, 1, 1); PG8_STAGE(PG8_SB(1, 0), b3, voffB); PG8_STAGE(PG8_SB(1, 1), b3 + hB, voffB); PG8_STAGE(PG8_SA(1, 0), a3, a0c);
            PG8_WAIT_V(8); PG8_WAIT_L(0); PG8_BAR; PG8_MMA(1, 0, At, B0); PG8_MMA(1, 1, At, B1); PG8_BAR; PG8_SCHED;
        }
        if constexpr (ALIGN_EPI) { if (wr == 0) PG8_BAR; }
        if constexpr (FP8) asm volatile("s_nop 15\n\ts_nop 15" ::: "memory");
        { int fr_ = fr, fq_ = fq; asm volatile("" : "+v"(fr_), "+v"(fq_)); E(acc, cur, wr, wc, fr_, fq_); }
        if (!has_next) break;
#pragma unroll
        for (int a = 0; a < 2; ++a)
#pragma unroll
            for (int b = 0; b < 2; ++b)
#pragma unroll
                for (int m = 0; m < 4; ++m)
#pragma unroll
                    for (int n = 0; n < 2; ++n) acc[a][b][m][n] = (f32x4){0.f, 0.f, 0.f, 0.f};
        cur = nxt; cA = nA; cB = nB; ++ui;
        if constexpr (ALIGN_EPI) { if (wr == 1) PG8_BAR; }
    }
    PG8_WAIT_V(0);
    if constexpr (!ALIGN_EPI) { if (wr == 0) PG8_BAR; }
    PG8_BAR;
#undef PG8_SA
#undef PG8_SB
#undef PG8_STAGE
#undef PG8_LDA
#undef PG8_IDX
#undef PG8_LD8
#undef PG8_LDB
#undef PG8_MMA
#undef PG8_WAIT_V
#undef PG8_WAIT_L
#undef PG8_BAR
#undef PG8_SCHED
}

typedef const f32x4 (&AccRef)[2][2][4][2];
__device__ __forceinline__ u32x4 pack8(const f32x4 v0, const f32x4 v1) { u32x4 w; w.x = cvt_pk_bf16(v0[0], v0[1]); w.y = cvt_pk_bf16(v0[2], v0[3]); w.z = cvt_pk_bf16(v1[0], v1[1]); w.w = cvt_pk_bf16(v1[2], v1[3]); return w; }

struct EpiBf16 {
    static constexpr bool PERM = true;
    bf16_t* O; int ldc; float scale;
    __device__ __forceinline__ void operator()(AccRef acc, const Unit& u, int wr, int wc, int fr, int fq) const {
        const int row0 = u.orow + wr * 64 + fr, col0 = u.ocol + wc * 32 + 8 * fq;
#pragma unroll
        for (int ai = 0; ai < 2; ++ai)
#pragma unroll
            for (int m = 0; m < 4; ++m) { bf16_t* rowp = O + (size_t)(row0 + ai * HALF + m * 16) * ldc + col0;
#pragma unroll
                for (int bj = 0; bj < 2; ++bj) *(u32x4*)(rowp + bj * HALF) = pack8(acc[ai][bj][m][0] * scale, acc[ai][bj][m][1] * scale); }
    }
};
struct EpiFp8 {
    static constexpr bool PERM = true;
    unsigned char* O; int ldc; float scale;
    __device__ __forceinline__ void operator()(AccRef acc, const Unit& u, int wr, int wc, int fr, int fq) const {
        const int row0 = u.orow + wr * 64 + fr, col0 = u.ocol + wc * 32 + 8 * fq;
#pragma unroll
        for (int ai = 0; ai < 2; ++ai)
#pragma unroll
            for (int m = 0; m < 4; ++m) { unsigned char* rowp = O + (size_t)(row0 + ai * HALF + m * 16) * ldc + col0;
#pragma unroll
                for (int bj = 0; bj < 2; ++bj) { const f32x4 v0 = acc[ai][bj][m][0] * scale, v1 = acc[ai][bj][m][1] * scale; u32x2 w;
                    w.x = cvt4_fp8(clamp448(v0[0]), clamp448(v0[1]), clamp448(v0[2]), clamp448(v0[3])); w.y = cvt4_fp8(clamp448(v1[0]), clamp448(v1[1]), clamp448(v1[2]), clamp448(v1[3]));
                    *(u32x2*)(rowp + bj * HALF) = w; } }
    }
};
struct EpiInProj {
    static constexpr bool PERM = true;
    bf16_t* O; const LAS f32x2* rope;
    __device__ __forceinline__ void operator()(AccRef acc, const Unit& u, int wr, int wc, int fr, int fq) const {
        const int row0 = u.orow + wr * 64 + fr, col0 = u.ocol + wc * 32 + 8 * fq;
        const bool do_rope = (u.ocol < 1024) && (u.orow < ML);
        const float sgn = (fq < 2) ? -1.f : 1.f;
#pragma unroll
        for (int ai = 0; ai < 2; ++ai)
#pragma unroll
            for (int m = 0; m < 4; ++m) { const int row = row0 + ai * HALF + m * 16; bf16_t* rowp = O + (size_t)row * INW + col0;
                f32x2 cs[8];
                if (do_rope) { const int t = row & (T - 1); const int pos = (wc & 1) ? (t & 63) : (t >> 6);
                    const LAS f32x4* rp = (const LAS f32x4*)(rope + pos * 16 + 8 * (fq & 1));
#pragma unroll
                    for (int k = 0; k < 4; ++k) { const f32x4 q = rp[k]; cs[2 * k] = (f32x2){q[0], q[1]}; cs[2 * k + 1] = (f32x2){q[2], q[3]}; } }
#pragma unroll
                for (int bj = 0; bj < 2; ++bj) { f32x4 v0 = acc[ai][bj][m][0], v1 = acc[ai][bj][m][1];
                    if (do_rope) {
#pragma unroll
                        for (int k = 0; k < 4; ++k) { const float p0 = xor32f(v0[k], fq < 2), p1 = xor32f(v1[k], fq < 2);
                            v0[k] = v0[k] * cs[k].x + sgn * p0 * cs[k].y; v1[k] = v1[k] * cs[4 + k].x + sgn * p1 * cs[4 + k].y; } }
                    *(u32x4*)(rowp + bj * HALF) = pack8(v0, v1); } }
    }
};
struct EpiF32 {
    static constexpr bool PERM = false;
    float* C; int ldc;
    __device__ __forceinline__ void operator()(AccRef acc, const Unit& u, int wr, int wc, int fr, int fq) const {
        const int row0 = u.orow + wr * 64 + fr, col0 = u.ocol + wc * 32 + 4 * fq;
#pragma unroll
        for (int ai = 0; ai < 2; ++ai)
#pragma unroll
            for (int m = 0; m < 4; ++m) { float* rowp = C + (size_t)(row0 + ai * HALF + m * 16) * ldc + col0;
#pragma unroll
                for (int bj = 0; bj < 2; ++bj)
#pragma unroll
                    for (int n = 0; n < 2; ++n) *(f32x4*)(rowp + bj * HALF + n * 16) = acc[ai][bj][m][n]; }
    }
};
struct EpiGateUp {
    static constexpr bool PERM = true;
    unsigned char* O;
    __device__ __forceinline__ void operator()(AccRef acc, const Unit& u, int wr, int wc, int fr, int fq) const {
        const int row0 = u.orow + wr * 64 + fr, col0 = u.ocol + wc * 32 + 8 * fq; constexpr float sg = 1.0f / (SX8 * SWG8);
#pragma unroll
        for (int ai = 0; ai < 2; ++ai)
#pragma unroll
            for (int m = 0; m < 4; ++m) { unsigned char* rowp = O + (size_t)(row0 + ai * HALF + m * 16) * FE + col0;
                float h[8];
#pragma unroll
                for (int k = 0; k < 4; ++k) { const float g0 = acc[ai][0][m][0][k] * sg, g1 = acc[ai][0][m][1][k] * sg;
                    h[k] = clamp448(g0 * fast_sigmoid(g0) * acc[ai][1][m][0][k] * (sg * SH8)); h[4 + k] = clamp448(g1 * fast_sigmoid(g1) * acc[ai][1][m][1][k] * (sg * SH8)); }
                u32x2 w; w.x = cvt4_fp8(h[0], h[1], h[2], h[3]); w.y = cvt4_fp8(h[4], h[5], h[6], h[7]); *(u32x2*)rowp = w; }
    }
};
struct EpiF1 {
    static constexpr bool PERM = true;
    bf16_t* GT; bf16_t* GTC;
    __device__ __forceinline__ void operator()(AccRef acc, const Unit& u, int wr, int wc, int fr, int fq) const {
        const int p = u.orow >> 8, pn = u.ocol >> 8, c0 = wr * 64 + fr, t0 = wc * 32 + 8 * fq;
        bf16_t* base; int cs;
        if (pn < 256) { base = GT + ((size_t)(pn >> 4) << 21) + (size_t)p * 4096 + (pn & 15) * 256; cs = 8192; }
        else { base = GTC + (size_t)(pn - 256) * 131072 + p * 256; cs = 512; }
        bf16_t* lp = base + (size_t)c0 * cs + t0;
#pragma unroll
        for (int ai = 0; ai < 2; ++ai)
#pragma unroll
            for (int m = 0; m < 4; ++m) { bf16_t* rp = lp + (size_t)(ai * HALF + m * 16) * cs;
#pragma unroll
                for (int bj = 0; bj < 2; ++bj) *(u32x4*)(rp + bj * HALF) = pack8(acc[ai][bj][m][0], acc[ai][bj][m][1]); }
    }
};

struct EpiF2H {
    static constexpr bool PERM = true;
    float* PQ; bf16_t* CC; unsigned* flags; unsigned epoch;
    __device__ __forceinline__ void operator()(AccRef acc, const Unit& u, int wr, int wc, int fr, int fq) const {
        const int part = u.ocol, b = u.orow >> 3, pm8 = u.orow & 7;
        float* tile = PQ + (size_t)u.orow * 65536; const int r0 = wr * 64 + fr, c0 = wc * 32 + 8 * fq;
        if (part == 0) {
#pragma unroll
            for (int ai = 0; ai < 2; ++ai)
#pragma unroll
                for (int m = 0; m < 4; ++m) { float* rp = tile + (size_t)(r0 + ai * HALF + m * 16) * 256 + c0;
#pragma unroll
                    for (int bj = 0; bj < 2; ++bj) { *(f32x4*)(rp + bj * HALF) = acc[ai][bj][m][0]; *(f32x4*)(rp + bj * HALF + 4) = acc[ai][bj][m][1]; } }
            asm volatile("s_waitcnt vmcnt(0)" ::: "memory"); __builtin_amdgcn_s_barrier();
            if (threadIdx.x == 0) { __builtin_amdgcn_fence(__ATOMIC_RELEASE, "agent"); asm volatile("s_waitcnt vmcnt(0)" ::: "memory"); __hip_atomic_store(flags + u.orow * 64, epoch, __ATOMIC_RELAXED, __HIP_MEMORY_SCOPE_AGENT); }
        } else {
            if (threadIdx.x == 0) { unsigned sp = 0; while (__hip_atomic_load(flags + u.orow * 64, __ATOMIC_RELAXED, __HIP_MEMORY_SCOPE_AGENT) < epoch) { __builtin_amdgcn_s_sleep(2); if (++sp > (1u << 20)) break; }
                __builtin_amdgcn_fence(__ATOMIC_ACQUIRE, "agent"); asm volatile("s_waitcnt vmcnt(0)" ::: "memory"); }
            __builtin_amdgcn_s_barrier(); asm volatile("" ::: "memory");
#pragma unroll
            for (int ai = 0; ai < 2; ++ai)
#pragma unroll
                for (int m = 0; m < 4; ++m) { const int r = r0 + ai * HALF + m * 16, k = pm8 * 256 + r; const float* rp = tile + (size_t)r * 256 + c0;
                    bf16_t* y0 = CC + (size_t)(b * T + k) * D + 768 + c0; bf16_t* y1 = CC + (size_t)(b * T + (T - k)) * D + 768 + c0;
#pragma unroll
                    for (int bj = 0; bj < 2; ++bj) { const f32x4 p0 = __builtin_nontemporal_load((const f32x4*)(rp + bj * HALF)), p1 = __builtin_nontemporal_load((const f32x4*)(rp + bj * HALF + 4));
                        *(u32x4*)(y0 + bj * HALF) = pack8(p0 + acc[ai][bj][m][0], p1 + acc[ai][bj][m][1]);
                        if (k > 0) *(u32x4*)(y1 + bj * HALF) = pack8(p0 - acc[ai][bj][m][0], p1 - acc[ai][bj][m][1]); } }
        }
    }
};

struct SchedPlain {
    int nN, total, G, c; const char* A; const char* B; size_t tA, tB; bool grp8;
    __device__ __forceinline__ bool next(int i, Unit& u) const { const int L = i * G + c; if (L >= total) return false; int pm = L / nN, pn = L - pm * nN;
        if (grp8) { const int gsz = 8 * nN, gi = L / gsz, r = L - gi * gsz; pm = gi * 8 + (r & 7); pn = r >> 3; }
        u.a = A + (size_t)pm * tA; u.b = B + (size_t)pn * tB; u.orow = pm * BM; u.ocol = pn * BM; u.idx = nullptr; return true; }
};
struct SchedF1 {
    int total, G, c; const char* A; const char* B;
    __device__ __forceinline__ bool next(int i, Unit& u) const { const int L = i * G + c; if (L >= total) return false; const int pn = L >> 1, pm = L & 1;
        u.a = A + (size_t)pm * (256 * 256 * 2); u.b = B + (size_t)pn * (256 * (size_t)INW * 2); u.orow = pm * BM; u.ocol = pn * BM; u.idx = nullptr; return true; }
};
struct SchedF2L {
    int G, c; const char* AT; const char* GT;
    __device__ __forceinline__ bool next(int i, Unit& u) const { const int L = i * G + c; if (L >= 256) return false;
        int b = L >> 4, pm = L & 15; if (G == 256) { const int x = L >> 5, w = L & 31; pm = (x & 3) * 4 + (w & 3); b = (x >> 2) * 8 + (w >> 2); }
        u.a = AT + (size_t)pm * (256 * 8192 * 2); u.b = GT + (size_t)b * (256 * 8192 * 2); u.orow = b * T + pm * BM; u.ocol = 768; u.idx = nullptr; return true; }
};
struct SchedF2H {
    int G, c; const char* AT; const char* GT;
    __device__ __forceinline__ bool next(int i, Unit& u) const { const int L = i * G + c; if (L >= 256) return false;
        const int x = L >> 5, w = L & 31, part = w & 1, pm8 = (x & 1) * 4 + ((w >> 1) & 3), b = (x >> 1) * 4 + (w >> 3);
        u.a = AT + (size_t)pm8 * (256 * 8192 * 2) + (size_t)part * (4096 * 2); u.b = GT + (size_t)b * (256 * 8192 * 2) + (size_t)part * (4096 * 2); u.orow = b * 8 + pm8; u.ocol = part; u.idx = nullptr; return true; }
};
struct SchedF2C {
    int G, c; const char* AC; const char* GTC;
    __device__ __forceinline__ bool next(int i, Unit& u) const { const int L = i * G + c; if (L >= 16) return false;
        u.a = AC; u.b = GTC + (size_t)L * (256 * 512 * 2); u.orow = ML + L * TC; u.ocol = 768; u.idx = nullptr; return true; }
};
struct SchedGU {
    int nrt, G, c; const char* XS; const char* W; const int* IDX;
    __device__ __forceinline__ bool next(int i, Unit& u) const { const int L = i * G + c; if (L >= 16 * 16 * nrt) return false;
        const int e = L / (16 * nrt), r = L - e * 16 * nrt;
        const int gi = r >> 6, rr = r & 63, gsz = (nrt - 4 * gi) < 4 ? (nrt - 4 * gi) : 4, half = rr / (gsz * 8), w = rr - half * gsz * 8, rt = gi * 4 + w % gsz, ct = half * 8 + w / gsz;
        const int rowbase = (rt < 32) ? (e * 17 + (rt >> 1)) * 512 + (rt & 1) * 256 : (e * 17 + 16) * 512 + (rt - 32) * 256;
        u.a = XS; u.idx = IDX + rowbase; u.b = W + (size_t)e * (2 * FE * D) + (size_t)ct * (128 * D); u.orow = rowbase; u.ocol = ct * 128; return true; }
};
struct SchedDN {
    int nrt, G, c; const char* HM; const char* W;
    __device__ __forceinline__ bool next(int i, Unit& u) const { const int L = i * G + c; if (L >= 16 * 4 * nrt) return false;
        const int e = L / (4 * nrt), r = L - e * 4 * nrt, rt = r >> 2, ct = r & 3;
        const int rowbase = (rt < 32) ? (e * 17 + (rt >> 1)) * 512 + (rt & 1) * 256 : (e * 17 + 16) * 512 + (rt - 32) * 256;
        u.a = HM + (size_t)rowbase * FE; u.b = W + (size_t)e * (D * FE) + (size_t)ct * (256 * FE); u.orow = rowbase; u.ocol = ct * 256; u.idx = nullptr; return true; }
};
}
namespace att {
constexpr int NW = 8, QBLK = 32, KVBLK = 64, LDZ = INW;
constexpr float SCALE = 0.125f, THR = 8.f;
#ifndef ATT_SDEPTH
#define ATT_SDEPTH 2
#endif
constexpr int SDEPTH = ATT_SDEPTH;
constexpr int SHM_V = KVBLK * 128 * 2, SHM_K = KVBLK * 64 * 2;
#ifndef ATT_RING3
#define ATT_RING3 1
#endif
constexpr int NBUF = ATT_RING3 ? 3 : 2;
constexpr int OFF_V = 0, OFF_K = NBUF * SHM_V, OFF_WS = OFF_K + NBUF * SHM_K, ATT_LDS = OFF_WS + NW * 64 * 4;
#define KSWZ(row, colB) ((row) * 128 + ((colB) ^ ((((row) >> 1) & 7) << 4)))
#define SBAR() __builtin_amdgcn_sched_barrier(0)
__device__ __forceinline__ int crow(int r, int hi) { return (r & 3) + 8 * (r >> 2) + 4 * hi; }
__device__ __forceinline__ void partialSM(f32x16& p0, f32x16& p1, float& m_reg, float& mn, float& alpha) {
  constexpr float C = SCALE * 1.4426950408889634f;
  float pmax = p0[0];
#pragma unroll
  for (int r = 1; r < 16; ++r) pmax = fmaxf(pmax, p0[r]);
#pragma unroll
  for (int r = 0; r < 16; ++r) pmax = fmaxf(pmax, p1[r]);
  { unsigned r0, r1; swap32(__float_as_uint(pmax), r0, r1); pmax = fmaxf(__uint_as_float(r0), __uint_as_float(r1)); }
  if (__builtin_expect(__all(pmax - m_reg <= THR / SCALE), 1)) { mn = m_reg; alpha = 1.f; }
  else { mn = fmaxf(m_reg, pmax); alpha = __builtin_amdgcn_exp2f((m_reg - mn) * C); m_reg = mn; }
  float mnC = -mn * C;
#pragma unroll
  for (int r = 0; r < 16; ++r) p0[r] = fmaf(p0[r], C, mnC);
#pragma unroll
  for (int r = 0; r < 16; ++r) p1[r] = fmaf(p1[r], C, mnC);
#ifndef ABL_NOEXP
#pragma unroll
  for (int r = 0; r < 16; ++r) p0[r] = __builtin_amdgcn_exp2f(p0[r]);
#endif
}
__device__ __forceinline__ void finishSM(f32x16& p0, f32x16& p1, float alpha, float& l_reg, bf16x8& pa0, bf16x8& pa1, bf16x8& pa2, bf16x8& pa3) {
#ifndef ABL_NOEXP
#pragma unroll
  for (int r = 0; r < 16; ++r) p1[r] = __builtin_amdgcn_exp2f(p1[r]);
#endif
  float ps = 0;
#pragma unroll
  for (int r = 0; r < 16; ++r) ps += p0[r];
#pragma unroll
  for (int r = 0; r < 16; ++r) ps += p1[r];
  { unsigned r0, r1; swap32(__float_as_uint(ps), r0, r1); ps = __uint_as_float(r0) + __uint_as_float(r1); }
  l_reg = l_reg * alpha + ps;
#define PK4(P, BASE, OUT) do { unsigned a0 = cvt_pk_bf16(P[BASE + 0], P[BASE + 1]), a1 = cvt_pk_bf16(P[BASE + 2], P[BASE + 3]);   \
    unsigned b0 = cvt_pk_bf16(P[BASE + 4], P[BASE + 5]), b1 = cvt_pk_bf16(P[BASE + 6], P[BASE + 7]);                              \
    auto r0 = __builtin_amdgcn_permlane32_swap(a0, b0, false, false); auto r1 = __builtin_amdgcn_permlane32_swap(a1, b1, false, false); \
    u32x4 w = {r0[0], r1[0], r0[1], r1[1]}; OUT = __builtin_bit_cast(bf16x8, w); } while (0)
  PK4(p0, 0, pa0); PK4(p0, 8, pa1); PK4(p1, 0, pa2); PK4(p1, 8, pa3);
#undef PK4
}
__device__ __forceinline__ void qkt(f32x16& p0, f32x16& p1, const LAS char* Ks, const bf16x8* qr, int r32, int hi) {
#pragma unroll
  for (int r = 0; r < 16; ++r) { p0[r] = 0.f; p1[r] = 0.f; }
#pragma unroll
  for (int d0 = 0; d0 < 4; ++d0) { const int cb = (d0 * 16 + hi * 8) * 2;
    bf16x8 b0 = *(const LAS bf16x8*)(Ks + KSWZ(r32, cb));
    bf16x8 b1 = *(const LAS bf16x8*)(Ks + KSWZ(32 + r32, cb));
    p0 = __builtin_amdgcn_mfma_f32_32x32x16_bf16(b0, qr[d0], p0, 0, 0, 0);
    p1 = __builtin_amdgcn_mfma_f32_32x32x16_bf16(b1, qr[d0], p1, 0, 0, 0); }
}
__device__ __forceinline__ int v_st(int k, int c) { const int kk = (k & ~0xC) | ((k & 4) << 1) | ((k & 8) >> 1); return ((kk >> 3) * 4 + (c >> 5)) * 512 + ((kk & 7) * 32 + (c & 31)) * 2; }
__device__ __forceinline__ int v_rd_base(int lane) { return ((lane & 3) << 3) | (((lane >> 2) & 3) << 6) | (((lane >> 4) & 1) << 5) | (((lane >> 5) & 1) << 8); }
constexpr int v_rd_off(int d0, int ks, int half) { return d0 * 512 + ks * 4096 + half * 2048; }
template <int OFF> __device__ __forceinline__ s16x4 tr_read(int vb) {
  s16x4 r; asm volatile("ds_read_b64_tr_b16 %0, %1 offset:%2" : "=&v"(r) : "v"(vb), "i"(OFF) : "memory"); return r;
}
template <int D0> __device__ __forceinline__ void pv_one(f32x16& od, int vb, bf16x8 pa0, bf16x8 pa1, bf16x8 pa2, bf16x8 pa3) {
  const s16x4 l0 = tr_read<v_rd_off(D0, 0, 0)>(vb), h0 = tr_read<v_rd_off(D0, 0, 1)>(vb), l1 = tr_read<v_rd_off(D0, 1, 0)>(vb), h1 = tr_read<v_rd_off(D0, 1, 1)>(vb);
  const s16x4 l2 = tr_read<v_rd_off(D0, 2, 0)>(vb), h2 = tr_read<v_rd_off(D0, 2, 1)>(vb), l3 = tr_read<v_rd_off(D0, 3, 0)>(vb), h3 = tr_read<v_rd_off(D0, 3, 1)>(vb);
  asm volatile("s_waitcnt lgkmcnt(0)" ::: "memory"); SBAR();
#define PK(L, H) (bf16x8){L[0], L[1], L[2], L[3], H[0], H[1], H[2], H[3]}
  od = __builtin_amdgcn_mfma_f32_32x32x16_bf16(pa0, PK(l0, h0), od, 0, 0, 0);
  od = __builtin_amdgcn_mfma_f32_32x32x16_bf16(pa1, PK(l1, h1), od, 0, 0, 0);
  od = __builtin_amdgcn_mfma_f32_32x32x16_bf16(pa2, PK(l2, h2), od, 0, 0, 0);
  od = __builtin_amdgcn_mfma_f32_32x32x16_bf16(pa3, PK(l3, h3), od, 0, 0, 0);
#undef PK
}
__device__ __forceinline__ void pv_d0(f32x16* o, int vb, bf16x8 pa0, bf16x8 pa1, bf16x8 pa2, bf16x8 pa3) {
  pv_one<0>(o[0], vb, pa0, pa1, pa2, pa3); pv_one<1>(o[1], vb, pa0, pa1, pa2, pa3); pv_one<2>(o[2], vb, pa0, pa1, pa2, pa3); pv_one<3>(o[3], vb, pa0, pa1, pa2, pa3);
}

__device__ __forceinline__ void diff_attn_unit(const bf16_t* __restrict__ Z, bf16_t* __restrict__ CC, float* o1s, const float* __restrict__ gvec, float lam, float gsc,
                                               int qrow0, int h, int seg0, int n0, int seg1, int NT, LAS char* lds, int tid) {
  asm volatile("" : "+v"(tid));
  const int wid = tid >> 6, lane = tid & 63, r32 = lane & 31, hi = lane >> 5;
  LAS char* V_lds = lds + OFF_V; LAS char* K_lds = lds + OFF_K;
  LAS float* ws = (LAS float*)(lds + OFF_WS) + wid * 64; LAS float* li_l = ws; LAS float* al_l = ws + 32;
  const int sr = tid >> 4, sc = (tid & 15) * 8, vst0 = v_st(sr, sc), vst1 = v_st(32 + sr, sc);
  const int kr = tid >> 3, kc = (tid & 7) * 8, kst = KSWZ(kr, kc * 2);
  const int vb0 = (int)(uintptr_t)V_lds + v_rd_base(lane);
  const bf16_t* Vcol = Z + 1024 + h * 128 + sc;
  for (int mp = 0; mp < 2; ++mp) {
    __syncthreads();
    const bf16_t* Kcol = Z + 512 + h * 128 + mp * 64 + kc;
    float m_reg = -1e30f, l_reg = 0; f32x16 o[4]; bf16x8 qr[4];
#pragma unroll
    for (int d = 0; d < 4; ++d)
#pragma unroll
      for (int r = 0; r < 16; ++r) o[d][r] = 0.f;
    const bf16_t* Qw = Z + (size_t)(qrow0 + wid * QBLK + r32) * LDZ + h * 128 + mp * 64 + hi * 8;
#pragma unroll
    for (int d0 = 0; d0 < 4; ++d0) qr[d0] = *(const bf16x8*)(Qw + d0 * 16);
    struct { bf16x8 vs0, vs1, ks; } sr_[SDEPTH];
#define TROW(j) ((j) < n0 ? seg0 + (j) * KVBLK : seg1 + ((j) - n0) * KVBLK)
#define SLOAD(i, j) do { const int _k0 = TROW(j); sr_[i].vs0 = *(const bf16x8*)(Vcol + (size_t)(_k0 + sr) * LDZ); sr_[i].vs1 = *(const bf16x8*)(Vcol + (size_t)(_k0 + 32 + sr) * LDZ); \
    sr_[i].ks = *(const bf16x8*)(Kcol + (size_t)(_k0 + kr) * LDZ); } while (0)
#define SWRITE(b, i) do { *(LAS bf16x8*)(V_lds + (b) * SHM_V + vst0) = sr_[i].vs0; *(LAS bf16x8*)(V_lds + (b) * SHM_V + vst1) = sr_[i].vs1; \
    *(LAS bf16x8*)(K_lds + (b) * SHM_K + kst) = sr_[i].ks; } while (0)
#define SWAIT() do { if constexpr (SDEPTH == 2) asm volatile("s_waitcnt vmcnt(3)" ::: "memory"); else asm volatile("s_waitcnt vmcnt(0)" ::: "memory"); } while (0)
#define RESC(a) do { if (__any((a) < 1.f)) { if (hi == 0) al_l[r32] = (a); asm volatile("s_waitcnt lgkmcnt(0)" ::: "memory"); \
    _Pragma("unroll") for (int d = 0; d < 4; ++d) _Pragma("unroll") for (int r = 0; r < 16; ++r) o[d][r] *= al_l[crow(r, hi)]; } } while (0)
    f32x16 pA0, pA1, pB0, pB1; float mnA, mnB, alA, alB; bf16x8 pa0, pa1, pa2, pa3;
    constexpr int SE = 0, SO = SDEPTH - 1;
    SLOAD(SE, 0); asm volatile("s_waitcnt vmcnt(0)" ::: "memory"); SWRITE(0, SE); __syncthreads();
    qkt(pA0, pA1, K_lds, qr, r32, hi); partialSM(pA0, pA1, m_reg, mnA, alA);
    SLOAD(SO, 1); if constexpr (SDEPTH == 2) { if (2 < NT) SLOAD(SE, 2); }
    SWAIT(); SWRITE(1, SO); __syncthreads();
#if ATT_RING3
    int b0 = 0, b1 = 1, b2 = 2;
    for (int j = 1; j + 1 < NT; j += 2) {
      SBAR(); qkt(pB0, pB1, K_lds + b1 * SHM_K, qr, r32, hi);
      finishSM(pA0, pA1, alA, l_reg, pa0, pa1, pa2, pa3); SBAR();
      SLOAD(SO, j + SDEPTH); SBAR();
      pv_d0(o, vb0 + b0 * SHM_V, pa0, pa1, pa2, pa3); partialSM(pB0, pB1, m_reg, mnB, alB);
      SWAIT(); SWRITE(b2, SE);
      RESC(alB); __syncthreads();
      SBAR(); qkt(pA0, pA1, K_lds + b2 * SHM_K, qr, r32, hi);
      finishSM(pB0, pB1, alB, l_reg, pa0, pa1, pa2, pa3); SBAR();
      if (SDEPTH == 1 || j + 3 < NT) SLOAD(SE, j + 1 + SDEPTH); SBAR();
      pv_d0(o, vb0 + b1 * SHM_V, pa0, pa1, pa2, pa3); partialSM(pA0, pA1, m_reg, mnA, alA);
      SWAIT(); SWRITE(b0, SO);
      RESC(alA); __syncthreads();
      { const int t0_ = b0; b0 = b2; b2 = b1; b1 = t0_; }
    }
    SBAR(); qkt(pB0, pB1, K_lds + b1 * SHM_K, qr, r32, hi);
    finishSM(pA0, pA1, alA, l_reg, pa0, pa1, pa2, pa3); SBAR();
    pv_d0(o, vb0 + b0 * SHM_V, pa0, pa1, pa2, pa3); partialSM(pB0, pB1, m_reg, mnB, alB);
    RESC(alB);
    finishSM(pB0, pB1, alB, l_reg, pa0, pa1, pa2, pa3); SBAR();
    pv_d0(o, vb0 + b1 * SHM_V, pa0, pa1, pa2, pa3);
#else
    for (int j = 1; j + 1 < NT; j += 2) {
      SBAR(); qkt(pB0, pB1, K_lds + SHM_K, qr, r32, hi);
      finishSM(pA0, pA1, alA, l_reg, pa0, pa1, pa2, pa3); SBAR();
      SLOAD(SO, j + SDEPTH); SBAR();
      pv_d0(o, vb0, pa0, pa1, pa2, pa3); partialSM(pB0, pB1, m_reg, mnB, alB);
      __syncthreads(); SWAIT(); SWRITE(0, SE);
      RESC(alB); __syncthreads();
      SBAR(); qkt(pA0, pA1, K_lds, qr, r32, hi);
      finishSM(pB0, pB1, alB, l_reg, pa0, pa1, pa2, pa3); SBAR();
      if (SDEPTH == 1 || j + 3 < NT) SLOAD(SE, j + 1 + SDEPTH); SBAR();
      pv_d0(o, vb0 + SHM_V, pa0, pa1, pa2, pa3); partialSM(pA0, pA1, m_reg, mnA, alA);
      __syncthreads(); SWAIT(); SWRITE(1, SO);
      RESC(alA); __syncthreads();
    }
    SBAR(); qkt(pB0, pB1, K_lds + SHM_K, qr, r32, hi);
    finishSM(pA0, pA1, alA, l_reg, pa0, pa1, pa2, pa3); SBAR();
    pv_d0(o, vb0, pa0, pa1, pa2, pa3); partialSM(pB0, pB1, m_reg, mnB, alB);
    __syncthreads(); RESC(alB);
    finishSM(pB0, pB1, alB, l_reg, pa0, pa1, pa2, pa3); SBAR();
    pv_d0(o, vb0 + SHM_V, pa0, pa1, pa2, pa3);
#endif
    if (hi == 0) li_l[r32] = l_reg; asm volatile("s_waitcnt lgkmcnt(0)" ::: "memory");
    float rli[16];
#pragma unroll
    for (int r = 0; r < 16; ++r) rli[r] = __builtin_amdgcn_rcpf(li_l[crow(r, hi)]);
    float* op = o1s + tid * 64;
    if (mp == 0) {
#pragma unroll
      for (int d0 = 0; d0 < 4; ++d0)
#pragma unroll
        for (int r4 = 0; r4 < 4; ++r4) *(f32x4*)(op + d0 * 16 + r4 * 4) = (f32x4){o[d0][4 * r4] * rli[4 * r4], o[d0][4 * r4 + 1] * rli[4 * r4 + 1], o[d0][4 * r4 + 2] * rli[4 * r4 + 2], o[d0][4 * r4 + 3] * rli[4 * r4 + 3]};
    } else {
      float ss[16];
#pragma unroll
      for (int r = 0; r < 16; ++r) ss[r] = 0.f;
#pragma unroll
      for (int d0 = 0; d0 < 4; ++d0)
#pragma unroll
        for (int r4 = 0; r4 < 4; ++r4) { const f32x4 o1 = __builtin_nontemporal_load((const f32x4*)(op + d0 * 16 + r4 * 4));
#pragma unroll
          for (int k = 0; k < 4; ++k) { const int r = 4 * r4 + k; const float v = o1[k] - lam * (o[d0][r] * rli[r]); o[d0][r] = v; ss[r] += v * v; } }
#pragma unroll
      for (int r = 0; r < 16; ++r) {
        ss[r] = row32_sum(ss[r]);
        ss[r] = __builtin_amdgcn_rsqf(ss[r] * (1.0f / 128.0f) + RMS_EPS) * gsc; }
      float gg[4];
#pragma unroll
      for (int d0 = 0; d0 < 4; ++d0) gg[d0] = gvec[h * 128 + d0 * 32 + r32];
      bf16_t* Ow = CC + (size_t)(qrow0 + wid * QBLK) * D + h * 128 + r32;
#pragma unroll
      for (int r = 0; r < 16; ++r) { int roff = crow(r, hi) * D; asm volatile("" : "+v"(roff)); bf16_t* rp = Ow + roff;
#pragma unroll
        for (int d0 = 0; d0 < 4; ++d0) rp[d0 * 32] = (bf16_t)f2bf(o[d0][r] * ss[r] * gg[d0]); }
    }
#undef TROW
#undef SLOAD
#undef SWRITE
#undef SWAIT
#undef RESC
  }
}
#undef KSWZ
}
struct Args { const float* in[28]; float* out; unsigned char* ws; int ph_lo, ph_hi, li, pad; };
struct Frame {
    LAS unsigned char* lds;
    int tid, lane, wave, vcu, G;
    unsigned char* ws;
};
enum { I_X = 0, I_C, I_CTX, I_CCTX, I_WMOD, I_BMOD, I_WIN, I_LQ1, I_LK1, I_LQ2, I_LK2, I_ANG, I_CONVW, I_CONVB, I_LWA, I_LBA, I_LWX, I_LBX, I_LLAM, I_WOUT,
       I_LN1G, I_LN1B, I_WR, I_WG, I_WU, I_WD, I_LN2G, I_LN2B };

__device__ __forceinline__ void transpose_item(const float* W, int N, bf16_t* WT, int ldt, LAS float* scr, int kb, int nb, int lane) {
    const int k0 = 64 * kb, n0 = 32 * nb;
#pragma unroll 8
    for (int i = 0; i < 32; ++i) { const int kk = 2 * i + (lane >> 5); scr[kk * 33 + (lane & 31)] = W[(size_t)(k0 + kk) * N + n0 + (lane & 31)]; }
    LDS_WAIT(); asm volatile("" ::: "memory");
    const int c = lane & 7;
#pragma unroll
    for (int j = 0; j < 4; ++j) { const int n = (lane >> 3) + 8 * j; const LAS float* s = scr + (8 * c) * 33 + n;
        u32x4 o; o.x = pk2(s[0 * 33], s[1 * 33]); o.y = pk2(s[2 * 33], s[3 * 33]); o.z = pk2(s[4 * 33], s[5 * 33]); o.w = pk2(s[6 * 33], s[7 * 33]);
        *(u32x4*)(WT + (size_t)(n0 + n) * ldt + k0 + 8 * c) = o; }
    LDS_WAIT(); asm volatile("" ::: "memory");
}

__device__ __forceinline__ void p0a(Frame& F, const Args& args) {
    const int gw = F.vcu * NWAVES + F.wave, NGW = F.G * NWAVES;
    LAS float* scr = (LAS float*)(F.lds + F.wave * 16384);
    { constexpr int IA = 16 * 72, IB = 16 * 32, PER = IA + IB;
      for (int it = gw; it < DEPTH * PER; it += NGW) { const int l = it / PER, r = it - l * PER;
        if (r < IA) transpose_item(args.in[I_WIN] + (size_t)l * D * INW, INW, (bf16_t*)(F.ws + WS_WIN) + (size_t)l * INW * D, D, scr, r / 72, r % 72, F.lane);
        else { const int r2 = r - IA; transpose_item(args.in[I_WOUT] + (size_t)l * D * D, D, (bf16_t*)(F.ws + WS_WOUT) + (size_t)l * D * D, D, scr, r2 / 32, r2 % 32, F.lane); } } }
    __syncthreads();
    { LAS float* sl = (LAS float*)F.lds;
      LAS float* cmb = sl + 17 * 1024;
      bool loaded = false;
      for (int it = F.vcu; it < DEPTH * 24; it += F.G) {
        if (!loaded) { for (int i = F.tid; i < 17 * 1024; i += NTHR) { const float c = (i < 16 * 1024) ? args.in[I_C][i] : args.in[I_CCTX][i - 16 * 1024]; sl[i] = c * fast_sigmoid(c); } loaded = true; }
        __syncthreads();
        const int l = it / 24, nb = it % 24, col = nb * 256 + (F.tid & 255), kh = F.tid >> 8;
        const float* wp = args.in[I_WMOD] + (size_t)l * D * 6144 + (size_t)(kh * 512) * 6144 + col;
        float acc[17];
#pragma unroll
        for (int j = 0; j < 17; ++j) acc[j] = 0.f;
        const float* wq = wp; float w0 = wq[0], w1 = wq[6144], w2 = wq[2 * 6144], w3 = wq[3 * 6144];
#pragma unroll 1
        for (int k = 0; k < 512; k += 4) {
            wq += 4 * 6144; const bool more = (k + 4 < 512);
            const float n0 = more ? wq[0] : 0.f, n1 = more ? wq[6144] : 0.f, n2 = more ? wq[2 * 6144] : 0.f, n3 = more ? wq[3 * 6144] : 0.f;
#pragma unroll
            for (int j = 0; j < 17; ++j) { const f32x4 s = *(const LAS f32x4*)(sl + j * 1024 + kh * 512 + k); acc[j] += s[0] * w0 + s[1] * w1 + s[2] * w2 + s[3] * w3; }
            w0 = n0; w1 = n1; w2 = n2; w3 = n3; }
        if (kh == 1) {
#pragma unroll
            for (int j = 0; j < 17; ++j) cmb[j * 256 + (F.tid & 255)] = acc[j]; }
        __syncthreads();
        if (kh == 0) { const float bm = args.in[I_BMOD][l * 6144 + col]; float* mo = (float*)(F.ws + WS_MOD) + (size_t)l * 17 * 6144 + col;
#pragma unroll
            for (int j = 0; j < 17; ++j) mo[(size_t)j * 6144] = acc[j] + cmb[j * 256 + (F.tid & 255)] + bm; }
        __syncthreads(); } }
    __syncthreads();
    { LAS f32x2* tab = (LAS f32x2*)F.lds;
      for (int r = F.tid; r < 4096; r += NTHR) { float s, c; sincospif((float)r * (1.0f / 2048.0f), &s, &c); tab[r] = (f32x2){c, s}; }
      __syncthreads();
      bf16_t* AT = (bf16_t*)(F.ws + WS_AT);
      for (int k = F.vcu; k < 2048; k += F.G) {
        for (int c8 = F.tid; c8 < 1024; c8 += NTHR) { const int half = c8 >> 9, t0 = (c8 & 511) * 8; unsigned w[4];
#pragma unroll
            for (int q = 0; q < 4; ++q) { const f32x2 e0 = tab[(k * (t0 + 2 * q)) & 4095], e1 = tab[(k * (t0 + 2 * q + 1)) & 4095];
                w[q] = half ? pk2(-e0.y * (1.f / 64.f), -e1.y * (1.f / 64.f)) : pk2(e0.x * (1.f / 64.f), e1.x * (1.f / 64.f)); }
            *(u32x4*)(AT + (size_t)k * 8192 + half * 4096 + t0) = (u32x4){w[0], w[1], w[2], w[3]}; } }
      bf16_t* AC = (bf16_t*)(F.ws + WS_SMALL + SM_AC);
      for (int i = gw * 64 + F.lane; i < 256 * 512; i += NGW * 64) { const int k = i >> 9, c = i & 511, half = c >> 8, t = c & 255; const f32x2 e = tab[((k * t) & 255) * 16];
        AC[i] = (bf16_t)f2bf(half ? -e.y * (1.f / 16.f) : e.x * (1.f / 16.f)); }
      bf16_t* DC = (bf16_t*)(F.ws + WS_SMALL + SM_DC);
      for (int i = gw * 64 + F.lane; i < 512 * 256; i += NGW * 64) { const int r = i >> 8, col = i & 255, p = r >> 8, g = (r >> 6) & 3, cp = r & 63, g2 = col >> 6, c = col & 63;
        const f32x2 e = tab[((c * cp) & 63) * 64]; DC[i] = (bf16_t)((g == g2) ? f2bf((p ? e.y : e.x) * 0.125f) : 0u); }
    }
    { bf16_t* LW = (bf16_t*)(F.ws + WS_SMALL + SM_LRUW);
      for (int i = gw * 64 + F.lane; i < 4 * 2 * 2 * 4 * 4096; i += NGW * 64) { const int k = i & 63, n = (i >> 6) & 63, blk = (i >> 12) & 3, gate = (i >> 14) & 1, ld = i >> 15;
        const float* src = (gate ? args.in[I_LWX] : args.in[I_LWA]) + ((size_t)(ld * 4 + blk) * 64 + k) * 64 + n; LW[i] = (bf16_t)f2bf(*src); } }
    if (F.vcu == 0 && F.wave == 0) { float* lamv = (float*)(F.ws + WS_SMALL + SM_LAM);
      for (int l = 0; l < DEPTH; ++l) { const float a = wave_sum(args.in[I_LQ1][l * 64 + F.lane] * args.in[I_LK1][l * 64 + F.lane]), b = wave_sum(args.in[I_LQ2][l * 64 + F.lane] * args.in[I_LK2][l * 64 + F.lane]);
        const float li = 0.8f - 0.6f * expf(-0.3f * (float)l); if (F.lane == 0) lamv[l] = expf(a) - expf(b) + li; } }
    __syncthreads();
}

__device__ __forceinline__ void ln_mod_store(const f32x4 (&v)[4], const float* md_sh, const float* md_sc, bf16_t* hrow, int lane) {
    float s = 0.f;
#pragma unroll
    for (int q = 0; q < 4; ++q) s += (v[q][0] + v[q][1]) + (v[q][2] + v[q][3]);
    const float mean = wave_sum(s) * (1.f / D); float s2 = 0.f; f32x4 d[4];
#pragma unroll
    for (int q = 0; q < 4; ++q) { d[q] = v[q] - mean; s2 += (d[q][0] * d[q][0] + d[q][1] * d[q][1]) + (d[q][2] * d[q][2] + d[q][3] * d[q][3]); }
    const float rstd = __builtin_amdgcn_rsqf(wave_sum(s2) * (1.f / D) + LN_EPS);
#pragma unroll
    for (int q = 0; q < 4; ++q) { const int col = 4 * lane + 256 * q; const f32x4 sh = *(const f32x4*)(md_sh + col), sc = *(const f32x4*)(md_sc + col);
        const f32x4 h = d[q] * rstd * (sc + 1.0f) + sh; u32x2 w; w.x = cvt_pk_bf16(h[0], h[1]); w.y = cvt_pk_bf16(h[2], h[3]); *(u32x2*)(hrow + col) = w; }
}
__device__ __forceinline__ void p0b(Frame& F, const Args& args) {
    const int gw = F.vcu * NWAVES + F.wave, NGW = F.G * NWAVES;
    bf16_t* H = (bf16_t*)(F.ws + WS_H); const float* mod = (const float*)(F.ws + WS_MOD);
#define SRCROW(mm) ((mm) < ML ? args.in[I_X] + (size_t)(mm) * D : args.in[I_CTX] + (size_t)((mm) - ML) * D)
    f32x4 vn[4];
    if (gw < M) {
#pragma unroll
        for (int q = 0; q < 4; ++q) vn[q] = *(const f32x4*)(SRCROW(gw) + 4 * F.lane + 256 * q); }
    for (int m = gw; m < M; m += NGW) { const int j = m < ML ? (m >> 12) : 16;
        f32x4 v[4], shp[4], scp[4]; const float* md = mod + (size_t)j * 6144;
#pragma unroll
        for (int q = 0; q < 4; ++q) { v[q] = vn[q]; shp[q] = *(const f32x4*)(md + 4 * F.lane + 256 * q); scp[q] = *(const f32x4*)(md + D + 4 * F.lane + 256 * q); }
        asm volatile("" ::: "memory");
        if (m + NGW < M) {
#pragma unroll
            for (int q = 0; q < 4; ++q) vn[q] = *(const f32x4*)(SRCROW(m + NGW) + 4 * F.lane + 256 * q); }
        asm volatile("" ::: "memory");
        float s = 0.f;
#pragma unroll
        for (int q = 0; q < 4; ++q) s += (v[q][0] + v[q][1]) + (v[q][2] + v[q][3]);
        const float mean = wave_sum(s) * (1.f / D); float s2 = 0.f;
#pragma unroll
        for (int q = 0; q < 4; ++q) { v[q] = v[q] - mean; s2 += (v[q][0] * v[q][0] + v[q][1] * v[q][1]) + (v[q][2] * v[q][2] + v[q][3] * v[q][3]); }
        const float rstd = __builtin_amdgcn_rsqf(wave_sum(s2) * (1.f / D) + LN_EPS);
#pragma unroll
        for (int q = 0; q < 4; ++q) { const f32x4 h = v[q] * rstd * (scp[q] + 1.0f) + shp[q]; u32x2 w; w.x = cvt_pk_bf16(h[0], h[1]); w.y = cvt_pk_bf16(h[2], h[3]); *(u32x2*)(H + (size_t)m * D + 4 * F.lane + 256 * q) = w; } }
#undef SRCROW
}

__device__ __forceinline__ void pw_item(const float* W, int N, unsigned char* WT, int ldt, LAS float* scr, int kb, int nb, int tid, float scale) {
    const int wave = tid >> 6, lane = tid & 63, k0 = 128 * kb, n0 = 256 * nb;
    const float* src = W + (size_t)(k0 + wave * 16) * N + n0 + lane * 4;
#pragma unroll
    for (int i = 0; i < 16; ++i) *(LAS f32x4*)(scr + (wave * 16 + i) * 260 + lane * 4) = *(const f32x4*)(src + (size_t)i * N);
    __syncthreads();
    const int n = tid & 255, kh = tid >> 8; const LAS float* s = scr + (64 * kh) * 260 + n; unsigned char* dst = WT + (size_t)(n0 + n) * ldt + k0 + 64 * kh;
#pragma unroll
    for (int h = 0; h < 4; ++h) { unsigned w[4];
#pragma unroll
        for (int g = 0; g < 4; ++g) { const LAS float* p = s + (16 * h + 4 * g) * 260; w[g] = cvt4_fp8(p[0] * scale, p[260] * scale, p[520] * scale, p[780] * scale); }
        *(u32x4*)(dst + 16 * h) = (u32x4){w[0], w[1], w[2], w[3]}; }
    __syncthreads();
}
__device__ __forceinline__ void pw_experts(Frame& F, const Args& args, int l) {
    LAS float* scr = (LAS float*)F.lds;
    unsigned char* WGU = F.ws + WS_WEXP; unsigned char* WDN = F.ws + WS_WDN;
    for (int it = F.vcu; it < NE * 192; it += F.G) { const int e = it / 192, r = it - e * 192, which = r >> 6, q = r & 63;
        if (which < 2) pw_item(args.in[which ? I_WU : I_WG] + ((size_t)l * NE + e) * D * FE, FE, WGU + ((size_t)e * 2 + which) * FE * D, D, scr, q >> 3, q & 7, F.tid, SWG8);
        else pw_item(args.in[I_WD] + ((size_t)l * NE + e) * FE * D, D, WDN + (size_t)e * D * FE, FE, scr, q >> 2, q & 3, F.tid, SWD8); }
}

__device__ __forceinline__ void pe_phase(Frame& F, const Args& args, int l, int nrows) {
    const int gw = F.vcu * NWAVES + F.wave, NGW = F.G * NWAVES;
    LAS f32x4* WR4 = (LAS f32x4*)F.lds;
    { const float* wr = args.in[I_WR] + (size_t)l * D * NE;
      for (int i = F.tid; i < 16 * 4 * 64; i += NTHR) { const int ln = i & 63, e4 = (i >> 6) & 3, qi = i >> 8, q = qi >> 2, ii = qi & 3; WR4[i] = *(const f32x4*)(wr + (size_t)(4 * ln + ii + 256 * q) * NE + 4 * e4); } }
    __syncthreads();
    float* X = (float*)(F.ws + WS_X); const bf16_t* MIX = (const bf16_t*)(F.ws + WS_ZR); unsigned char* H8 = F.ws + WS_H; float* SC = (float*)(F.ws + WS_SC);
    const float* mod = (const float*)(F.ws + WS_MOD) + (size_t)l * 17 * 6144;
    const float* g1p = args.in[I_LN1G] + l * D; const float* b1p = args.in[I_LN1B] + l * D;
    f32x4 xn[4]; u32x2 mn[4];
    const float* Xin0 = (l == 0) ? args.in[I_X] : X; const float* Xin1 = (l == 0) ? args.in[I_CTX] - (size_t)ML * D : X;
#define XROW(mm) (((mm) < ML ? Xin0 : Xin1) + (size_t)(mm) * D)
    if (gw < nrows) {
#pragma unroll
        for (int q = 0; q < 4; ++q) { const int col = 4 * F.lane + 256 * q; xn[q] = *(const f32x4*)(XROW(gw) + col); mn[q] = *(const u32x2*)(MIX + (size_t)gw * D + col); } }
    f32x4 g1r[4], b1r[4];
#pragma unroll
    for (int q = 0; q < 4; ++q) { g1r[q] = *(const f32x4*)(g1p + 4 * F.lane + 256 * q); b1r[q] = *(const f32x4*)(b1p + 4 * F.lane + 256 * q); }
    for (int m = gw; m < nrows; m += NGW) { const int j = m < ML ? (m >> 12) : 16; const float* md = mod + (size_t)j * 6144;
        f32x4 v[4], gm[4], sh2[4], sc2[4]; float s = 0.f;
#pragma unroll
        for (int q = 0; q < 4; ++q) { const int col = 4 * F.lane + 256 * q; gm[q] = *(const f32x4*)(md + 2 * D + col); }
#pragma unroll
        for (int q = 0; q < 4; ++q) { const int col = 4 * F.lane + 256 * q; sh2[q] = *(const f32x4*)(md + 3 * D + col); sc2[q] = *(const f32x4*)(md + 4 * D + col); }
#pragma unroll
        for (int q = 0; q < 4; ++q) { const f32x4 mx4 = (f32x4){bflo(mn[q].x), bfhi(mn[q].x), bflo(mn[q].y), bfhi(mn[q].y)};
            v[q] = xn[q] * DN_ALPHA + gm[q] * mx4; s += (v[q][0] + v[q][1]) + (v[q][2] + v[q][3]); }
        asm volatile("" ::: "memory");
        if (m + NGW < nrows) {
#pragma unroll
            for (int q = 0; q < 4; ++q) { const int col = 4 * F.lane + 256 * q; xn[q] = *(const f32x4*)(XROW(m + NGW) + col); mn[q] = *(const u32x2*)(MIX + (size_t)(m + NGW) * D + col); } }
        asm volatile("" ::: "memory");
        const float mean = wave_sum(s) * (1.f / D); float s2 = 0.f;
#pragma unroll
        for (int q = 0; q < 4; ++q) { v[q] = v[q] - mean; s2 += (v[q][0] * v[q][0] + v[q][1] * v[q][1]) + (v[q][2] * v[q][2] + v[q][3] * v[q][3]); }
        const float rstd = __builtin_amdgcn_rsqf(wave_sum(s2) * (1.f / D) + LN_EPS); s = 0.f;
#pragma unroll
        for (int q = 0; q < 4; ++q) { const int col = 4 * F.lane + 256 * q; v[q] = v[q] * rstd * g1r[q] + b1r[q]; *(f32x4*)(X + (size_t)m * D + col) = v[q];
            s += (v[q][0] + v[q][1]) + (v[q][2] + v[q][3]); }
        const float mean2 = wave_sum(s) * (1.f / D); s2 = 0.f;
#pragma unroll
        for (int q = 0; q < 4; ++q) { v[q] = v[q] - mean2; s2 += (v[q][0] * v[q][0] + v[q][1] * v[q][1]) + (v[q][2] * v[q][2] + v[q][3] * v[q][3]); }
        const float rstd2 = __builtin_amdgcn_rsqf(wave_sum(s2) * (1.f / D) + LN_EPS);
        float lg[16];
#pragma unroll
        for (int e = 0; e < 16; ++e) lg[e] = 0.f;
#pragma unroll
        for (int q = 0; q < 4; ++q) { const int col = 4 * F.lane + 256 * q;
            const f32x4 h = v[q] * rstd2 * (sc2[q] + 1.0f) + sh2[q]; *(unsigned*)(H8 + (size_t)m * D + col) = cvt4_fp8(clamp448(h[0] * SX8), clamp448(h[1] * SX8), clamp448(h[2] * SX8), clamp448(h[3] * SX8));
#pragma unroll
            for (int ii = 0; ii < 4; ++ii)
#pragma unroll
                for (int e4 = 0; e4 < 4; ++e4) { const f32x4 w4 = WR4[((q * 4 + ii) * 4 + e4) * 64 + F.lane];
#pragma unroll
                    for (int k = 0; k < 4; ++k) lg[e4 * 4 + k] += h[ii] * w4[k]; } }
        float r1[8], r2[4];
#pragma unroll
        for (int k = 0; k < 8; ++k) { const float ta = lg[k] + xor32f(lg[k], F.lane < 32), tb = lg[k + 8] + xor32f(lg[k + 8], F.lane < 32); r1[k] = (F.lane & 32) ? tb : ta; }
#pragma unroll
        for (int k = 0; k < 4; ++k) { const float ta = r1[k] + swz16f(r1[k]), tb = r1[k + 4] + swz16f(r1[k + 4]); r2[k] = (F.lane & 16) ? tb : ta; }
        float mx = -1e30f;
#pragma unroll
        for (int k = 0; k < 4; ++k) { float t = r2[k]; t += dppf<0xB1>(t); t += dppf<0x4E>(t); t += dppf<0x141>(t); t += dppf<0x140>(t); r2[k] = t; mx = fmaxf(mx, t); }
        mx = fmaxf(mx, swz16f(mx)); mx = fmaxf(mx, xor32f(mx, F.lane < 32));
        float se = 0.f;
#pragma unroll
        for (int k = 0; k < 4; ++k) { r2[k] = __expf(r2[k] - mx); se += r2[k]; }
        se += swz16f(se); se += xor32f(se, F.lane < 32);
        const float inv = 1.0f / se;
        if ((F.lane & 15) == 0) *(f32x4*)(SC + (size_t)m * NE + 4 * (F.lane >> 4)) = (f32x4){r2[0] * inv, r2[1] * inv, r2[2] * inv, r2[3] * inv}; }
#undef XROW
    __syncthreads();
}

__device__ __forceinline__ int block_sum_i(LAS int* red, int v, int wave, int lane) {
    v = wave_sum_i(v);
    if (lane == 0) red[wave] = v;
    __syncthreads();
    int s = 0;
#pragma unroll
    for (int w = 0; w < 8; ++w) s += red[w];
    return s;
}
__device__ __forceinline__ int lower_lanes(unsigned long long m) { return (int)__builtin_amdgcn_mbcnt_hi((unsigned)(m >> 32), __builtin_amdgcn_mbcnt_lo((unsigned)m, 0u)); }
__device__ __forceinline__ void topk_pair(Frame& F, const float* SC, int* TM, int m0, int n, int e, int cap, int yrow0, LAS int* sel, LAS int* red) {
    unsigned key[8];
#pragma unroll
    for (int k = 0; k < 8; ++k) { const int t = k * NTHR + F.tid; key[k] = (t < n) ? __builtin_bit_cast(unsigned, SC[(size_t)(m0 + t) * NE + e]) : 0u; }
    unsigned v = 0u; int it = 0;
    for (int shift = 28; shift >= -2; shift -= 3, ++it) { const int sh = shift < 0 ? 0 : shift; const unsigned jmax = shift < 0 ? 1u : 7u;
        int c[8];
#pragma unroll
        for (int j = 0; j < 8; ++j) c[j] = 0;
#pragma unroll
        for (int k = 0; k < 8; ++k) { const unsigned t = key[k] >= v ? min((key[k] - v) >> sh, jmax) : 0u;
#pragma unroll
            for (int j = 1; j < 8; ++j) c[j] += (t >= (unsigned)j) ? 1 : 0; }
        int pk[4];
#pragma unroll
        for (int q = 0; q < 4; ++q) pk[q] = wave_sum_i(c[2 * q] | (c[2 * q + 1] << 16));
        LAS int* rb = red + (it & 1) * 32;
        if (F.lane == 0) {
#pragma unroll
            for (int q = 0; q < 4; ++q) rb[F.wave * 4 + q] = pk[q]; }
        __syncthreads();
        int tot[4] = {0, 0, 0, 0};
#pragma unroll
        for (int w = 0; w < 8; ++w)
#pragma unroll
            for (int q = 0; q < 4; ++q) tot[q] += rb[w * 4 + q];
        unsigned best = 0u;
#pragma unroll
        for (int j = 1; j < 8; ++j) { const int cj = (j & 1) ? (tot[j >> 1] >> 16) : (tot[j >> 1] & 0xffff); if (cj >= cap && (unsigned)j <= jmax) best = (unsigned)j; }
        v |= best << sh; }
    LAS int* cgt = red + 64; LAS int* ceq = red + 64 + 64;
    __syncthreads();
    int lg[8], le[8];
#pragma unroll
    for (int k = 0; k < 8; ++k) { const unsigned long long mg = __builtin_amdgcn_ballot_w64(key[k] > v), me = __builtin_amdgcn_ballot_w64(key[k] == v);
        lg[k] = lower_lanes(mg); le[k] = lower_lanes(me);
        if (F.lane == 0) { cgt[k * 8 + F.wave] = __builtin_popcountll(mg); ceq[k * 8 + F.wave] = __builtin_popcountll(me); } }
    __syncthreads();
    int tot_gt = 0;
    for (int i = 0; i < 64; ++i) tot_gt += cgt[i];
    const int need_eq = cap - tot_gt;
    int gb = 0, eb = 0, idx = 0;
#pragma unroll
    for (int k = 0; k < 8; ++k) {
        for (; idx < k * 8 + F.wave; ++idx) { gb += cgt[idx]; eb += ceq[idx]; }
        const int t = k * NTHR + F.tid;
        if (t < n) { const bool gt = key[k] > v, eq = key[k] == v; const int myg = gb + lg[k], mye = eb + le[k];
            const bool selx = gt || (eq && mye < need_eq); const int slot = myg + (mye < need_eq ? mye : need_eq);
            if (selx) sel[slot] = m0 + t;
            TM[(size_t)(m0 + t) * NE + e] = selx ? (yrow0 + slot) : -1; } }
    __syncthreads();
}
__device__ __forceinline__ void pk_phase(Frame& F, bool with_ctx) {
    LAS int* sel = (LAS int*)F.lds; LAS int* red = sel + 512;
    const float* SC = (const float*)(F.ws + WS_SC); int* TM = (int*)(F.ws + WS_TM);
    int* IDXp = (int*)(F.ws + WS_IDX);
    for (int pr = F.vcu; pr < (with_ctx ? 512 : 256); pr += F.G) {
        const bool lat = pr < 256; const int q = lat ? pr : pr - 256, b = q >> 4, e = q & 15;
        const int cap = lat ? CAPL : CAPC, yrow0 = lat ? (e * 17 + b) * 512 : (e * 17 + 16) * 512 + b * CAPC;
        topk_pair(F, SC, TM, lat ? b * T : ML + b * TC, lat ? T : TC, e, cap, yrow0, sel, red);
        for (int s = F.tid; s < cap; s += NTHR) IDXp[yrow0 + s] = sel[s];
        __syncthreads(); }
}

__device__ __forceinline__ void pj_phase(Frame& F, const Args& args, int l, int nrows) {
    const int gw = F.vcu * NWAVES + F.wave, NGW = F.G * NWAVES; const bool last = (l == DEPTH - 1);
    float* X = (float*)(F.ws + WS_X); bf16_t* H = (bf16_t*)(F.ws + WS_H); const float* SC = (const float*)(F.ws + WS_SC); const int* TM = (const int*)(F.ws + WS_TM);
    const unsigned char* Y = F.ws + WS_ZR;
    const float* mod = (const float*)(F.ws + WS_MOD) + (size_t)l * 17 * 6144; const float* modn = mod + 17 * 6144;
    const float* g2p = args.in[I_LN2G] + l * D; const float* b2p = args.in[I_LN2B] + l * D;
    int tmn = -1; float scn = 0.f; f32x4 xnx[4];
    if (gw < nrows) { if (F.lane < 16) { tmn = TM[(size_t)gw * NE + F.lane]; scn = SC[(size_t)gw * NE + F.lane]; }
#pragma unroll
        for (int q = 0; q < 4; ++q) xnx[q] = *(const f32x4*)(X + (size_t)gw * D + 4 * F.lane + 256 * q); }
    f32x4 g2r[4], b2r[4];
#pragma unroll
    for (int q = 0; q < 4; ++q) { g2r[q] = *(const f32x4*)(g2p + 4 * F.lane + 256 * q); b2r[q] = *(const f32x4*)(b2p + 4 * F.lane + 256 * q); }
    for (int m = gw; m < nrows; m += NGW) { const int j = m < ML ? (m >> 12) : 16; const float* md = mod + (size_t)j * 6144; const float* mdn = modn + (size_t)j * 6144;
        const int tmv = tmn; const float scv = scn;
        f32x4 xr[4], g2m[4], shn[4], scq[4];
#pragma unroll
        for (int q = 0; q < 4; ++q) { xr[q] = xnx[q]; g2m[q] = *(const f32x4*)(md + 5 * D + 4 * F.lane + 256 * q); }
        if (!last) {
#pragma unroll
            for (int q = 0; q < 4; ++q) { shn[q] = *(const f32x4*)(mdn + 4 * F.lane + 256 * q); scq[q] = *(const f32x4*)(mdn + D + 4 * F.lane + 256 * q); } }
        unsigned long long mask = __builtin_amdgcn_ballot_w64(tmv >= 0);
        f32x4 a[4];
#pragma unroll
        for (int q = 0; q < 4; ++q) a[q] = (f32x4){0.f, 0.f, 0.f, 0.f};
        bool first = true;
        do {
            int yr[4]; float gg[4];
#pragma unroll
            for (int k = 0; k < 4; ++k) { if (mask) { const int e = __builtin_ctzll(mask); mask &= mask - 1; yr[k] = __builtin_amdgcn_readlane(tmv, e); gg[k] = __builtin_bit_cast(float, __builtin_amdgcn_readlane(__builtin_bit_cast(int, scv), e)); } else { yr[k] = 0; gg[k] = 0.f; } }
            unsigned w[4][4];
#pragma unroll
            for (int k = 0; k < 4; ++k)
#pragma unroll
                for (int q = 0; q < 4; ++q) w[k][q] = *(const unsigned*)(Y + (size_t)yr[k] * D + 4 * F.lane + 256 * q);
            asm volatile("" ::: "memory");
            if (first && m + NGW < nrows) { if (F.lane < 16) { tmn = TM[(size_t)(m + NGW) * NE + F.lane]; scn = SC[(size_t)(m + NGW) * NE + F.lane]; }
#pragma unroll
                for (int q = 0; q < 4; ++q) xnx[q] = *(const f32x4*)(X + (size_t)(m + NGW) * D + 4 * F.lane + 256 * q); }
            first = false;
            asm volatile("" ::: "memory");
#pragma unroll
            for (int k = 0; k < 4; ++k)
#pragma unroll
                for (int q = 0; q < 4; ++q) { const float gs = gg[k] * (1.0f / SY8); a[q][0] += gs * __builtin_amdgcn_cvt_f32_fp8((int)w[k][q], 0); a[q][1] += gs * __builtin_amdgcn_cvt_f32_fp8((int)w[k][q], 1); a[q][2] += gs * __builtin_amdgcn_cvt_f32_fp8((int)w[k][q], 2); a[q][3] += gs * __builtin_amdgcn_cvt_f32_fp8((int)w[k][q], 3); }
        } while (mask);
        f32x4 v[4]; float s = 0.f;
#pragma unroll
        for (int q = 0; q < 4; ++q) { v[q] = xr[q] * DN_ALPHA + g2m[q] * a[q]; s += (v[q][0] + v[q][1]) + (v[q][2] + v[q][3]); }
        const float mean = wave_sum(s) * (1.f / D); float s2 = 0.f;
#pragma unroll
        for (int q = 0; q < 4; ++q) { v[q] = v[q] - mean; s2 += (v[q][0] * v[q][0] + v[q][1] * v[q][1]) + (v[q][2] * v[q][2] + v[q][3] * v[q][3]); }
        const float rstd = __builtin_amdgcn_rsqf(wave_sum(s2) * (1.f / D) + LN_EPS);
        float* dst = last ? args.out + (size_t)m * D : X + (size_t)m * D; s = 0.f;
#pragma unroll
        for (int q = 0; q < 4; ++q) { const int col = 4 * F.lane + 256 * q; v[q] = v[q] * rstd * g2r[q] + b2r[q]; *(f32x4*)(dst + col) = v[q]; s += (v[q][0] + v[q][1]) + (v[q][2] + v[q][3]); }
        if (!last) { const float mean2 = wave_sum(s) * (1.f / D); s2 = 0.f;
#pragma unroll
            for (int q = 0; q < 4; ++q) { v[q] = v[q] - mean2; s2 += (v[q][0] * v[q][0] + v[q][1] * v[q][1]) + (v[q][2] * v[q][2] + v[q][3] * v[q][3]); }
            const float rstd2 = __builtin_amdgcn_rsqf(wave_sum(s2) * (1.f / D) + LN_EPS);
#pragma unroll
            for (int q = 0; q < 4; ++q) { const int col = 4 * F.lane + 256 * q; const f32x4 h = v[q] * rstd2 * (scq[q] + 1.0f) + shn[q]; u32x2 w; w.x = cvt_pk_bf16(h[0], h[1]); w.y = cvt_pk_bf16(h[2], h[3]); *(u32x2*)(H + (size_t)m * D + col) = w; } } }
}
constexpr int LRU_U = 0, LRU_SA = 33280, LRU_SI = LRU_SA + 32768, LRU_HS = LRU_SI + 32768;
static_assert(LRU_HS + 32768 + 5 * 256 * 4 <= PH_LDS, "lru lds");
constexpr int NCHUNK = 2048 + 128;
constexpr size_t WS_AX = WS_HM + 64 * MiB;
template <bool FINAL>
__device__ __forceinline__ void lru_phase(Frame& F, const Args& args, int l, int nunits) {
    const bf16_t* Z = (const bf16_t*)(F.ws + WS_ZR); bf16_t* CC = (bf16_t*)(F.ws + WS_CC);
    f32x2* SUMM = (f32x2*)(F.ws + WS_SUM); const float* CAR = (const float*)(F.ws + WS_CAR); unsigned* AX = (unsigned*)(F.ws + WS_AX);
    LAS float* U32 = (LAS float*)(F.lds + LRU_U); LAS float* SA = (LAS float*)(F.lds + LRU_SA); LAS float* SI = (LAS float*)(F.lds + LRU_SI); LAS float* HS = (LAS float*)(F.lds + LRU_HS);
    const int fr = F.lane & 15, fq = F.lane >> 4, dw = F.wave >> 2, blk = F.wave & 3;
    bf16x8 bw[2][4][2];
    { const bf16_t* LW = (const bf16_t*)(F.ws + WS_SMALL + SM_LRUW);
#pragma unroll
      for (int gate = 0; gate < 2; ++gate)
#pragma unroll
        for (int nt = 0; nt < 4; ++nt)
#pragma unroll
          for (int s = 0; s < 2; ++s) bw[gate][nt][s] = *(const bf16x8*)(LW + ((size_t)((((l * 2 + dw) * 2 + gate) * 4 + blk) * 64 + 16 * nt + fr)) * 64 + 32 * s + 8 * fq); }
    float gba[4], gbx[4], gsp[4];
#pragma unroll
    for (int nt = 0; nt < 4; ++nt) { const int ch = blk * 64 + 16 * nt + fr, o = (l * 2 + dw) * 256 + ch; gba[nt] = args.in[I_LBA][o]; gbx[nt] = args.in[I_LBX][o]; gsp[nt] = log1pf(expf(-args.in[I_LLAM][o])); }
    const float* cw = args.in[I_CONVW] + l * 4 * 256; const float* cb = args.in[I_CONVB] + l * 256;
    const int dt = F.tid >> 8, cht = F.tid & 255;
    const int ctt = F.tid >> 5, cch0 = (F.tid & 31) * 8;
    LAS float* CW = (LAS float*)(F.lds + LRU_HS + 32768);
    for (int i = F.tid; i < 5 * 256; i += NTHR) CW[i] = (i < 1024) ? cw[i] : cb[i - 1024];
    __syncthreads();
    u32x4 zr[2][4];
#define LRU_DECODE(u_, m0_, sl_, t0_) do { if ((u_) < 2048) { m0_ = ((u_) >> 7) * T; sl_ = T; t0_ = ((u_) & 127) * 32; } else { const int u2_ = (u_) - 2048; m0_ = ML + (u2_ >> 3) * TC; sl_ = TC; t0_ = (u2_ & 7) * 32; } } while (0)
#define LRU_ZLOAD(u_) do { int m0_, sl_, t0_; LRU_DECODE(u_, m0_, sl_, t0_); _Pragma("unroll") for (int hh = 0; hh < 2; ++hh) _Pragma("unroll") for (int j = 0; j < 4; ++j) { const int ts = t0_ + ctt + 16 * hh + j - 2; \
        zr[hh][j] = (ts >= 0 && ts < sl_) ? *(const u32x4*)(Z + (size_t)(m0_ + ts) * INW + 1536 + cch0) : (u32x4){0u, 0u, 0u, 0u}; } } while (0)
    if (F.vcu < nunits) LRU_ZLOAD(F.vcu);
    for (int uidx = F.vcu; uidx < nunits; uidx += F.G) {
        int m0, seqlen, t0; LRU_DECODE(uidx, m0, seqlen, t0);
        {
#pragma unroll
          for (int hh = 0; hh < 2; ++hh) { const int tk = ctt + 16 * hh; float u[8];
#pragma unroll
            for (int i = 0; i < 8; ++i) u[i] = CW[1024 + cch0 + i];
#pragma unroll
            for (int j = 0; j < 4; ++j) { const u32x4 z = zr[hh][j];
                    const f32x4 wa = *(const LAS f32x4*)(CW + j * 256 + cch0), wb = *(const LAS f32x4*)(CW + j * 256 + cch0 + 4);
                    u[0] += bflo(z.x) * wa[0]; u[1] += bfhi(z.x) * wa[1]; u[2] += bflo(z.y) * wa[2]; u[3] += bfhi(z.y) * wa[3];
                    u[4] += bflo(z.z) * wb[0]; u[5] += bfhi(z.z) * wb[1]; u[6] += bflo(z.w) * wb[2]; u[7] += bfhi(z.w) * wb[3]; }
            *(LAS f32x4*)(U32 + tk * 260 + cch0) = (f32x4){u[0], u[1], u[2], u[3]}; *(LAS f32x4*)(U32 + tk * 260 + cch0 + 4) = (f32x4){u[4], u[5], u[6], u[7]}; } }
        if (uidx + F.G < nunits) LRU_ZLOAD(uidx + F.G);
        __syncthreads();
        float h = FINAL ? CAR[(size_t)uidx * 512 + F.tid] : 0.f, P = 1.f;
#pragma unroll
        for (int j = 0; j < 2; ++j) {
            { const int sc = dw ? 1 - j : j;
              bf16x8 af[2];
#pragma unroll
              for (int s = 0; s < 2; ++s) { const LAS float* up = U32 + (16 * sc + fr) * 260 + blk * 64 + 32 * s + 8 * fq; const f32x4 x0 = *(const LAS f32x4*)up, x1 = *(const LAS f32x4*)(up + 4);
                  u32x4 w; w.x = cvt_pk_bf16(x0[0], x0[1]); w.y = cvt_pk_bf16(x0[2], x0[3]); w.z = cvt_pk_bf16(x1[0], x1[1]); w.w = cvt_pk_bf16(x1[2], x1[3]); af[s] = __builtin_bit_cast(bf16x8, w); }
#pragma unroll
              for (int nt = 0; nt < 4; ++nt) { f32x4 pa = (f32x4){0.f, 0.f, 0.f, 0.f}, px = pa;
#pragma unroll
                for (int s = 0; s < 2; ++s) { pa = __builtin_amdgcn_mfma_f32_16x16x32_bf16(af[s], bw[0][nt][s], pa, 0, 0, 0); px = __builtin_amdgcn_mfma_f32_16x16x32_bf16(af[s], bw[1][nt][s], px, 0, 0, 0); }
                const int ch = blk * 64 + 16 * nt + fr;
#pragma unroll
                for (int i = 0; i < 4; ++i) { const int tk = 4 * fq + i; const float e1 = 1.0f + __expf(-(pa[i] + gba[nt])), e2 = 1.0f + __expf(-(px[i] + gbx[nt])), t12 = __builtin_amdgcn_rcpf(e1 * e2), r = t12 * e2, ig = t12 * e1;
                    const float la = -8.0f * r * gsp[nt], a = __expf(la), mult = __builtin_amdgcn_sqrtf(fmaxf(1.0f - a * a, 0.f)), u = U32[(16 * sc + tk) * 260 + ch];
                    SA[tk * 512 + dw * 256 + ch] = a; SI[tk * 512 + dw * 256 + ch] = mult * ig * u; } } }
            __syncthreads();
            { const int sct = dt ? 1 - j : j;
#pragma unroll
              for (int k = 0; k < 16; ++k) { const int tk = dt ? 15 - k : k; const float a = SA[tk * 512 + F.tid], x = SI[tk * 512 + F.tid]; h = a * h + x; P *= a;
                  if (!FINAL) AX[(size_t)(m0 + t0 + 16 * sct + tk) * 512 + F.tid] = pk2(1.0f - a, x);
                  if (FINAL) { LAS float* hp = HS + (16 * sct + tk) * 256 + cht; *hp = (j == 0) ? h : *hp + h; } } }
            __syncthreads();
        }
        if (!FINAL) SUMM[(size_t)uidx * 512 + F.tid] = (f32x2){P, h};
        else { const int tok = F.tid >> 4, ch0 = (F.tid & 15) * 16; const size_t m = (size_t)(m0 + t0 + tok);
#pragma unroll
            for (int hh = 0; hh < 2; ++hh) { const u32x4 g = *(const u32x4*)(Z + m * INW + 1792 + ch0 + 8 * hh); const unsigned gw_[4] = {g.x, g.y, g.z, g.w}; float y[8];
#pragma unroll
                for (int i = 0; i < 8; ++i) { const float gv = (i & 1) ? bfhi(gw_[i >> 1]) : bflo(gw_[i >> 1]); const float ge = gv * fast_sigmoid(1.5957691216057308f * (gv + 0.044715f * gv * gv * gv));
                    y[i] = HS[tok * 256 + ch0 + 8 * hh + i] * ge; }
                u32x4 w; w.x = cvt_pk_bf16(y[0], y[1]); w.y = cvt_pk_bf16(y[2], y[3]); w.z = cvt_pk_bf16(y[4], y[5]); w.w = cvt_pk_bf16(y[6], y[7]);
                *(u32x4*)(CC + m * D + 512 + ch0 + 8 * hh) = w; }
            __syncthreads(); }
    }
}
#undef LRU_DECODE
#undef LRU_ZLOAD

__device__ __forceinline__ void lru_final(Frame& F, int nunits) {
    const bf16_t* Z = (const bf16_t*)(F.ws + WS_ZR); bf16_t* CC = (bf16_t*)(F.ws + WS_CC);
    const float* CAR = (const float*)(F.ws + WS_CAR); const unsigned* AX = (const unsigned*)(F.ws + WS_AX);
    LAS float* HF = (LAS float*)F.lds; LAS float* HB = HF + 32 * 256;
    const int dt = F.tid >> 8, cht = F.tid & 255;
    unsigned ax[32]; float hin = 0.f;
#define LF_DECODE(u_, m0_, t0_) do { if ((u_) < 2048) { m0_ = ((u_) >> 7) * T; t0_ = ((u_) & 127) * 32; } else { const int u2_ = (u_) - 2048; m0_ = ML + (u2_ >> 3) * TC; t0_ = (u2_ & 7) * 32; } } while (0)
#define LF_LOAD(u_) do { int m0_, t0_; LF_DECODE(u_, m0_, t0_); _Pragma("unroll") for (int k = 0; k < 32; ++k) ax[k] = AX[(size_t)(m0_ + t0_ + (dt ? 31 - k : k)) * 512 + F.tid]; hin = CAR[(size_t)(u_) * 512 + F.tid]; } while (0)
    if (F.vcu < nunits) LF_LOAD(F.vcu);
    for (int uidx = F.vcu; uidx < nunits; uidx += F.G) {
        int m0, t0; LF_DECODE(uidx, m0, t0);
        const int tok = F.tid >> 4, ch0 = (F.tid & 15) * 16; const size_t m = (size_t)(m0 + t0 + tok);
        const u32x4 g0 = *(const u32x4*)(Z + m * INW + 1792 + ch0), g1 = *(const u32x4*)(Z + m * INW + 1792 + ch0 + 8);
        float h = hin; LAS float* hp = (dt ? HB : HF) + cht;
#pragma unroll
        for (int k = 0; k < 32; ++k) { const int tk = dt ? 31 - k : k; const unsigned w = ax[k]; h = (1.0f - bflo(w)) * h + bfhi(w); hp[tk * 256] = h; }
        if (uidx + F.G < nunits) LF_LOAD(uidx + F.G);
        __syncthreads();
        { const unsigned gw_[8] = {g0.x, g0.y, g0.z, g0.w, g1.x, g1.y, g1.z, g1.w};
#pragma unroll
          for (int hh = 0; hh < 2; ++hh) { float y[8];
#pragma unroll
            for (int i = 0; i < 8; ++i) { const unsigned wv = gw_[4 * hh + (i >> 1)]; const float gv = (i & 1) ? bfhi(wv) : bflo(wv); const float ge = gv * fast_sigmoid(1.5957691216057308f * (gv + 0.044715f * gv * gv * gv));
                y[i] = (HF[tok * 256 + ch0 + 8 * hh + i] + HB[tok * 256 + ch0 + 8 * hh + i]) * ge; }
            u32x4 w; w.x = cvt_pk_bf16(y[0], y[1]); w.y = cvt_pk_bf16(y[2], y[3]); w.z = cvt_pk_bf16(y[4], y[5]); w.w = cvt_pk_bf16(y[6], y[7]);
            *(u32x4*)(CC + m * D + 512 + ch0 + 8 * hh) = w; } }
        __syncthreads();
    }
#undef LF_DECODE
#undef LF_LOAD
}
__device__ __forceinline__ void lru_carry(Frame& F) {
    const int gid = (F.vcu - (F.G - NB)) * NTHR + F.tid; if (gid < 0 || gid >= NB * 512) return;
    const f32x2* SUMM = (const f32x2*)(F.ws + WS_SUM); float* CAR = (float*)(F.ws + WS_CAR);
    const int b = gid >> 9, dch = gid & 511, d = dch >> 8; float h = 0.f;
#pragma unroll 1
    for (int s0 = 0; s0 < 136; s0 += 34) { f32x2 sm[34];
#pragma unroll
        for (int k = 0; k < 34; ++k) { const int s = s0 + k; const int ux = (s < 8) ? 2048 + b * 8 + (d ? 7 - s : s) : b * 128 + (d ? 127 - (s - 8) : (s - 8)); sm[k] = SUMM[(size_t)ux * 512 + dch]; }
#pragma unroll
        for (int k = 0; k < 34; ++k) { const int s = s0 + k; const int ux = (s < 8) ? 2048 + b * 8 + (d ? 7 - s : s) : b * 128 + (d ? 127 - (s - 8) : (s - 8)); CAR[(size_t)ux * 512 + dch] = h; h = sm[k].x * h + sm[k].y; } }
}

constexpr int CW_F2 = 232000;
constexpr int CW_BAR = 1024, NPH_L = 10, NPHASE = 2 + DEPTH * NPH_L;
__global__ void __launch_bounds__(NTHR, 2) fwd_kernel(Args args) {
    extern __shared__ __attribute__((aligned(16))) unsigned char lds_raw[];
    Frame F;
    F.lds = (LAS unsigned char*)lds_raw;
    int wave_s = __builtin_amdgcn_readfirstlane((int)threadIdx.x >> 6);
    F.tid = threadIdx.x; F.lane = F.tid & 63; F.wave = wave_s;
    F.G = gridDim.x; { const int bx = blockIdx.x; F.vcu = (F.G % 8 == 0) ? (bx % 8) * (F.G / 8) + bx / 8 : bx; }
    F.ws = args.ws;
    volatile LAS unsigned* MISC = (volatile LAS unsigned*)(F.lds + MISC_OFF);
    if (F.tid < 128) MISC[F.tid] = 0u;
    { LAS f32x2* rope = (LAS f32x2*)(F.lds + ROPE_OFF);
      for (int i = F.tid; i < 1024; i += NTHR) { const int pos = i >> 4, j = i & 15; const float inv = exp2f(-(float)j * (13.287712379549449f / 16.0f)); float s, c; sincosf((float)pos * inv, &s, &c); rope[i] = (f32x2){c, s}; } }
    __syncthreads();
    XcdBarrier bar = xcd_barrier_post((unsigned*)(F.ws + WS_CTL) + CW_BAR + args.li * XCD_BAR_WORDS, MISC + 8);
    const int lo = args.ph_lo, hi = args.ph_hi;
#ifndef PHMASK
#define PHMASK 0xFFFFFFFFu
#endif
#define IN(k) (lo <= (k) && (k) < hi)
#define ON(b) ((PHMASK >> (b)) & 1u)
#define SEAM(k) do { if (IN(k) && IN((k) + 1)) { XcdBarrier b2_ = bar; unsigned x_ = b2_.x; asm volatile("" : "+s"(x_)); b2_.x = x_; unsigned* p_ = b2_.bar; asm volatile("" : "+s"(p_)); b2_.bar = p_; xcd_barrier(b2_); } RELAUNDER(); } while (0)
#define RELAUNDER() do { asm volatile("" : "+s"(wave_s)); int l_ = lane_id(); asm volatile("" : "+v"(l_)); F.lane = l_; F.wave = wave_s; F.tid = wave_s * 64 + l_; int v_ = F.vcu; asm volatile("" : "+s"(v_)); F.vcu = v_; size_t z_ = 0; asm volatile("" : "+s"(z_)); F.ws = args.ws + z_;     } while (0)
    LAS unsigned char* lds = F.lds;
    if (IN(0)) p0a(F, args);
    SEAM(0);
    if (IN(1)) p0b(F, args);
    SEAM(1);
    for (int l = 0; l < DEPTH; ++l) {
        RELAUNDER();
        const int pb = 2 + l * NPH_L; const bool last = (l == DEPTH - 1); const int nrows = last ? ML : M;
        const char* wsb = (const char*)F.ws;
        if (IN(pb + 0)) {
            pg8::GemmP g{D, D, D, (size_t)128 * D * 2, (size_t)128 * D * 2};
            pg8::SchedPlain S{9, (M / 256) * 9, F.G, F.vcu, wsb + WS_H, wsb + WS_WIN + (size_t)l * INW * D * 2, (size_t)256 * D * 2, (size_t)256 * D * 2, true};
            pg8::EpiInProj E{(bf16_t*)(F.ws + WS_ZR), (const LAS f32x2*)(F.lds + ROPE_OFF)};
            pg8::gemm_phase<pg8::EpiInProj, pg8::SchedPlain, true>(lds, g, S, E, F.tid);
        }
        SEAM(pb + 0);
        if (IN(pb + 1)) lru_phase<false>(F, args, l, NCHUNK);
        if (IN(pb + 1)) {
            pg8::GemmP g{256, 256, INW, (size_t)128 * 256 * 2, (size_t)128 * INW * 2};
            pg8::SchedF1 S{2 * (nrows / 256), F.G, F.vcu, wsb + WS_SMALL + SM_DC, wsb + WS_ZR + 2048 * 2};
            pg8::EpiF1 E{(bf16_t*)(F.ws + WS_GT), (bf16_t*)(F.ws + WS_GTC)};
            pg8::gemm_phase<pg8::EpiF1, pg8::SchedF1, true>(lds, g, S, E, F.tid);
        }
        if (IN(pb + 1) && !last) {
            const float lam = ((const float*)(F.ws + WS_SMALL + SM_LAM))[l], gsc = 1.0f - (0.8f - 0.6f * expf(-0.3f * (float)l));
            int bx_ = blockIdx.x; asm volatile("" : "+s"(bx_)); float* o1s = (float*)(F.ws + WS_O1) + (size_t)bx_ * 32768;
            for (int u2 = F.G - 1 - F.vcu; u2 < 64; u2 += F.G) { const int b = u2 >> 2, h = u2 & 3, qrow0 = ML + b * TC;
                att::diff_attn_unit((const bf16_t*)(F.ws + WS_ZR), (bf16_t*)(F.ws + WS_CC), o1s, args.in[I_ANG] + l * 512, lam, gsc, qrow0, h, qrow0, 4, qrow0, 4, (LAS char*)lds, F.tid); }
            __syncthreads();
        }
        SEAM(pb + 1);
        if (IN(pb + 2)) lru_carry(F);
        if (IN(pb + 2)) {
#pragma unroll 1
            for (int u = F.vcu; u < 1024; u += F.G) {
                if (u - F.vcu == (F.vcu & 3) * F.G) { __syncthreads(); { Frame Fp = F; int t_ = F.tid; asm volatile("" : "+v"(t_)); Fp.tid = t_; pw_experts(Fp, args, l); } __syncthreads(); }
                int lz = l; asm volatile("" : "+s"(lz));
                const float lam = ((const float*)(F.ws + WS_SMALL + SM_LAM))[lz], gsc = 1.0f - (0.8f - 0.6f * expf(-0.3f * (float)lz));
                int bx_ = blockIdx.x; asm volatile("" : "+s"(bx_)); float* o1s = (float*)(F.ws + WS_O1) + (size_t)bx_ * 32768;
                const int b = u >> 6, h = (u >> 4) & 3, qrow0 = b * T + (u & 15) * 256, seg0 = b * T, n0 = 64, seg1 = ML + b * TC, NT = 68;
                att::diff_attn_unit((const bf16_t*)(F.ws + WS_ZR), (bf16_t*)(F.ws + WS_CC), o1s, args.in[I_ANG] + lz * 512, lam, gsc, qrow0, h, seg0, n0, seg1, NT, (LAS char*)lds, F.tid);
            }
            __syncthreads();
        }
        SEAM(pb + 2);
        if (IN(pb + 3)) lru_final(F, last ? 2048 : NCHUNK);
        if (IN(pb + 3)) {
            { pg8::GemmP g{4096, 8192, 8192, (size_t)128 * 8192 * 2, (size_t)128 * 8192 * 2};
              pg8::SchedF2H S{F.G, F.vcu, wsb + WS_AT, wsb + WS_GT};
              pg8::EpiF2H E{(float*)(F.ws + WS_HM), (bf16_t*)(F.ws + WS_CC), (unsigned*)(F.ws + WS_CTL) + CW_F2, (unsigned)(l + 1)};
              pg8::gemm_phase<pg8::EpiF2H, pg8::SchedF2H, true>(lds, g, S, E, F.tid); }
            {
              const bf16_t* GT = (const bf16_t*)(F.ws + WS_GT); bf16_t* CC = (bf16_t*)(F.ws + WS_CC);
              for (int pr = F.vcu * NWAVES + F.wave; pr < NB * 256; pr += F.G * NWAVES) { const int b = pr >> 8, cp = pr & 255; const bf16_t* g = GT + ((size_t)(b * 256 + cp) * 2) * 4096 + F.lane * 64; float s = 0.f;
#pragma unroll
                  for (int q = 0; q < 8; ++q) { const u32x4 w = *(const u32x4*)(g + 8 * q); s += (bflo(w.x) - bfhi(w.x)) + (bflo(w.y) - bfhi(w.y)) + (bflo(w.z) - bfhi(w.z)) + (bflo(w.w) - bfhi(w.w)); }
                  s = wave_sum(s) * (1.0f / 64.0f); if (F.lane == 0) CC[(size_t)(b * T + T / 2) * D + 768 + cp] = (bf16_t)f2bf(s); } }
            if (!last) { pg8::GemmP g{512, 512, 512, (size_t)128 * 512 * 2, (size_t)128 * 512 * 2};
              pg8::SchedF2C S{F.G, F.vcu, wsb + WS_SMALL + SM_AC, wsb + WS_GTC};
              pg8::EpiBf16 E{(bf16_t*)(F.ws + WS_CC), D, 1.0f};
              pg8::gemm_phase<pg8::EpiBf16, pg8::SchedF2C, true>(lds, g, S, E, F.tid); }
        }
        SEAM(pb + 3);
        if (IN(pb + 4)) {
            pg8::GemmP g{D, D, D, (size_t)128 * D * 2, (size_t)128 * D * 2};
            pg8::SchedPlain S{4, (nrows / 256) * 4, F.G, F.vcu, wsb + WS_CC, wsb + WS_WOUT + (size_t)l * D * D * 2, (size_t)256 * D * 2, (size_t)256 * D * 2, false};
            pg8::EpiBf16 E{(bf16_t*)(F.ws + WS_ZR), D, 1.0f};
            pg8::gemm_phase<pg8::EpiBf16, pg8::SchedPlain, true>(lds, g, S, E, F.tid);
        }
        SEAM(pb + 4);
        if (IN(pb + 5)) pe_phase(F, args, l, nrows);
        SEAM(pb + 5);
        if (IN(pb + 6)) pk_phase(F, !last);
        SEAM(pb + 6);
        if (IN(pb + 7)) {
            pg8::GemmP g{D / 2, D / 2, D / 2, (size_t)128 * D, (size_t)FE * D};
            pg8::SchedGU S{last ? 32 : 34, F.G, F.vcu, wsb + WS_H, wsb + WS_WEXP, (const int*)(wsb + WS_IDX)};
            pg8::EpiGateUp E{F.ws + WS_HM};
            pg8::gemm_phase<pg8::EpiGateUp, pg8::SchedGU, true, true, true>(lds, g, S, E, F.tid);
        }
        SEAM(pb + 7);
        if (IN(pb + 8)) {
            pg8::GemmP g{FE / 2, FE / 2, FE / 2, (size_t)128 * FE, (size_t)128 * FE};
            pg8::SchedDN S{last ? 32 : 34, F.G, F.vcu, wsb + WS_HM, wsb + WS_WDN};
            pg8::EpiFp8 E{F.ws + WS_ZR, D, SY8 / (SH8 * SWD8)};
            pg8::gemm_phase<pg8::EpiFp8, pg8::SchedDN, true, true>(lds, g, S, E, F.tid);
        }
        SEAM(pb + 8);
        if (IN(pb + 9)) pj_phase(F, args, l, nrows);
        SEAM(pb + 9);
    }
#undef IN
#undef SEAM
}

#ifndef MK_PER_PHASE
#define MK_PER_PHASE 0
#endif
extern "C" void kernel_launch(void* const* d_in, const int* in_sizes, int n_in, void* d_out, int out_size, void* d_ws, size_t ws_size, hipStream_t stream) {
    static int grid = 0;
    if (grid == 0) {
        if (n_in != 28 || in_sizes[0] != ML * D || out_size != ML * D || ws_size < WS_END) { fprintf(stderr, "kernel_launch: unexpected shapes / workspace (n_in %d, ws %zu < %zu)\n", n_in, ws_size, (size_t)WS_END); grid = -1; return; }
        int dev = 0, cus = 0, per_cu = 0;
        if (hipGetDevice(&dev) != hipSuccess || hipDeviceGetAttribute(&cus, hipDeviceAttributeMultiprocessorCount, dev) != hipSuccess) { grid = -1; return; }
        if (hipFuncSetAttribute((const void*)fwd_kernel, hipFuncAttributeMaxDynamicSharedMemorySize, LDS_BYTES) != hipSuccess) { fprintf(stderr, "kernel_launch: hipFuncSetAttribute failed\n"); grid = -1; return; }
        if (hipOccupancyMaxActiveBlocksPerMultiprocessor(&per_cu, (const void*)fwd_kernel, NTHR, LDS_BYTES) != hipSuccess || per_cu < 1) { fprintf(stderr, "kernel_launch: occupancy query says %d\n", per_cu); }
        (void)hipGetLastError();
        grid = cus < 256 ? cus : 256;
    }
    if (grid < 0) return;
    if (hipMemsetAsync((char*)d_ws + WS_CTL, 0, CTL_ZERO_BYTES, stream) != hipSuccess) return;
    Args a{};
    for (int i = 0; i < 28; ++i) a.in[i] = (const float*)d_in[i];
    a.out = (float*)d_out; a.ws = (unsigned char*)d_ws;
#if MK_PER_PHASE
#ifdef DIAG
    hipMemsetAsync((char*)d_ws + WS_DIAG, 0, 256, stream);
#ifndef DIAG_L
#define DIAG_L 0
#endif
#ifndef DIAG_VAL
#define DIAG_VAL -1
#endif
#endif
    for (int p = 0; p < NPHASE; ++p) { a.ph_lo = p; a.ph_hi = p + 1; a.li = p; hipLaunchKernelGGL(fwd_kernel, dim3(grid), dim3(NTHR), LDS_BYTES, stream, a);
#ifdef DIAG
        const int l = (p - 2) / NPH_L, k = (p - 2) % NPH_L; int ids[2] = {-1, -1};
        if (p == 1) ids[0] = 0;
        if (p >= 2 && l == DIAG_L) { if (k == 0) ids[0] = 1; if (k == 2) ids[0] = 2; if (k == 3) { ids[0] = 3; ids[1] = 4; } if (k == 4) ids[0] = 5; if (k == 5) ids[0] = 6; if (k == 6) ids[0] = 7; if (k == 7) ids[0] = 8; if (k == 8) ids[0] = 9; }
        if (p >= 2 && l == 3 && k == 9) ids[0] = 10;
        for (int q = 0; q < 2; ++q) if (ids[q] >= 0) hipLaunchKernelGGL(chk_kernel, dim3(48), dim3(256), 0, stream, a, ids[q], ids[q] == 0 ? 0 : (ids[q] == 10 ? 3 : DIAG_L));
#endif
    }
#ifdef DIAG
    hipLaunchKernelGGL(fin_kernel, dim3(1), dim3(1), 0, stream, a, 16, DIAG_VAL);
#endif
#else
    a.ph_lo = 0; a.ph_hi = NPHASE; a.li = 0; hipLaunchKernelGGL(fwd_kernel, dim3(grid), dim3(NTHR), LDS_BYTES, stream, a);
#endif
}
```
